# Optimizing an MI355X kernel written in HIP

```python
import numpy as np
import jax, jax.numpy as jnp
from jax import lax

D_MODEL = 1024
BATCH = 8
SEQ = 2048
DEPTH = 1

HEAD_DIM = 64
NSA_HEADS = 8
NSA_KV = 2
NSA_REP = NSA_HEADS // NSA_KV
RWKV_HEADS = 8
NSA_WIDTH = NSA_HEADS * HEAD_DIM
RWKV_WIDTH = RWKV_HEADS * HEAD_DIM
MIX_WIDTH = NSA_WIDTH + RWKV_WIDTH
KV_WIDTH = NSA_KV * HEAD_DIM
ROPE_DIM = HEAD_DIM // 4
ROPE_THETA = 500000.0
CMP_BLOCK = 32
CMP_STRIDE = 16
CMP_HIDDEN = 256
SEL_BLOCK = 64
SEL_TOPK = 8
WINDOW = 512
Q_BLOCK = 128
DECAY_RANK = 64
ICLR_RANK = 64
RWKV_SHIFT_WIDTH = 3 * RWKV_WIDTH + DECAY_RANK + ICLR_RANK
IN_SIZES = (NSA_WIDTH, KV_WIDTH, KV_WIDTH, KV_WIDTH, KV_WIDTH, KV_WIDTH, KV_WIDTH,
            3 * NSA_HEADS, NSA_WIDTH, RWKV_SHIFT_WIDTH, RWKV_WIDTH)
IN_WIDTH = sum(IN_SIZES)
SCALE = HEAD_DIM ** -0.5
RMS_EPS = 1e-6
GN_EPS = 64e-5
NEG_INF = -1e30
FORCE_BONUS = 1e3

kernel_name = "hymba_nsa_rwkv7_hybrid"


def _split(h, sizes):
    idx = np.cumsum(sizes)[:-1].tolist()
    return jnp.split(h, idx, axis=-1)


def rms_norm(x, g):
    xf = x.astype(jnp.float32)
    y = xf * lax.rsqrt(jnp.mean(xf * xf, axis=-1, keepdims=True) + RMS_EPS)
    return (y * g.astype(jnp.float32)).astype(x.dtype)


def partial_rope(t, pos):
    half = ROPE_DIM // 2
    inv = ROPE_THETA ** (-jnp.arange(half, dtype=jnp.float32) / half)
    ang = pos.astype(jnp.float32)[:, None] * inv[None, :]
    cos, sin = jnp.cos(ang), jnp.sin(ang)
    tr = t[..., :ROPE_DIM].astype(jnp.float32)
    t1, t2 = tr[..., :half], tr[..., half:]
    rot = jnp.concatenate([t1 * cos - t2 * sin, t2 * cos + t1 * sin], axis=-1).astype(t.dtype)
    return jnp.concatenate([rot, t[..., ROPE_DIM:]], axis=-1)


def masked_softmax(s, mask):
    s = jnp.where(mask, s.astype(jnp.float32), NEG_INF)
    p = jax.nn.softmax(s, axis=-1)
    return jnp.where(mask, p, 0.0)


def compress_blocks(kv, pos_emb, w1, w2):
    B, G, S, D = kv.shape
    ch = kv.reshape(B, G, S // CMP_STRIDE, CMP_STRIDE, D)
    blk = jnp.concatenate([ch[:, :, :-1], ch[:, :, 1:]], axis=3) + pos_emb
    flat = blk.reshape(B, G, -1, CMP_BLOCK * D)
    return jax.nn.silu(flat @ w1) @ w2


def cmp_to_sel_matrix(n_cmp, n_sel):
    c0 = np.arange(n_cmp)[:, None] * CMP_STRIDE
    s0 = np.arange(n_sel)[None, :] * SEL_BLOCK
    ov = np.clip(np.minimum(c0 + CMP_BLOCK, s0 + SEL_BLOCK) - np.maximum(c0, s0), 0, None)
    return jnp.asarray(ov / CMP_BLOCK, dtype=jnp.float32)


def nsa_mixer(q, kc, vc, ks, vs, kw, vw, gate_logits,
              pos_k, w1_k, w2_k, pos_v, w1_v, w2_v):
    B, S, _ = q.shape
    n_cmp = S // CMP_STRIDE - 1
    n_sel = S // SEL_BLOCK
    top_n = min(SEL_TOPK, n_sel)
    n_qb = S // Q_BLOCK
    pos = jnp.arange(S)
    f32 = jnp.float32
    qh = q.reshape(B, S, NSA_KV, NSA_REP, HEAD_DIM).transpose(0, 2, 3, 1, 4)

    def kvh(t):
        return t.reshape(B, S, NSA_KV, HEAD_DIM).transpose(0, 2, 1, 3)

    k_cmp = compress_blocks(kvh(kc), pos_k, w1_k, w2_k)
    v_cmp = compress_blocks(kvh(vc), pos_v, w1_v, w2_v)
    s_cmp = jnp.einsum('bgrsd,bgcd->bgrsc', qh, k_cmp) * SCALE
    cmp_end = jnp.arange(n_cmp) * CMP_STRIDE + CMP_BLOCK - 1
    p_cmp = masked_softmax(s_cmp, cmp_end[None, :] <= pos[:, None])
    o_cmp = jnp.einsum('bgrsc,bgcd->bgrsd', p_cmp, v_cmp.astype(f32))

    imp = jnp.einsum('bgrsc,cj->bgsj', p_cmp, cmp_to_sel_matrix(n_cmp, n_sel))
    t_blk = (pos // SEL_BLOCK)[:, None]
    j = jnp.arange(n_sel)[None, :]
    forced = ((j == 0) | (j == t_blk) | (j == t_blk - 1)).astype(f32)
    imp = jnp.where(j <= t_blk, imp + FORCE_BONUS * forced, -1.0)
    _, sel_idx = lax.top_k(imp, top_n)

    q_rot = partial_rope(qh, pos)
    ks_blk = partial_rope(kvh(ks), pos).reshape(B, NSA_KV, n_sel, SEL_BLOCK, HEAD_DIM)
    vs_blk = kvh(vs).reshape(B, NSA_KV, n_sel, SEL_BLOCK, HEAD_DIM)
    pad = ((0, 0), (0, 0), (WINDOW, 0), (0, 0))
    kw_pad = jnp.pad(partial_rope(kvh(kw), pos), pad)
    vw_pad = jnp.pad(kvh(vw), pad)
    bi = jnp.arange(B)[:, None, None, None]
    gi = jnp.arange(NSA_KV)[None, :, None, None]
    n_tok = top_n * SEL_BLOCK

    def block_fn(qb):
        q0 = qb * Q_BLOCK
        tq = q0 + jnp.arange(Q_BLOCK)
        qc = lax.dynamic_slice_in_dim(q_rot, q0, Q_BLOCK, axis=3)
        idx = lax.dynamic_slice_in_dim(sel_idx, q0, Q_BLOCK, axis=2)
        k_g = ks_blk[bi, gi, idx].reshape(B, NSA_KV, Q_BLOCK, n_tok, HEAD_DIM)
        v_g = vs_blk[bi, gi, idx].reshape(B, NSA_KV, Q_BLOCK, n_tok, HEAD_DIM)
        k_pos = (idx[..., None] * SEL_BLOCK + jnp.arange(SEL_BLOCK)).reshape(B, NSA_KV, Q_BLOCK, n_tok)
        s_sel = jnp.einsum('bgrqd,bgqmd->bgrqm', qc, k_g) * SCALE
        p_sel = masked_softmax(s_sel, (k_pos <= tq[:, None])[:, :, None])
        o_sel = jnp.einsum('bgrqm,bgqmd->bgrqd', p_sel, v_g.astype(f32))
        kwc = lax.dynamic_slice_in_dim(kw_pad, q0, WINDOW + Q_BLOCK, axis=2)
        vwc = lax.dynamic_slice_in_dim(vw_pad, q0, WINDOW + Q_BLOCK, axis=2)
        w_pos = q0 - WINDOW + jnp.arange(WINDOW + Q_BLOCK)
        diff = tq[:, None] - w_pos[None, :]
        w_mask = (diff >= 0) & (diff < WINDOW) & (w_pos[None, :] >= 0)
        s_win = jnp.einsum('bgrqd,bgkd->bgrqk', qc, kwc) * SCALE
        p_win = masked_softmax(s_win, w_mask)
        o_win = jnp.einsum('bgrqk,bgkd->bgrqd', p_win, vwc.astype(f32))
        return o_sel, o_win

    o_sel, o_win = lax.map(block_fn, jnp.arange(n_qb))

    def unblock(o):
        return o.transpose(1, 2, 3, 0, 4, 5).reshape(B, NSA_KV, NSA_REP, S, HEAD_DIM)

    g = jax.nn.sigmoid(gate_logits.astype(f32)).reshape(B, S, NSA_KV, NSA_REP, 3).transpose(0, 2, 3, 1, 4)
    o = g[..., 0:1] * o_cmp + g[..., 1:2] * unblock(o_sel) + g[..., 2:3] * unblock(o_win)
    return o.transpose(0, 3, 1, 2, 4).reshape(B, S, NSA_WIDTH)


def rwkv7_step(state, inp):
    r_t, w_t, k_t, v_t, kk_t, a_t = inp
    sa = jnp.einsum('bhvk,bhk->bhv', state, -kk_t)
    state = (state * w_t[:, :, None, :] + sa[..., None] * (kk_t * a_t)[:, :, None, :]
             + v_t[..., None] * k_t[:, :, None, :])
    y = jnp.einsum('bhvk,bhk->bhv', state, r_t)
    return state, y


def rwkv7_mixer(p, shift_mu, w0, w_up, a0, a_up, k_k, k_a, r_k, gn_w, gn_b):
    B, S, _ = p.shape
    f32 = jnp.float32
    prev = jnp.pad(p, ((0, 0), (1, 0), (0, 0)))[:, :-1]
    p = p + shift_mu * (prev - p)
    r, k, v, wd, ad = _split(p, (RWKV_WIDTH, RWKV_WIDTH, RWKV_WIDTH, DECAY_RANK, ICLR_RANK))
    w = (w0 + jnp.tanh(wd) @ w_up).astype(f32)
    decay = jnp.exp(-jnp.exp(-jax.nn.softplus(-w) - 0.5))
    a = jax.nn.sigmoid((a0 + ad @ a_up).astype(f32))

    def heads(t):
        return t.astype(f32).reshape(B, S, RWKV_HEADS, HEAD_DIM)

    kk = heads(k * k_k)
    kk = kk / jnp.maximum(jnp.sqrt(jnp.sum(kk * kk, axis=-1, keepdims=True)), 1e-12)
    k = k.astype(f32) * (1.0 + (a - 1.0) * k_a)
    rh, kh, vh, wh, ah = heads(r), heads(k), heads(v), heads(decay), heads(a)

    def tm(t):
        return t.transpose(1, 0, 2, 3)

    s0 = jnp.zeros((B, RWKV_HEADS, HEAD_DIM, HEAD_DIM), f32)
    _, y = lax.scan(rwkv7_step, s0, (tm(rh), tm(wh), tm(kh), tm(vh), tm(kk), tm(ah)))
    y = y.transpose(1, 0, 2, 3)
    mean = jnp.mean(y, axis=-1, keepdims=True)
    var = jnp.mean(jnp.square(y - mean), axis=-1, keepdims=True)
    y = (y - mean) * lax.rsqrt(var + GN_EPS)
    y = y * gn_w.reshape(RWKV_HEADS, HEAD_DIM) + gn_b.reshape(RWKV_HEADS, HEAD_DIM)
    y = y + jnp.sum(rh * kh * r_k.reshape(RWKV_HEADS, HEAD_DIM), axis=-1, keepdims=True) * vh
    return y.reshape(B, S, RWKV_WIDTH)


def hybrid_layer(x, norm_g, w_in, cmp_pos_k, cmp_w1_k, cmp_w2_k, cmp_pos_v, cmp_w1_v, cmp_w2_v,
                 shift_mu, decay_w0, decay_up, iclr_a0, iclr_up, k_k, k_a, r_k, gn_w, gn_b, w_out):
    h = rms_norm(x, norm_g)
    proj = h @ w_in
    (q, kc, vc, ks, vs, kw, vw, gl, g_nsa, rwkv_in, g_rwkv) = _split(proj, IN_SIZES)
    o_nsa = nsa_mixer(q, kc, vc, ks, vs, kw, vw, gl,
                      cmp_pos_k, cmp_w1_k, cmp_w2_k, cmp_pos_v, cmp_w1_v, cmp_w2_v)
    o_nsa = o_nsa * jax.nn.silu(g_nsa.astype(jnp.float32))
    o_rwkv = rwkv7_mixer(rwkv_in, shift_mu, decay_w0, decay_up, iclr_a0, iclr_up,
                         k_k, k_a, r_k, gn_w, gn_b)
    o_rwkv = o_rwkv * jax.nn.silu(g_rwkv.astype(jnp.float32))
    mix = jnp.concatenate([o_nsa, o_rwkv], axis=-1).astype(x.dtype)
    return x + mix @ w_out


def setup_inputs(seed: int = 0) -> dict:
    key = jax.random.key(seed)
    ks = jax.random.split(key, 24)
    f32 = jnp.float32

    def nrm(k, shape, scale):
        return jax.random.normal(k, shape, f32) * scale

    L = DEPTH
    return {
        "x": nrm(ks[0], (BATCH, SEQ, D_MODEL), 1.0),
        "norm_g": 1.0 + nrm(ks[1], (L, D_MODEL), 0.05),
        "w_in": nrm(ks[2], (L, D_MODEL, IN_WIDTH), D_MODEL ** -0.5),
        "cmp_pos_k": nrm(ks[3], (L, CMP_BLOCK, HEAD_DIM), 0.1),
        "cmp_w1_k": nrm(ks[4], (L, CMP_BLOCK * HEAD_DIM, CMP_HIDDEN), (CMP_BLOCK * HEAD_DIM) ** -0.5),
        "cmp_w2_k": nrm(ks[5], (L, CMP_HIDDEN, HEAD_DIM), CMP_HIDDEN ** -0.5),
        "cmp_pos_v": nrm(ks[6], (L, CMP_BLOCK, HEAD_DIM), 0.1),
        "cmp_w1_v": nrm(ks[7], (L, CMP_BLOCK * HEAD_DIM, CMP_HIDDEN), (CMP_BLOCK * HEAD_DIM) ** -0.5),
        "cmp_w2_v": nrm(ks[8], (L, CMP_HIDDEN, HEAD_DIM), CMP_HIDDEN ** -0.5),
        "shift_mu": jax.random.uniform(ks[9], (L, RWKV_SHIFT_WIDTH), f32),
        "decay_w0": jax.random.uniform(ks[10], (L, RWKV_WIDTH), f32, -4.0, 1.0),
        "decay_up": nrm(ks[11], (L, DECAY_RANK, RWKV_WIDTH), 0.1 * DECAY_RANK ** -0.5),
        "iclr_a0": nrm(ks[12], (L, RWKV_WIDTH), 0.5),
        "iclr_up": nrm(ks[13], (L, ICLR_RANK, RWKV_WIDTH), 0.5 * ICLR_RANK ** -0.5),
        "k_k": 0.85 + nrm(ks[14], (L, RWKV_WIDTH), 0.05),
        "k_a": 1.0 + nrm(ks[15], (L, RWKV_WIDTH), 0.05),
        "r_k": nrm(ks[16], (L, RWKV_WIDTH), 0.1),
        "gn_w": 1.0 + nrm(ks[17], (L, RWKV_WIDTH), 0.05),
        "gn_b": nrm(ks[18], (L, RWKV_WIDTH), 0.02),
        "w_out": nrm(ks[19], (L, MIX_WIDTH, D_MODEL), MIX_WIDTH ** -0.5),
        "final_g": 1.0 + nrm(ks[20], (D_MODEL,), 0.05),
    }


def reference(x, norm_g, w_in, cmp_pos_k, cmp_w1_k, cmp_w2_k, cmp_pos_v, cmp_w1_v, cmp_w2_v,
              shift_mu, decay_w0, decay_up, iclr_a0, iclr_up, k_k, k_a, r_k, gn_w, gn_b,
              w_out, final_g):
    h = x
    for l in range(DEPTH):
        h = hybrid_layer(h, norm_g[l], w_in[l], cmp_pos_k[l], cmp_w1_k[l], cmp_w2_k[l],
                         cmp_pos_v[l], cmp_w1_v[l], cmp_w2_v[l], shift_mu[l], decay_w0[l],
                         decay_up[l], iclr_a0[l], iclr_up[l], k_k[l], k_a[l], r_k[l],
                         gn_w[l], gn_b[l], w_out[l])
    return rms_norm(h, final_g)
```

```cpp
#include <hip/hip_runtime.h>
#include <hip/hip_bf16.h>
#include <hip/hip_cooperative_groups.h>
#include <cstdio>
namespace cg = cooperative_groups;


typedef unsigned short bf16_t;
using bf16x8 = __attribute__((ext_vector_type(8))) short;
using f32x16 = __attribute__((ext_vector_type(16))) float;

#define DI __device__ __forceinline__

constexpr int T_ = 16384, S_ = 2048;
constexpr int NPAD = 4096;
constexpr int LDH = 1088, LDW = 1088, LDW1 = 2112, LDHID = 320, LDW2 = 320, LDKC = 136, VTS = 2112;

typedef __bf16 bf16x2_t __attribute__((ext_vector_type(2)));
typedef float f32x2_t __attribute__((ext_vector_type(2)));
DI unsigned pk2(float a, float b) {
  f32x2_t v = {a, b};
  return __builtin_bit_cast(unsigned, __builtin_convertvector(v, bf16x2_t));
}
DI bf16_t f2bf(float x) { return (bf16_t)(pk2(x, 0.f) & 0xffffu); }
DI float bf2f(bf16_t b) { return __uint_as_float(((unsigned)b) << 16); }
DI float sigmoidf_(float x) { return 1.f / (1.f + __expf(-x)); }
DI float siluf_(float x) { return x / (1.f + __expf(-x)); }
DI float wsum(float x) {
#pragma unroll
  for (int o = 32; o >= 1; o >>= 1) x += __shfl_xor(x, o);
  return x;
}
DI float wmax(float x) {
#pragma unroll
  for (int o = 32; o >= 1; o >>= 1) x = fmaxf(x, __shfl_xor(x, o));
  return x;
}
template <int CTRL> DI float dppf(float x) {
  return __int_as_float(__builtin_amdgcn_update_dpp(0, __float_as_int(x), CTRL, 0xf, 0xf, true));
}
DI float allred16(float x) {
  x += dppf<0xB1>(x);
  x += dppf<0x4E>(x);
  x += dppf<0x141>(x);
  x += dppf<0x128>(x);
  return x;
}

struct Params {
  const float *x, *norm_g, *w_in, *pos_k, *w1_k, *w2_k, *pos_v, *w1_v, *w2_v, *mu, *w0, *w_up, *a0, *a_up, *k_k, *k_a, *r_k,
      *gn_w, *gn_b, *w_out, *final_g;
  float* out;
  bf16_t *WinT, *WoutT, *W1Tk, *W1Tv, *W2Tk, *W2Tv, *WupT, *AupT;
  float *bias1k, *bias1v;
  float2* rope;
  bf16_t *qb, *kcb, *vcb, *ksb, *kwb, *vsb, *vwb, *vsT, *vwT;
  float* glb;
  bf16_t *gns, *rw, *grw, *hidk, *hidv, *kcmp, *vcmp, *vcmpT;
  bf16_t *rr, *kp, *vv, *kk, *bb;
  float *dec, *yraw;
  bf16_t* mix;
  bf16_t* hb;
  unsigned* ctr;
  unsigned* xbar;
};

DI void transpose_tile(const float* __restrict__ src, int ldsrc, bf16_t* __restrict__ dst, int ldd, int k0, int n0, const float* scale,
                       int mapmode, int nvalid, float* tile) {
  const int tid = threadIdx.x, tx = tid & 63, ty = tid >> 6;
  int n = n0 + tx;
  int on;
  if (mapmode == 1) on = (n < 1304) ? n : (n < 1408 ? -1 : n - 104);
  else on = (n < nvalid) ? n : -1;
#pragma unroll 4
  for (int i = 0; i < 16; ++i) {
    int kl = ty * 16 + i;
    float v = 0.f;
    if (on >= 0) {
      v = src[(size_t)(k0 + kl) * ldsrc + on];
      if (scale) v *= scale[k0 + kl];
    }
    tile[kl * 65 + tx] = v;
  }
  __syncthreads();
#pragma unroll 4
  for (int i = 0; i < 16; ++i) {
    int nl = ty * 16 + i;
    dst[(size_t)(n0 + nl) * ldd + k0 + tx] = f2bf(tile[tx * 65 + nl]);
  }
  __syncthreads();
}

__device__ void phase_prep(const Params& p, char* smem) {
  float* tile = (float*)smem;
  const int nb = gridDim.x, bid = blockIdx.x, tid = threadIdx.x;
  {
    const int lane = tid & 63;
    for (int row = bid * 4 + (tid >> 6); row < T_; row += nb * 4) {
      const float4* x4 = (const float4*)(p.x + (size_t)row * 1024);
      float4 v[4];
      float ss = 0.f;
#pragma unroll
      for (int i = 0; i < 4; ++i) {
        v[i] = x4[i * 64 + lane];
        ss += v[i].x * v[i].x + v[i].y * v[i].y + v[i].z * v[i].z + v[i].w * v[i].w;
      }
      ss = wsum(ss);
      const float sc = rsqrtf(ss * (1.f / 1024.f) + 1e-6f);
      uint2* h2 = (uint2*)(p.hb + (size_t)row * LDH);
#pragma unroll
      for (int i = 0; i < 4; ++i) {
        uint2 o;
        o.x = pk2(v[i].x * sc, v[i].y * sc);
        o.y = pk2(v[i].z * sc, v[i].w * sc);
        h2[i * 64 + lane] = o;
      }
    }
  }
  const int n_win = 16 * 64, n_wout = 16 * 16, n_w1 = 32 * 4, n_w2 = 4 * 2, n_lora = 1 * 8;
  const int o1 = n_win, o2 = o1 + n_wout, o3 = o2 + n_w1, o4 = o3 + n_w1, o5 = o4 + n_w2, o6 = o5 + n_w2, o7 = o6 + n_lora,
            o8 = o7 + n_lora, o9 = o8 + 128, o10 = o9 + 16;
  for (int it = bid; it < o10; it += nb) {
    if (it < o1) {
      int kt = it & 15, nt = it >> 4;
      transpose_tile(p.w_in, 3992, p.WinT, LDW, kt * 64, nt * 64, p.norm_g, 1, 0, tile);
    } else if (it < o2) {
      int j = it - o1, kt = j & 15, nt = j >> 4;
      transpose_tile(p.w_out, 1024, p.WoutT, LDW, kt * 64, nt * 64, nullptr, 0, 1024, tile);
    } else if (it < o3) {
      int j = it - o2, kt = j & 31, nt = j >> 5;
      transpose_tile(p.w1_k, 256, p.W1Tk, LDW1, kt * 64, nt * 64, nullptr, 0, 256, tile);
    } else if (it < o4) {
      int j = it - o3, kt = j & 31, nt = j >> 5;
      transpose_tile(p.w1_v, 256, p.W1Tv, LDW1, kt * 64, nt * 64, nullptr, 0, 256, tile);
    } else if (it < o5) {
      int j = it - o4, kt = j & 3, nt = j >> 2;
      transpose_tile(p.w2_k, 64, p.W2Tk, LDW2, kt * 64, nt * 64, nullptr, 0, 64, tile);
    } else if (it < o6) {
      int j = it - o5, kt = j & 3, nt = j >> 2;
      transpose_tile(p.w2_v, 64, p.W2Tv, LDW2, kt * 64, nt * 64, nullptr, 0, 64, tile);
    } else if (it < o7) {
      int nt = it - o6;
      transpose_tile(p.w_up, 512, p.WupT, 64, 0, nt * 64, nullptr, 0, 512, tile);
    } else if (it < o8) {
      int nt = it - o7;
      transpose_tile(p.a_up, 512, p.AupT, 64, 0, nt * 64, nullptr, 0, 512, tile);
    } else if (it < o9) {
      const int j = it - o8, which = j >> 6, n0 = (j & 63) * 4;
      const float* pos = which ? p.pos_v : p.pos_k;
      const float* w1 = which ? p.w1_v : p.w1_k;
      float* bo = which ? p.bias1v : p.bias1k;
      const int kp = tid >> 2, nn = tid & 3;
      float a = 0.f;
#pragma unroll 16
      for (int k = kp * 32; k < kp * 32 + 32; ++k) a += pos[k] * w1[(size_t)k * 256 + n0 + nn];
      tile[tid] = a;
      __syncthreads();
      if (tid < 4) {
        float sum = 0.f;
        for (int q = 0; q < 64; ++q) sum += tile[q * 4 + tid];
        bo[n0 + tid] = sum;
      }
      __syncthreads();
    } else {
      int j = it - o9;
      for (int e = tid; e < 1024; e += 256) {
        int idx = j * 1024 + e;
        int pos = idx >> 3, i = idx & 7;
        float inv = powf(500000.0f, -(float)i / 8.0f);
        float ang = (float)pos * inv;
        float sn, cs;
        sincosf(ang, &sn, &cs);
        p.rope[idx] = make_float2(cs, sn);
      }
    }
  }
}

constexpr int LDT = 40;

DI int crow(int i, int h) { return (i & 3) + 8 * (i >> 2) + 4 * h; }

enum { G_PROJ = 0, G_CMP1 = 1, G_CMP2 = 2, G_OUT = 3 };

template <int MODE, bool EPI = true>
__device__ void gemm_tile(const Params& p, int mt, int nt, int which, char* smem) {
  constexpr int K = (MODE == G_PROJ) ? 1024 : (MODE == G_CMP1) ? 2048 : (MODE == G_CMP2) ? 256 : 1024;
  constexpr int LDA = (MODE == G_PROJ) ? LDH : (MODE == G_CMP1) ? LDKC : (MODE == G_CMP2) ? LDHID : LDH;
  constexpr int LDB = (MODE == G_PROJ) ? LDW : (MODE == G_CMP1) ? LDW1 : (MODE == G_CMP2) ? LDW2 : LDW;
  const int tid = threadIdx.x, lane = tid & 63, wave = tid >> 6;
  const int wm = wave >> 1, wn = wave & 1;
  const int m0 = mt * 128, n0 = nt * 128;

  const bf16_t* Bt;
  const bf16_t* Ab;
  if (MODE == G_PROJ) { Bt = p.WinT; Ab = p.hb; }
  else if (MODE == G_CMP1) { Bt = which ? p.W1Tv : p.W1Tk; Ab = which ? p.vcb : p.kcb; }
  else if (MODE == G_CMP2) { Bt = which ? p.W2Tv : p.W2Tk; Ab = which ? p.hidv : p.hidk; }
  else { Bt = p.WoutT; Ab = p.mix; }

  const int lrr = lane >> 2;
  const int lks = (lane & 3) ^ ((lane >> 4) & 3);
  const bf16_t* apA;
  const bf16_t* apB;
  const bf16_t* bpA;
  const bf16_t* bpB;
  {
    const int r0 = m0 + (2 * wave) * 16 + lrr, r1 = r0 + 16;
    size_t a0, a1;
    if (MODE == G_CMP1) {
      a0 = (size_t)(r0 >> 1) * (16 * LDA) + (r0 & 1) * 64;
      a1 = (size_t)(r1 >> 1) * (16 * LDA) + (r1 & 1) * 64;
    } else {
      a0 = (size_t)r0 * LDA;
      a1 = (size_t)r1 * LDA;
    }
    apA = Ab + a0;
    apB = Ab + a1;
    bpA = Bt + (size_t)(n0 + (2 * wave) * 16 + lrr) * LDB + lks * 8;
    bpB = bpA + (size_t)16 * LDB;
  }
  char* ldsw = smem + (2 * wave) * 1024;
  auto glds = [&](int kt) __attribute__((always_inline)) {
    char* st = ldsw + (kt & 3) * 16384;
    const int k_ = kt * 32 + lks * 8;
    const size_t ko_ = (MODE == G_CMP1) ? ((size_t)(k_ >> 6) * LDA + (k_ & 63)) : (size_t)k_;
    __builtin_amdgcn_global_load_lds((const unsigned*)(apA + ko_), (__attribute__((address_space(3))) unsigned*)(st), 16, 0, 0);
    __builtin_amdgcn_global_load_lds((const unsigned*)(apB + ko_), (__attribute__((address_space(3))) unsigned*)(st + 1024), 16, 0, 0);
    __builtin_amdgcn_global_load_lds((const unsigned*)(bpA + kt * 32), (__attribute__((address_space(3))) unsigned*)(st + 8192), 16, 0, 0);
    __builtin_amdgcn_global_load_lds((const unsigned*)(bpB + kt * 32), (__attribute__((address_space(3))) unsigned*)(st + 8192 + 1024), 16, 0, 0);
  };

  f32x16 acc[2][2];
#pragma unroll
  for (int a = 0; a < 2; ++a)
#pragma unroll
    for (int b = 0; b < 2; ++b)
#pragma unroll
      for (int i = 0; i < 16; ++i) acc[a][b][i] = 0.f;

  const int frr = lane & 15, fhi = (lane >> 4) & 1, fq = lane >> 5;
  int offA[2], offB[2];
#pragma unroll
  for (int i = 0; i < 2; ++i) {
    offA[i] = ((wm * 64 + i * 32) >> 4) * 1024 + fhi * 1024 + frr * 64;
    offB[i] = 8192 + ((wn * 64 + i * 32) >> 4) * 1024 + fhi * 1024 + frr * 64;
  }
  const int fsw = (frr >> 2) & 3;
  auto compute = [&](int stg) __attribute__((always_inline)) {
    const char* sb = smem + stg * 16384;
#pragma unroll
    for (int ks = 0; ks < 2; ++ks) {
      const int so = ((ks * 2 + fq) ^ fsw) * 16;
      bf16x8 af[2], bfr[2];
#pragma unroll
      for (int mi = 0; mi < 2; ++mi) af[mi] = *(const bf16x8*)(sb + offA[mi] + so);
#pragma unroll
      for (int ni = 0; ni < 2; ++ni) bfr[ni] = *(const bf16x8*)(sb + offB[ni] + so);
#pragma unroll
      for (int mi = 0; mi < 2; ++mi)
#pragma unroll
        for (int ni = 0; ni < 2; ++ni) acc[mi][ni] = __builtin_amdgcn_mfma_f32_32x32x16_bf16(af[mi], bfr[ni], acc[mi][ni], 0, 0, 0);
    }
  };

  constexpr int KT = K / 32;
  asm volatile("s_waitcnt vmcnt(0)" ::: "memory");
  glds(0);
  glds(1);
  glds(2);
#pragma unroll 1
  for (int kt = 0; kt < KT; ++kt) {
    if (kt <= KT - 3) asm volatile("s_waitcnt vmcnt(8)" ::: "memory");
    else if (kt == KT - 2) asm volatile("s_waitcnt vmcnt(4)" ::: "memory");
    else asm volatile("s_waitcnt vmcnt(0)" ::: "memory");
    asm volatile("s_waitcnt lgkmcnt(0)" ::: "memory");
    __builtin_amdgcn_s_barrier();
    if (kt + 3 < KT) glds(kt + 3);
    compute(kt & 3);
  }
  asm volatile("s_waitcnt lgkmcnt(0)" ::: "memory");
  __builtin_amdgcn_s_barrier();

  if (!EPI) {
    float sacc = 0.f;
#pragma unroll
    for (int a = 0; a < 2; ++a)
#pragma unroll
      for (int b = 0; b < 2; ++b)
#pragma unroll
        for (int i = 0; i < 16; ++i) sacc += acc[a][b][i];
    if (sacc == 12345.678f) p.ctr[8] = 1u;
    return;
  }
  const int h5 = lane >> 5, cl = lane & 31;
  auto each = [&](auto&& f) __attribute__((always_inline)) {
#pragma unroll
    for (int mi = 0; mi < 2; ++mi)
#pragma unroll
      for (int ni = 0; ni < 2; ++ni)
#pragma unroll
        for (int i = 0; i < 16; ++i) {
          const int rl = wm * 64 + mi * 32 + crow(i, h5);
          f(ni, rl, m0 + rl, n0 + wn * 64 + ni * 32 + cl, acc[mi][ni][i]);
        }
  };
  if (MODE == G_PROJ) {
    const int ct = nt;
    if (ct == 10) {
      each([&](int ni, int rl, int row, int col, float v) {
        const int c2 = col - 1280;
        if (c2 < 24) p.glb[(size_t)row * 24 + c2] = sigmoidf_(v);
      });
    } else {
      bf16_t* tl = (bf16_t*)smem;
      if (ct == 6 || ct == 8) {
        each([&](int ni, int rl, int row, int col, float v) {
          if (ni == 0) {
            float other = __shfl_xor(v, 8);
            if (cl < 16) {
              float2 cs = p.rope[(row & 2047) * 8 + (cl & 7)];
              v = (cl < 8) ? (v * cs.x - other * cs.y) : (v * cs.x + other * cs.y);
            }
          }
          tl[rl * 136 + (col - n0)] = f2bf(v);
        });
      } else if ((ct >= 11 && ct < 15) || ct >= 28) {
        each([&](int ni, int rl, int row, int col, float v) { tl[rl * 136 + (col - n0)] = f2bf(siluf_(v)); });
      } else {
        each([&](int ni, int rl, int row, int col, float v) { tl[rl * 136 + (col - n0)] = f2bf(v); });
      }
      __syncthreads();
      if (ct == 7 || ct == 9) {
        bf16_t* d2 = (ct == 7) ? p.vsT : p.vwT;
        const int b = m0 >> 11, s0 = m0 & 2047;
#pragma unroll
        for (int i = 0; i < 8; ++i) {
          const int idx = tid + 256 * i;
          const int c2 = idx & 127, rseg = idx >> 7;
          unsigned short e[8];
#pragma unroll
          for (int j = 0; j < 8; ++j) e[j] = tl[(rseg * 8 + j) * 136 + c2];
          uint4 o;
          o.x = e[0] | ((unsigned)e[1] << 16); o.y = e[2] | ((unsigned)e[3] << 16);
          o.z = e[4] | ((unsigned)e[5] << 16); o.w = e[6] | ((unsigned)e[7] << 16);
          *(uint4*)(d2 + ((size_t)((b * 2 + (c2 >> 6)) * 64 + (c2 & 63))) * VTS + s0 + rseg * 8) = o;
        }
      } else {
        bf16_t* dst;
        int ld, cb;
        if (ct < 4) { dst = p.qb; ld = 512; cb = n0; }
        else if (ct == 4) { dst = p.kcb; ld = LDKC; cb = 0; }
        else if (ct == 5) { dst = p.vcb; ld = LDKC; cb = 0; }
        else if (ct == 6) { dst = p.ksb; ld = 128; cb = 0; }
        else if (ct == 8) { dst = p.kwb; ld = 128; cb = 0; }
        else if (ct < 15) { dst = p.gns; ld = 512; cb = n0 - 1408; }
        else if (ct < 28) { dst = p.rw; ld = 1664; cb = n0 - 1920; }
        else { dst = p.grw; ld = 512; cb = n0 - 3584; }
#pragma unroll
        for (int i = 0; i < 8; ++i) {
          const int idx = tid + 256 * i;
          const int r = idx >> 4, sg = idx & 15;
          const uint4 v4 = *(const uint4*)(tl + r * 136 + sg * 8);
          *(uint4*)(dst + (size_t)(m0 + r) * ld + cb + sg * 8) = v4;
        }
      }
    }
  } else if (MODE == G_CMP1) {
    const float* bias = which ? p.bias1v : p.bias1k;
    bf16_t* hid = which ? p.hidv : p.hidk;
    each([&](int ni, int rl, int row, int col, float v) { hid[(size_t)row * LDHID + col] = f2bf(siluf_(v + bias[col])); });
  } else if (MODE == G_CMP2) {
    each([&](int ni, int rl, int row, int col, float v) {
      if (col < 64) {
        const int b = row >> 8, c = (row >> 1) & 127, g = row & 1;
        const int bg = b * 2 + g;
        bf16_t hv = (c < 127) ? f2bf(v) : (bf16_t)0;
        if (which == 0) {
          p.kcmp[((size_t)bg * 128 + c) * 64 + col] = hv;
        } else {
          p.vcmp[((size_t)bg * 128 + c) * 64 + col] = hv;
          p.vcmpT[((size_t)bg * 64 + col) * 128 + c] = hv;
        }
      }
    });
  } else {
    float xv[2][2][16];
#pragma unroll
    for (int mi = 0; mi < 2; ++mi)
#pragma unroll
      for (int ni = 0; ni < 2; ++ni)
#pragma unroll
        for (int i = 0; i < 16; ++i)
          xv[mi][ni][i] = p.x[(size_t)(m0 + wm * 64 + mi * 32 + crow(i, h5)) * 1024 + n0 + wn * 64 + ni * 32 + cl];
#pragma unroll
    for (int mi = 0; mi < 2; ++mi)
#pragma unroll
      for (int ni = 0; ni < 2; ++ni)
#pragma unroll
        for (int i = 0; i < 16; ++i)
          p.out[(size_t)(m0 + wm * 64 + mi * 32 + crow(i, h5)) * 1024 + n0 + wn * 64 + ni * 32 + cl] = xv[mi][ni][i] + acc[mi][ni][i];
  }
  __syncthreads();
}

DI float shiftv(const Params& p, int tok, int col) {
  float cur = bf2f(p.rw[(size_t)tok * 1664 + col]);
  float prev = (tok & 2047) ? bf2f(p.rw[(size_t)(tok - 1) * 1664 + col]) : 0.f;
  return cur + p.mu[col] * (prev - cur);
}

DI void unpack8(uint4 u, float (&f)[8]) {
  f[0] = __uint_as_float(u.x << 16); f[1] = __uint_as_float(u.x & 0xffff0000u);
  f[2] = __uint_as_float(u.y << 16); f[3] = __uint_as_float(u.y & 0xffff0000u);
  f[4] = __uint_as_float(u.z << 16); f[5] = __uint_as_float(u.z & 0xffff0000u);
  f[6] = __uint_as_float(u.w << 16); f[7] = __uint_as_float(u.w & 0xffff0000u);
}
DI uint4 pack8(const float (&f)[8]) {
  uint4 o;
  o.x = pk2(f[0], f[1]);
  o.y = pk2(f[2], f[3]);
  o.z = pk2(f[4], f[5]);
  o.w = pk2(f[6], f[7]);
  return o;
}
DI void ld8f(const float* ptr, float (&f)[8]) {
  const float4 a = *(const float4*)ptr, b = *(const float4*)(ptr + 4);
  f[0] = a.x; f[1] = a.y; f[2] = a.z; f[3] = a.w; f[4] = b.x; f[5] = b.y; f[6] = b.z; f[7] = b.w;
}
DI void shift8(const Params& p, int tok, int col, float (&o)[8]) {
  float c[8], pv[8], m[8];
  unpack8(*(const uint4*)(p.rw + (size_t)tok * 1664 + col), c);
  uint4 pu = make_uint4(0u, 0u, 0u, 0u);
  if (tok & 2047) pu = *(const uint4*)(p.rw + (size_t)(tok - 1) * 1664 + col);
  unpack8(pu, pv);
  ld8f(p.mu + col, m);
#pragma unroll
  for (int j = 0; j < 8; ++j) o[j] = c[j] + m[j] * (pv[j] - c[j]);
}

__device__ void rwkv_prep_tile(const Params& p, int tile, char* smem) {
  const int t0 = tile * 32;
  bf16_t* sW = (bf16_t*)smem;
  bf16_t* sAd = sW + 32 * 72;
  bf16_t* sA = sAd + 32 * 72;
  const int tid = threadIdx.x, lane = tid & 63, wave = tid >> 6;
#pragma unroll
  for (int i = 0; i < 2; ++i) {
    const int idx = tid + 256 * i, m = idx >> 4, sg = idx & 15;
    float v[8];
    shift8(p, t0 + m, 1536 + sg * 8, v);
    if (sg < 8) {
#pragma unroll
      for (int j = 0; j < 8; ++j) v[j] = tanhf(v[j]);
      *(uint4*)(sW + m * 72 + sg * 8) = pack8(v);
    } else {
      *(uint4*)(sAd + m * 72 + (sg - 8) * 8) = pack8(v);
    }
  }
  __syncthreads();
  const int h5 = lane >> 5, cl = lane & 31;
#pragma unroll 1
  for (int sp = 0; sp < 8; ++sp) {
    const int pass = sp >> 2, ni = sp & 3;
    const bf16_t* As = pass ? sAd : sW;
    const bf16_t* Bt = pass ? p.AupT : p.WupT;
    const int n = wave * 128 + ni * 32 + cl;
    f32x16 acc;
#pragma unroll
    for (int i = 0; i < 16; ++i) acc[i] = 0.f;
#pragma unroll
    for (int ks = 0; ks < 4; ++ks) {
      bf16x8 af = *(const bf16x8*)(As + cl * 72 + ks * 16 + h5 * 8);
      bf16x8 bfr = *(const bf16x8*)(Bt + (size_t)n * 64 + ks * 16 + h5 * 8);
      acc = __builtin_amdgcn_mfma_f32_32x32x16_bf16(af, bfr, acc, 0, 0, 0);
    }
    if (pass == 0) {
      const float w0n = p.w0[n];
#pragma unroll
      for (int i = 0; i < 16; ++i) {
        const int tok = t0 + crow(i, h5);
        const float sg = 1.f / (1.f + __expf(-(w0n + acc[i])));
        p.dec[(size_t)tok * 512 + n] = __expf(-0.6065306597126334f * sg);
      }
    } else {
      const float a0n = p.a0[n];
#pragma unroll
      for (int i = 0; i < 16; ++i) sA[crow(i, h5) * 520 + n] = f2bf(1.f / (1.f + __expf(-(a0n + acc[i]))));
    }
  }
  __syncthreads();
#pragma unroll 1
  for (int i = 0; i < 8; ++i) {
    const int idx = tid + 256 * i, m = idx >> 6, ch0 = (idx & 63) * 8;
    const int tok = t0 + m;
    const size_t o = (size_t)tok * 512 + ch0;
    float rs[8], ks[8], vs[8], a[8], kkc[8], kac[8];
    shift8(p, tok, ch0, rs);
    shift8(p, tok, 512 + ch0, ks);
    shift8(p, tok, 1024 + ch0, vs);
    unpack8(*(const uint4*)(sA + m * 520 + ch0), a);
    ld8f(p.k_k + ch0, kkc);
    ld8f(p.k_a + ch0, kac);
    float kkr[8], ssq = 0.f;
#pragma unroll
    for (int j = 0; j < 8; ++j) { kkr[j] = ks[j] * kkc[j]; ssq += kkr[j] * kkr[j]; }
    ssq += __shfl_xor(ssq, 1);
    ssq += __shfl_xor(ssq, 2);
    ssq += __shfl_xor(ssq, 4);
    const float inv = 1.0f / fmaxf(sqrtf(ssq), 1e-12f);
    float kp[8], bb[8];
#pragma unroll
    for (int j = 0; j < 8; ++j) {
      kkr[j] *= inv;
      kp[j] = ks[j] * (1.f + (a[j] - 1.f) * kac[j]);
      bb[j] = kkr[j] * a[j];
    }
    *(uint4*)(p.rr + o) = pack8(rs);
    *(uint4*)(p.kp + o) = pack8(kp);
    *(uint4*)(p.vv + o) = pack8(vs);
    *(uint4*)(p.kk + o) = pack8(kkr);
    *(uint4*)(p.bb + o) = pack8(bb);
  }
  __syncthreads();
}

constexpr int SCH = 16;
constexpr int SSTR = 336;

__device__ void scan_item(const Params& p, int item, char* smem) {
  const int xcd = item & 7, slot = item >> 3;
  const int bh = xcd * 8 + (slot >> 2), rg = slot & 3;
  const int b = bh >> 3, h = bh & 7, row0 = rg * 16;
  float* buf = (float*)smem;
  float* ybuf = buf + 2 * SCH * SSTR;
  const int tid = threadIdx.x, lane = tid & 63, wave = tid >> 6;
  const int q = lane >> 4, c = lane & 15, lr = wave * 4 + q;
  const size_t tokb = (size_t)b * 2048;

  const bf16_t* ap[2];
  int ast[2], aseg[2], aslot[2];
#pragma unroll
  for (int i = 0; i < 2; ++i) {
    int e = tid + 256 * i;
    int arr = e >> 7;
    ast[i] = (e >> 3) & 15;
    aseg[i] = e & 7;
    ap[i] = arr == 0 ? p.rr : arr == 1 ? p.kp : arr == 2 ? p.kk : p.bb;
    aslot[i] = arr == 0 ? 4 : arr;
  }
  const int dst_ = tid >> 4, dseg = tid & 15;
  const int vst = (tid >> 1) & 15, vseg = tid & 1;
  struct Stage { uint4 g0, g1, gv; float4 gd; };
  auto gload = [&](Stage& S, int ci) {
    const size_t s0 = tokb + (size_t)ci * SCH;
    S.g0 = *(const uint4*)(ap[0] + (s0 + ast[0]) * 512 + h * 64 + aseg[0] * 8);
    S.g1 = *(const uint4*)(ap[1] + (s0 + ast[1]) * 512 + h * 64 + aseg[1] * 8);
    S.gd = *(const float4*)(p.dec + (s0 + dst_) * 512 + h * 64 + dseg * 4);
    if (tid < 32) S.gv = *(const uint4*)(p.vv + (s0 + vst) * 512 + h * 64 + row0 + vseg * 8);
  };
  auto cvt8 = [&](uint4 u, float* d) {
    float4 a, b2;
    a.x = __uint_as_float(u.x << 16); a.y = __uint_as_float(u.x & 0xffff0000u);
    a.z = __uint_as_float(u.y << 16); a.w = __uint_as_float(u.y & 0xffff0000u);
    b2.x = __uint_as_float(u.z << 16); b2.y = __uint_as_float(u.z & 0xffff0000u);
    b2.z = __uint_as_float(u.w << 16); b2.w = __uint_as_float(u.w & 0xffff0000u);
    *(float4*)d = a;
    *(float4*)(d + 4) = b2;
  };
  auto sstore = [&](const Stage& S, int nbuf) {
    float* B = buf + nbuf * SCH * SSTR;
    cvt8(S.g0, B + ast[0] * SSTR + aslot[0] * 64 + aseg[0] * 8);
    cvt8(S.g1, B + ast[1] * SSTR + aslot[1] * 64 + aseg[1] * 8);
    *(float4*)(B + dst_ * SSTR + dseg * 4) = S.gd;
    if (tid < 32) cvt8(S.gv, B + vst * SSTR + 320 + vseg * 8);
  };

  f32x2_t sA = {0.f, 0.f}, sB = {0.f, 0.f};
  auto compute = [&](int ci, int cb) {
    const float* B = buf + cb * SCH * SSTR;
    float* Y = ybuf + cb * 256;
    const float* Lc = B + 4 * c;
    const float* Lv = B + 320 + lr;
    float4 w0_ = *(const float4*)(Lc), k0_ = *(const float4*)(Lc + 64), q0_ = *(const float4*)(Lc + 128),
           b0_ = *(const float4*)(Lc + 192), r0_ = *(const float4*)(Lc + 256);
    float v0_ = Lv[0];
    float4 w1_, k1_, q1_, b1_, r1_;
    float v1_;
    float pp;
    {
      const f32x2_t k0 = {q0_.x, q0_.y}, k1 = {q0_.z, q0_.w};
      f32x2_t pq = sA * k0;
      pq = sB * k1 + pq;
      pp = allred16(pq.x + pq.y);
    }
    float ysel = 0.f;
#define SCAN_STEP(W, K, BV, R, V, NW, NK, NQ, NB, NR, NV, ST)                                          \
  {                                                                                                    \
    if ((ST) + 1 < SCH) {                                                                              \
      NW = *(const float4*)(Lc + ((ST) + 1) * SSTR);                                                   \
      NK = *(const float4*)(Lc + ((ST) + 1) * SSTR + 64);                                              \
      NQ = *(const float4*)(Lc + ((ST) + 1) * SSTR + 128);                                             \
      NB = *(const float4*)(Lc + ((ST) + 1) * SSTR + 192);                                             \
      NR = *(const float4*)(Lc + ((ST) + 1) * SSTR + 256);                                             \
      NV = Lv[((ST) + 1) * SSTR];                                                                      \
    }                                                                                                  \
    const f32x2_t wa = {W.x, W.y}, wb = {W.z, W.w}, ka = {K.x, K.y}, kb = {K.z, K.w}, ba = {BV.x, BV.y}, \
                  bb2 = {BV.z, BV.w}, ra = {R.x, R.y}, rb = {R.z, R.w}, qa = {NQ.x, NQ.y}, qb = {NQ.z, NQ.w}; \
    const f32x2_t msa = {-pp, -pp}, vv2 = {V, V};                                                      \
    const f32x2_t t0 = ba * msa + ka * vv2, t1 = bb2 * msa + kb * vv2;                                 \
    sA = sA * wa + t0;                                                                                 \
    sB = sB * wb + t1;                                                                                 \
    f32x2_t yq = sA * ra;                                                                              \
    yq = sB * rb + yq;                                                                                 \
    f32x2_t pq = sA * qa;                                                                              \
    pq = sB * qb + pq;                                                                                 \
    float ys = yq.x + yq.y, ps = pq.x + pq.y;                                                          \
    ys += dppf<0xB1>(ys);  ps += dppf<0xB1>(ps);                                                       \
    ys += dppf<0x4E>(ys);  ps += dppf<0x4E>(ps);                                                       \
    ys += dppf<0x141>(ys); ps += dppf<0x141>(ps);                                                      \
    ys += dppf<0x128>(ys); ps += dppf<0x128>(ps);                                                      \
    pp = ps;                                                                                           \
    ysel = (c == (ST)) ? ys : ysel;                                                                    \
  }
#pragma unroll 2
    for (int st = 0; st < SCH; st += 2) {
      SCAN_STEP(w0_, k0_, b0_, r0_, v0_, w1_, k1_, q1_, b1_, r1_, v1_, st)
      SCAN_STEP(w1_, k1_, b1_, r1_, v1_, w0_, k0_, q0_, b0_, r0_, v0_, st + 1)
    }
#undef SCAN_STEP
    Y[c * 16 + lr] = ysel;
  };
  auto flush = [&](int ci, int cb) {
    const int st = tid >> 4, rr_ = tid & 15;
    p.yraw[(tokb + (size_t)ci * SCH + st) * 512 + h * 64 + row0 + rr_] = (ybuf + cb * 256)[tid];
  };

  constexpr int NCH = S_ / SCH;
  Stage SA, SB;
  gload(SA, 0);
  gload(SB, 1);
  sstore(SA, 0);
  __syncthreads();
  for (int ci = 0; ci < NCH; ci += 2) {
    if (ci + 2 < NCH) gload(SA, ci + 2);
    compute(ci, 0);
    sstore(SB, 1);
    __syncthreads();
    flush(ci, 0);
    if (ci + 3 < NCH) gload(SB, ci + 3);
    compute(ci + 1, 1);
    if (ci + 2 < NCH) sstore(SA, 0);
    __syncthreads();
    flush(ci + 1, 1);
  }
  __syncthreads();
}

using f32x4 = __attribute__((ext_vector_type(4))) float;
#define MFMA16(a, b, c) __builtin_amdgcn_mfma_f32_16x16x32_bf16((a), (b), (c), 0, 0, 0)
DI float ex2(float x) { return __builtin_amdgcn_exp2f(x); }
constexpr float SCL2 = 0.18033688011112042f;
constexpr float NEGB = -1e30f;

DI unsigned topk8(const float* imp, int tblk) {
  float v[32];
#pragma unroll
  for (int j = 0; j < 32; ++j) {
    float xv = imp[j];
    bool forced = (j == 0) | (j == tblk) | (j == tblk - 1);
    v[j] = (j <= tblk) ? (xv + (forced ? 1000.f : 0.f)) : -1.f;
  }
  unsigned sel = 0;
#pragma unroll
  for (int r = 0; r < 8; ++r) {
    float best = -3e38f;
    int bi = 0;
#pragma unroll
    for (int j = 0; j < 32; ++j) {
      bool ok = (((sel >> j) & 1u) == 0u) && (v[j] > best);
      best = ok ? v[j] : best;
      bi = ok ? j : bi;
    }
    sel |= 1u << bi;
  }
  return sel;
}

DI void head_step(const bf16x8& k00, const bf16x8& k01, const bf16x8& k10, const bf16x8& k11, const bf16x8& v0, const bf16x8& v1,
                  const bf16x8& v2, const bf16x8& v3, const bf16x8& q0, const bf16x8& q1, const float (&bias)[8], f32x4& O0,
                  f32x4& O1, f32x4& O2, f32x4& O3, float& m, float& l) {
  f32x4 sa = {0.f, 0.f, 0.f, 0.f}, sb = {0.f, 0.f, 0.f, 0.f};
  sa = MFMA16(k00, q0, sa);
  sb = MFMA16(k10, q0, sb);
  sa = MFMA16(k01, q1, sa);
  sb = MFMA16(k11, q1, sb);
  float sc[8];
  float cm = -3e38f;
#pragma unroll
  for (int e = 0; e < 8; ++e) {
    sc[e] = fmaf((e < 4) ? sa[e & 3] : sb[e & 3], SCL2, bias[e]);
    cm = fmaxf(cm, sc[e]);
  }
  if (__builtin_amdgcn_ballot_w64(cm > m) != 0ull) {
    cm = fmaxf(cm, __shfl_xor(cm, 16));
    cm = fmaxf(cm, __shfl_xor(cm, 32));
    const float mn = fmaxf(m, cm);
    const float alpha = ex2(m - mn);
    m = mn;
    l *= alpha;
    O0 *= alpha; O1 *= alpha; O2 *= alpha; O3 *= alpha;
  }
  float ps = 0.f;
  float pe[8];
#pragma unroll
  for (int e = 0; e < 8; ++e) {
    pe[e] = ex2(sc[e] - m);
    ps += pe[e];
  }
  l += ps;
  union { unsigned u[4]; bf16x8 v; } pk;
  pk.u[0] = pk2(pe[0], pe[1]); pk.u[1] = pk2(pe[2], pe[3]); pk.u[2] = pk2(pe[4], pe[5]); pk.u[3] = pk2(pe[6], pe[7]);
  O0 = MFMA16(v0, pk.v, O0);
  O1 = MFMA16(v1, pk.v, O1);
  O2 = MFMA16(v2, pk.v, O2);
  O3 = MFMA16(v3, pk.v, O3);
}

template <int MODE>
DI void attend(unsigned long long cmask, const bf16_t* __restrict__ Kb, const bf16_t* __restrict__ VT, const bf16x8* ql, int t,
               int t0, unsigned selmask, int n, int q4, f32x4 (&O)[4][4], float (&m)[4], float (&l)[4]) {
  const int krow = (n >> 2) * 8 + (n & 3);
  const bf16_t* Kl = Kb + (size_t)krow * 128 + q4 * 8;
  const bf16_t* Vl = VT + (size_t)n * VTS + q4 * 8;
  if (!cmask) return;
  int cur = __ffsll(cmask) - 1;
  cmask &= cmask - 1;
  bf16x8 k00, k01, k10, k11;
  {
    const bf16_t* kp_ = Kl + (size_t)cur * 32 * 128;
    k00 = *(const bf16x8*)(kp_); k01 = *(const bf16x8*)(kp_ + 32);
    k10 = *(const bf16x8*)(kp_ + 4 * 128); k11 = *(const bf16x8*)(kp_ + 4 * 128 + 32);
  }
  while (true) {
    int nxt = -1;
    if (cmask) { nxt = __ffsll(cmask) - 1; cmask &= cmask - 1; }
    bf16x8 n00, n01, n10, n11, v0, v1, v2, v3;
    {
      const bf16_t* vp_ = Vl + cur * 32;
      v0 = *(const bf16x8*)(vp_); v1 = *(const bf16x8*)(vp_ + 16 * VTS);
      v2 = *(const bf16x8*)(vp_ + 32 * VTS); v3 = *(const bf16x8*)(vp_ + 48 * VTS);
    }
    if (nxt >= 0) {
      const bf16_t* kp_ = Kl + (size_t)nxt * 32 * 128;
      n00 = *(const bf16x8*)(kp_); n01 = *(const bf16x8*)(kp_ + 32);
      n10 = *(const bf16x8*)(kp_ + 4 * 128); n11 = *(const bf16x8*)(kp_ + 4 * 128 + 32);
    }
    const int kb = cur * 32;
    const int key0 = kb + q4 * 8;
    bool blk = true;
    if (MODE == 1) blk = ((selmask >> (kb >> 6)) & 1u) != 0u;
    float bias[8];
#pragma unroll
    for (int e = 0; e < 8; ++e) {
      const int key = key0 + e;
      bool v = blk && (key <= t);
      if (MODE == 2) v = v && (key + 512 > t);
      bias[e] = v ? 0.f : NEGB;
    }
#pragma unroll
    for (int r = 0; r < 4; ++r) {
      const bf16x8 q0 = ql[(r * 2 + 0) * 64], q1 = ql[(r * 2 + 1) * 64];
      head_step(k00, k01, k10, k11, v0, v1, v2, v3, q0, q1, bias, O[r][0], O[r][1], O[r][2], O[r][3], m[r], l[r]);
      __builtin_amdgcn_sched_barrier(0);
    }
    if (nxt < 0) break;
    k00 = n00; k01 = n01; k10 = n10; k11 = n11;
    cur = nxt;
  }
}

constexpr int NSA_WFLOATS = 16 * 132 + 16 * 32;

__device__ void nsa_wave_item(const Params& p, int item, float* wl) {
  const int lane = threadIdx.x & 63, n = lane & 15, q4 = lane >> 4;
  const int bg = item & 15, tt = item >> 4;
  const int b = bg >> 1, g = bg & 1, t0 = tt * 16, t = t0 + n;
  const size_t tok = (size_t)b * 2048 + t;
  float* impb = wl + 2048;
  bf16x8* ql = (bf16x8*)wl + lane;
  const int krow = (n >> 2) * 8 + (n & 3);

#pragma unroll
  for (int r = 0; r < 4; ++r)
#pragma unroll
    for (int kd = 0; kd < 2; ++kd) ql[(r * 2 + kd) * 64] = *(const bf16x8*)(p.qb + tok * 512 + (g * 4 + r) * 64 + kd * 32 + q4 * 8);
  const float* gatep = p.glb + tok * 24 + g * 12;
  bf16_t* mixl = p.mix + tok * LDH + (g * 4) * 64 + q4 * 4;
  f32x4 Oc[4][4];

  {
    const bf16_t* Kc = p.kcmp + (size_t)bg * 128 * 64;
    const bf16_t* VcT = p.vcmpT + (size_t)bg * 64 * 128;
    const int nch = (t0 + 15 >= 31) ? ((min((t0 + 15 - 31) >> 4, 126) >> 5) + 1) : 0;
#pragma unroll
    for (int e = 0; e < 9; ++e) impb[lane * 9 + e] = 0.f;
    float m[4], l[4];
#pragma unroll
    for (int r = 0; r < 4; ++r) { m[r] = -1e29f; l[r] = 0.f; }
#pragma unroll 1
    for (int ch = 0; ch < nch; ++ch) {
      const int kb = ch * 32;
      bf16x8 kf[2][2];
#pragma unroll
      for (int sub = 0; sub < 2; ++sub)
#pragma unroll
        for (int kd = 0; kd < 2; ++kd) kf[sub][kd] = *(const bf16x8*)(Kc + (size_t)(kb + krow + sub * 4) * 64 + kd * 32 + q4 * 8);
      float bias[8];
#pragma unroll
      for (int e = 0; e < 8; ++e) bias[e] = (16 * (kb + q4 * 8 + e) + 31 <= t) ? 0.f : NEGB;
#pragma unroll
      for (int r = 0; r < 4; ++r) {
        f32x4 sa = {0.f, 0.f, 0.f, 0.f}, sb = {0.f, 0.f, 0.f, 0.f};
#pragma unroll
        for (int kd = 0; kd < 2; ++kd) {
          const bf16x8 qv = ql[(r * 2 + kd) * 64];
          sa = MFMA16(kf[0][kd], qv, sa);
          sb = MFMA16(kf[1][kd], qv, sb);
        }
        float sc[8];
        float cm = -3e38f;
#pragma unroll
        for (int e = 0; e < 8; ++e) {
          sc[e] = fmaf((e < 4) ? sa[e & 3] : sb[e & 3], SCL2, bias[e]);
          cm = fmaxf(cm, sc[e]);
        }
        if (__builtin_amdgcn_ballot_w64(cm > m[r]) != 0ull) {
          cm = fmaxf(cm, __shfl_xor(cm, 16));
          cm = fmaxf(cm, __shfl_xor(cm, 32));
          const float mn = fmaxf(m[r], cm);
          l[r] *= ex2(m[r] - mn);
          m[r] = mn;
        }
        float ps = 0.f;
#pragma unroll
        for (int e = 0; e < 8; ++e) ps += ex2(sc[e] - m[r]);
        l[r] += ps;
        __builtin_amdgcn_sched_barrier(0);
      }
    }
    float inv[4];
#pragma unroll
    for (int r = 0; r < 4; ++r) {
      float lv = l[r];
      lv += __shfl_xor(lv, 16);
      lv += __shfl_xor(lv, 32);
      inv[r] = (lv > 0.f) ? 1.f / lv : 0.f;
    }
#pragma unroll
    for (int dt = 0; dt < 4; ++dt)
#pragma unroll
      for (int r = 0; r < 4; ++r) Oc[dt][r] = f32x4{0.f, 0.f, 0.f, 0.f};
#pragma unroll 1
    for (int ch = 0; ch < nch; ++ch) {
      const int kb = ch * 32;
      bf16x8 kf[2][2];
#pragma unroll
      for (int sub = 0; sub < 2; ++sub)
#pragma unroll
        for (int kd = 0; kd < 2; ++kd) kf[sub][kd] = *(const bf16x8*)(Kc + (size_t)(kb + krow + sub * 4) * 64 + kd * 32 + q4 * 8);
      bf16x8 vf[4];
#pragma unroll
      for (int dt = 0; dt < 4; ++dt) vf[dt] = *(const bf16x8*)(VcT + (size_t)(dt * 16 + n) * 128 + kb + q4 * 8);
      float psm[8], bias[8];
#pragma unroll
      for (int e = 0; e < 8; ++e) {
        psm[e] = 0.f;
        bias[e] = (16 * (kb + q4 * 8 + e) + 31 <= t) ? 0.f : NEGB;
      }
      bf16x8 pf[4];
#pragma unroll
      for (int r = 0; r < 4; ++r) {
        f32x4 sa = {0.f, 0.f, 0.f, 0.f}, sb = {0.f, 0.f, 0.f, 0.f};
#pragma unroll
        for (int kd = 0; kd < 2; ++kd) {
          const bf16x8 qv = ql[(r * 2 + kd) * 64];
          sa = MFMA16(kf[0][kd], qv, sa);
          sb = MFMA16(kf[1][kd], qv, sb);
        }
        float pe[8];
#pragma unroll
        for (int e = 0; e < 8; ++e) {
          pe[e] = ex2(fmaf((e < 4) ? sa[e & 3] : sb[e & 3], SCL2, bias[e]) - m[r]) * inv[r];
          psm[e] += pe[e];
        }
        union { unsigned u[4]; bf16x8 v; } pk;
        pk.u[0] = pk2(pe[0], pe[1]); pk.u[1] = pk2(pe[2], pe[3]); pk.u[2] = pk2(pe[4], pe[5]); pk.u[3] = pk2(pe[6], pe[7]);
        pf[r] = pk.v;
        __builtin_amdgcn_sched_barrier(0);
      }
      {
        float* ip = impb + n * 36 + (kb >> 2) + 2 * q4;
        ip[0] += psm[0] + psm[1] + psm[2] + 0.5f * psm[3];
        __builtin_amdgcn_fence(__ATOMIC_ACQ_REL, "workgroup");
        __builtin_amdgcn_wave_barrier();
        ip[1] += 0.5f * psm[3] + psm[4] + psm[5] + psm[6] + 0.5f * psm[7];
        __builtin_amdgcn_fence(__ATOMIC_ACQ_REL, "workgroup");
        __builtin_amdgcn_wave_barrier();
        ip[2] += 0.5f * psm[7];
        __builtin_amdgcn_fence(__ATOMIC_ACQ_REL, "workgroup");
        __builtin_amdgcn_wave_barrier();
      }
#pragma unroll
      for (int dt = 0; dt < 4; ++dt)
#pragma unroll
        for (int r = 0; r < 4; ++r) Oc[dt][r] = MFMA16(vf[dt], pf[r], Oc[dt][r]);
    }
  }
#pragma unroll
  for (int r = 0; r < 4; ++r) {
    const float gsc = gatep[r * 3 + 0];
#pragma unroll
    for (int dt = 0; dt < 4; ++dt) {
      uint2 o;
      o.x = pk2(Oc[dt][r][0] * gsc, Oc[dt][r][1] * gsc);
      o.y = pk2(Oc[dt][r][2] * gsc, Oc[dt][r][3] * gsc);
      *(uint2*)(mixl + r * 64 + dt * 16) = o;
    }
  }
  __builtin_amdgcn_fence(__ATOMIC_ACQ_REL, "workgroup");
  __builtin_amdgcn_wave_barrier();
  const int tblk = t0 >> 6;
  unsigned selmask = topk8(impb + n * 36, tblk);
  selmask &= (tblk >= 31) ? 0xffffffffu : ((1u << (tblk + 1)) - 1u);
  __builtin_amdgcn_wave_barrier();

#pragma unroll
  for (int r = 0; r < 4; ++r) {
    const bf16x8 q0 = ql[(r * 2 + 0) * 64];
    union { unsigned u[4]; bf16x8 v; } pk;
    float vals[8];
#pragma unroll
    for (int j = 0; j < 8; ++j) {
      float xv = bf2f((bf16_t)q0[j]);
      float ov = __shfl_xor(xv, 16);
      float2 cs = p.rope[t * 8 + j];
      vals[j] = (q4 == 0) ? (xv * cs.x - ov * cs.y) : ((q4 == 1) ? (xv * cs.x + ov * cs.y) : xv);
    }
    pk.u[0] = pk2(vals[0], vals[1]); pk.u[1] = pk2(vals[2], vals[3]); pk.u[2] = pk2(vals[4], vals[5]); pk.u[3] = pk2(vals[6], vals[7]);
    ql[(r * 2 + 0) * 64] = pk.v;
  }

#pragma unroll 1
  for (int br = 1; br <= 2; ++br) {
    unsigned long long cmask = 0ull;
    const int hic = (t0 + 15) >> 5;
    if (br == 1) {
      unsigned any = selmask;
#pragma unroll
      for (int o = 32; o >= 1; o >>= 1) any |= (unsigned)__shfl_xor((int)any, o);
      any = __builtin_amdgcn_readfirstlane(any);
      for (int j = 0; j <= tblk; ++j)
        if ((any >> j) & 1u) cmask |= 3ull << (2 * j);
      if (hic < 63) cmask &= (1ull << (hic + 1)) - 1ull;
    } else {
      const int lo = max(0, t0 - 511) >> 5;
      cmask = (hic < 63) ? ((1ull << (hic + 1)) - 1ull) : ~0ull;
      cmask &= ~((1ull << lo) - 1ull);
    }
    f32x4 O[4][4];
    float m[4], l[4];
#pragma unroll
    for (int dt = 0; dt < 4; ++dt)
#pragma unroll
      for (int r = 0; r < 4; ++r) O[r][dt] = f32x4{0.f, 0.f, 0.f, 0.f};
#pragma unroll
    for (int r = 0; r < 4; ++r) { m[r] = -1e29f; l[r] = 0.f; }
    if (br == 1)
      attend<1>(cmask, p.ksb + (size_t)b * 2048 * 128 + g * 64, p.vsT + (size_t)bg * 64 * VTS, ql, t, t0, selmask, n, q4, O, m, l);
    else
      attend<2>(cmask, p.kwb + (size_t)b * 2048 * 128 + g * 64, p.vwT + (size_t)bg * 64 * VTS, ql, t, t0, selmask, n, q4, O, m, l);
#pragma unroll
    for (int r = 0; r < 4; ++r) {
      float lv = l[r];
      lv += __shfl_xor(lv, 16);
      lv += __shfl_xor(lv, 32);
      const float gsc = gatep[r * 3 + br] * ((lv > 0.f) ? 1.f / lv : 0.f);
#pragma unroll
      for (int dt = 0; dt < 4; ++dt) {
        uint2* mp = (uint2*)(mixl + r * 64 + dt * 16);
        const uint2 u = *mp;
        float a0 = __uint_as_float(u.x << 16) + O[r][dt][0] * gsc, a1 = __uint_as_float(u.x & 0xffff0000u) + O[r][dt][1] * gsc;
        float a2 = __uint_as_float(u.y << 16) + O[r][dt][2] * gsc, a3 = __uint_as_float(u.y & 0xffff0000u) + O[r][dt][3] * gsc;
        if (br == 2) {
          const uint2 gg = *(const uint2*)(p.gns + tok * 512 + (g * 4 + r) * 64 + dt * 16 + q4 * 4);
          a0 *= __uint_as_float(gg.x << 16); a1 *= __uint_as_float(gg.x & 0xffff0000u);
          a2 *= __uint_as_float(gg.y << 16); a3 *= __uint_as_float(gg.y & 0xffff0000u);
        }
        uint2 o;
        o.x = pk2(a0, a1);
        o.y = pk2(a2, a3);
        *mp = o;
      }
    }
  }
}

__device__ void phase_mix_rwkv(const Params& p) {
  int tx = threadIdx.x;
  asm volatile("" : "+v"(tx));
  const int lane = tx & 63, sub = lane >> 4, c = lane & 15;
  const int gw = blockIdx.x * 4 + (tx >> 6), nw = gridDim.x * 4;
  for (int it = gw; it < T_ * 2; it += nw) {
    const int ph = it * 4 + sub;
    const int tok = ph >> 3, h = ph & 7;
    const int ch = h * 64 + c * 4;
    const size_t idx = (size_t)tok * 512 + ch;
    const float4 y = *(const float4*)(p.yraw + idx);
    const float mean = allred16(y.x + y.y + y.z + y.w) * (1.f / 64.f);
    const float d0 = y.x - mean, d1 = y.y - mean, d2 = y.z - mean, d3 = y.w - mean;
    const float var = allred16(d0 * d0 + d1 * d1 + d2 * d2 + d3 * d3) * (1.f / 64.f);
    const float rs = rsqrtf(var + 64e-5f);
    const float4 gw4 = *(const float4*)(p.gn_w + ch), gb4 = *(const float4*)(p.gn_b + ch), rk4 = *(const float4*)(p.r_k + ch);
    const uint2 ru = *(const uint2*)(p.rr + idx), ku = *(const uint2*)(p.kp + idx), vu = *(const uint2*)(p.vv + idx),
                gu = *(const uint2*)(p.grw + idx);
    const float r0 = __uint_as_float(ru.x << 16), r1 = __uint_as_float(ru.x & 0xffff0000u), r2 = __uint_as_float(ru.y << 16),
                r3 = __uint_as_float(ru.y & 0xffff0000u);
    const float k0 = __uint_as_float(ku.x << 16), k1 = __uint_as_float(ku.x & 0xffff0000u), k2 = __uint_as_float(ku.y << 16),
                k3 = __uint_as_float(ku.y & 0xffff0000u);
    const float v0 = __uint_as_float(vu.x << 16), v1 = __uint_as_float(vu.x & 0xffff0000u), v2 = __uint_as_float(vu.y << 16),
                v3 = __uint_as_float(vu.y & 0xffff0000u);
    const float g0 = __uint_as_float(gu.x << 16), g1 = __uint_as_float(gu.x & 0xffff0000u), g2 = __uint_as_float(gu.y << 16),
                g3 = __uint_as_float(gu.y & 0xffff0000u);
    const float bonus = allred16(r0 * k0 * rk4.x + r1 * k1 * rk4.y + r2 * k2 * rk4.z + r3 * k3 * rk4.w);
    uint2 o;
    o.x = pk2((d0 * rs * gw4.x + gb4.x + bonus * v0) * g0, (d1 * rs * gw4.y + gb4.y + bonus * v1) * g1);
    o.y = pk2((d2 * rs * gw4.z + gb4.z + bonus * v2) * g2, (d3 * rs * gw4.w + gb4.w + bonus * v3) * g3);
    *(uint2*)(p.mix + (size_t)tok * LDH + 512 + ch) = o;
  }
}

__device__ void phase_final_norm(const Params& p) {
  int tx = threadIdx.x;
  asm volatile("" : "+v"(tx));
  const int lane = tx & 63;
  const int gw = blockIdx.x * 4 + (tx >> 6), nw = gridDim.x * 4;
  const float4* fg = (const float4*)p.final_g;
  for (int row = gw; row < T_; row += nw) {
    float4* o4 = (float4*)(p.out + (size_t)row * 1024);
    float4 v[4];
    float ss = 0.f;
#pragma unroll
    for (int i = 0; i < 4; ++i) {
      v[i] = o4[i * 64 + lane];
      ss += v[i].x * v[i].x + v[i].y * v[i].y + v[i].z * v[i].z + v[i].w * v[i].w;
    }
    ss = wsum(ss);
    const float sc = rsqrtf(ss * (1.f / 1024.f) + 1e-6f);
#pragma unroll
    for (int i = 0; i < 4; ++i) {
      float4 gq = fg[i * 64 + lane];
      v[i].x *= sc * gq.x; v[i].y *= sc * gq.y; v[i].z *= sc * gq.z; v[i].w *= sc * gq.w;
      o4[i * 64 + lane] = v[i];
    }
  }
}

constexpr int NPHASE = 8;
constexpr int SMEM_BYTES = 65536;

template <int PH> DI void run_phase(const Params& p, char* smem) {
  const int bid = blockIdx.x, nb = gridDim.x;
  if (PH == 0) phase_prep(p, smem);
  if (PH == 1)
    for (int t = bid; t < 128 * 32; t += nb) gemm_tile<G_PROJ>(p, t >> 5, t & 31, 0, smem);
  if (PH == 2)
    if (nb > 128) {
      if (bid < 64) gemm_tile<G_CMP1>(p, (bid & 31) >> 1, bid & 1, bid >> 5, smem);
      else
        for (int t = bid - 64; t < 512; t += nb - 64) rwkv_prep_tile(p, t, smem);
    } else {
      for (int t = bid; t < 512 + 64; t += nb) {
        if (t < 64) gemm_tile<G_CMP1>(p, (t & 31) >> 1, t & 1, t >> 5, smem);
        else rwkv_prep_tile(p, t - 64, smem);
      }
    }
  if (PH == 3) {
    if (nb != 512)
      for (int t = bid; t < 32; t += nb) gemm_tile<G_CMP2>(p, t & 15, 0, t >> 4, smem);
  }
  if (PH == 4) {
    unsigned* flag = p.ctr + 40;
    if (nb == 512 && bid >= 256 && bid < 288) {
      const int t = bid - 256;
      gemm_tile<G_CMP2>(p, t & 15, 0, t >> 4, smem);
      asm volatile("s_waitcnt vmcnt(0)" ::: "memory");
      __syncthreads();
      if (threadIdx.x == 0) {
        __builtin_amdgcn_fence(__ATOMIC_RELEASE, "agent");
        asm volatile("s_waitcnt vmcnt(0)" ::: "memory");
        __hip_atomic_fetch_add(flag, 1u, __ATOMIC_RELAXED, __HIP_MEMORY_SCOPE_AGENT);
      }
    }
    for (int t = bid; t < 256; t += nb) scan_item(p, t, smem);
    if (nb == 512) {
      if (threadIdx.x == 0) {
        while (__hip_atomic_load(flag, __ATOMIC_RELAXED, __HIP_MEMORY_SCOPE_AGENT) < 32u) __builtin_amdgcn_s_sleep(2);
        __builtin_amdgcn_fence(__ATOMIC_ACQUIRE, "agent");
        asm volatile("s_waitcnt vmcnt(0)" ::: "memory");
      }
      __syncthreads();
    }
    float* wl = (float*)smem + (threadIdx.x >> 6) * NSA_WFLOATS;
    while (true) {
      int it = 0;
      if ((threadIdx.x & 63) == 0) it = (int)atomicAdd(p.ctr, 1u);
      it = __builtin_amdgcn_readfirstlane(it);
      if (it >= 2048) break;
      nsa_wave_item(p, (127 - (it >> 4)) * 16 + (it & 15), wl);
    }
  }
  if (PH == 5) phase_mix_rwkv(p);
  if (PH == 6)
    for (int t = bid; t < 128 * 8; t += nb) gemm_tile<G_OUT>(p, t >> 3, t & 7, 0, smem);
  if (PH == 7) phase_final_norm(p);
}

template <int PH> __global__ void __launch_bounds__(256, 2) phk(Params p) {
  __shared__ __attribute__((aligned(16))) char smem[SMEM_BYTES];
  run_phase<PH>(p, smem);
}

#ifndef PROBE_PH
#define PROBE_PH -1
#endif
#define XB_CNT(j) (256 + 64 * (j))
#define XB_SUB(j) (1280 + 64 * (j))
#define XB_GEN(j) (2304 + 64 * (j))
#define XB_TOP 3328
#define XB_TOPGEN 3392
DI unsigned xb_ld(unsigned* q) { return __hip_atomic_load(q, __ATOMIC_RELAXED, __HIP_MEMORY_SCOPE_AGENT); }
DI unsigned xb_add(unsigned* q, unsigned v) { return __hip_atomic_fetch_add(q, v, __ATOMIC_RELAXED, __HIP_MEMORY_SCOPE_AGENT); }
DI unsigned xb_xcc() { return (unsigned)__builtin_amdgcn_s_getreg((3 << 11) | 20) & 0xFu; }
DI void fast_barrier(unsigned* bar) {
  asm volatile("s_waitcnt vmcnt(0)" ::: "memory");
  __syncthreads();
  if (threadIdx.x == 0) {
    const unsigned x = xb_xcc();
    unsigned nloc, nx;
    for (;;) {
      unsigned sum = 0u;
      nloc = 1u;
      nx = 0u;
#pragma unroll
      for (unsigned j = 0; j < 16; ++j) {
        const unsigned c = xb_ld(&bar[XB_CNT(j)]);
        sum += c;
        nx += (c > 0u) ? 1u : 0u;
        nloc = (j == x) ? c : nloc;
      }
      if (sum == gridDim.x) break;
      __builtin_amdgcn_s_sleep(1);
    }
    const unsigned old = xb_add(&bar[XB_SUB(x)], 1u);
    const unsigned gen = old / nloc;
    if (old + 1u == (gen + 1u) * nloc) {
      __builtin_amdgcn_fence(__ATOMIC_RELEASE, "agent");
      asm volatile("s_waitcnt vmcnt(0)" ::: "memory");
      const unsigned og = xb_add(&bar[XB_TOP], 1u);
      const unsigned tg = og / nx;
      if (og + 1u == (tg + 1u) * nx) xb_add(&bar[XB_TOPGEN], 1u);
      else
        while (xb_ld(&bar[XB_TOPGEN]) == tg) __builtin_amdgcn_s_sleep(1);
      __builtin_amdgcn_fence(__ATOMIC_ACQUIRE, "agent");
      xb_add(&bar[XB_GEN(x)], 1u);
      asm volatile("s_waitcnt vmcnt(0)" ::: "memory");
    } else {
      while (xb_ld(&bar[XB_GEN(x)]) == gen) __builtin_amdgcn_s_sleep(1);
      __builtin_amdgcn_fence(__ATOMIC_ACQUIRE, "agent");
      asm volatile("s_waitcnt vmcnt(0)" ::: "memory");
    }
  }
  __syncthreads();
}

__global__ void __launch_bounds__(256, 2) mega(Params p) {
  __shared__ __attribute__((aligned(16))) char smem[SMEM_BYTES];
  cg::grid_group grid = cg::this_grid();
  unsigned* bar = p.xbar;
  const unsigned nblk = gridDim.x;
  if (p.ctr == nullptr) grid.sync();
  if (threadIdx.x == 0) (void)xb_add(&bar[XB_CNT(xb_xcc())], 1u);
  run_phase<0>(p, smem); fast_barrier(bar);
  run_phase<1>(p, smem); fast_barrier(bar);
  run_phase<2>(p, smem); fast_barrier(bar);
  if (nblk != 512u) { run_phase<3>(p, smem); fast_barrier(bar); }
  run_phase<4>(p, smem); fast_barrier(bar);
  run_phase<5>(p, smem); fast_barrier(bar);
  run_phase<6>(p, smem); fast_barrier(bar);
  run_phase<7>(p, smem);
}

extern "C" void kernel_launch(void* const* d_in, const int* in_sizes, int n_in, void* d_out, int out_size, void* d_ws, size_t ws_size,
                              hipStream_t stream) {
  Params p{};
  const float** pin = (const float**)&p;
  for (int i = 0; i < 21; ++i) pin[i] = (const float*)d_in[i];
  p.out = (float*)d_out;
  char* w = (char*)d_ws;
  size_t off = 0;
  auto alloc = [&](size_t bytes) { void* r = w + off; off += (bytes + 255) & ~(size_t)255; return r; };
  p.WinT = (bf16_t*)alloc((size_t)NPAD * LDW * 2);
  p.WoutT = (bf16_t*)alloc((size_t)1024 * LDW * 2);
  p.W1Tk = (bf16_t*)alloc((size_t)256 * LDW1 * 2);
  p.W1Tv = (bf16_t*)alloc((size_t)256 * LDW1 * 2);
  p.W2Tk = (bf16_t*)alloc((size_t)128 * LDW2 * 2);
  p.W2Tv = (bf16_t*)alloc((size_t)128 * LDW2 * 2);
  p.WupT = (bf16_t*)alloc((size_t)512 * 64 * 2);
  p.AupT = (bf16_t*)alloc((size_t)512 * 64 * 2);
  p.bias1k = (float*)alloc(256 * 4);
  p.bias1v = (float*)alloc(256 * 4);
  p.rope = (float2*)alloc((size_t)2048 * 8 * 8);
  p.qb = (bf16_t*)alloc((size_t)T_ * 512 * 2);
  p.kcb = (bf16_t*)alloc((size_t)(T_ + 16) * LDKC * 2);
  p.vcb = (bf16_t*)alloc((size_t)(T_ + 16) * LDKC * 2);
  p.ksb = (bf16_t*)alloc((size_t)T_ * 128 * 2);
  p.kwb = (bf16_t*)alloc((size_t)T_ * 128 * 2);
  p.vsb = nullptr;
  p.vwb = nullptr;
  p.vsT = (bf16_t*)alloc((size_t)16 * 64 * VTS * 2);
  p.vwT = (bf16_t*)alloc((size_t)16 * 64 * VTS * 2);
  p.glb = (float*)alloc((size_t)T_ * 24 * 4);
  p.gns = (bf16_t*)alloc((size_t)T_ * 512 * 2);
  p.rw = (bf16_t*)alloc((size_t)T_ * 1664 * 2);
  p.yraw = (float*)p.rw;
  p.grw = (bf16_t*)alloc((size_t)T_ * 512 * 2);
  p.hidk = (bf16_t*)alloc((size_t)2048 * LDHID * 2);
  p.hidv = (bf16_t*)alloc((size_t)2048 * LDHID * 2);
  p.kcmp = (bf16_t*)alloc((size_t)16 * 128 * 64 * 2);
  p.vcmp = (bf16_t*)alloc((size_t)16 * 128 * 64 * 2);
  p.vcmpT = (bf16_t*)alloc((size_t)16 * 128 * 64 * 2);
  p.rr = (bf16_t*)alloc((size_t)T_ * 512 * 2);
  p.kp = (bf16_t*)alloc((size_t)T_ * 512 * 2);
  p.vv = (bf16_t*)alloc((size_t)T_ * 512 * 2);
  p.mix = (bf16_t*)alloc((size_t)T_ * LDH * 2);
  p.hb = p.mix;
  p.ctr = (unsigned*)alloc(256);
  p.xbar = (unsigned*)alloc(16384);
  p.dec = (float*)d_out;
  p.kk = (bf16_t*)((char*)d_out + (size_t)T_ * 512 * 4);
  p.bb = (bf16_t*)((char*)d_out + (size_t)T_ * 512 * 6);
  if (off > ws_size) {
    fprintf(stderr, "workspace too small: need %zu have %zu\n", off, ws_size);
    return;
  }
#ifdef MULTI_LAUNCH
  hipLaunchKernelGGL(phk<0>, dim3(512), dim3(256), 0, stream, p);
  hipLaunchKernelGGL(phk<1>, dim3(512), dim3(256), 0, stream, p);
  hipLaunchKernelGGL(phk<2>, dim3(512), dim3(256), 0, stream, p);
  hipLaunchKernelGGL(phk<3>, dim3(512), dim3(256), 0, stream, p);
  hipLaunchKernelGGL(phk<4>, dim3(512), dim3(256), 0, stream, p);
  hipLaunchKernelGGL(phk<5>, dim3(512), dim3(256), 0, stream, p);
  hipLaunchKernelGGL(phk<6>, dim3(512), dim3(256), 0, stream, p);
  hipLaunchKernelGGL(phk<7>, dim3(512), dim3(256), 0, stream, p);
#else
  static int grid_blocks = 0;
  if (!grid_blocks) {
    int dev = 0, cus = 0, per_cu = 0;
    hipGetDevice(&dev);
    hipDeviceGetAttribute(&cus, hipDeviceAttributeMultiprocessorCount, dev);
    hipOccupancyMaxActiveBlocksPerMultiprocessor(&per_cu, mega, 256, 0);
    if (per_cu > 2) per_cu = 2;
    if (per_cu < 1) per_cu = 1;
    grid_blocks = cus * per_cu;
  }
  hipMemsetAsync(p.ctr, 0, 256 + 16384, stream);
  void* args[] = {&p};
  hipError_t e = hipLaunchCooperativeKernel((void*)mega, dim3(grid_blocks), dim3(256), args, 0, stream);
  if (e != hipSuccess) fprintf(stderr, "cooperative launch failed: %s (grid %d)\n", hipGetErrorString(e), grid_blocks);
#endif
}
```

```cpp
#include <hip/hip_runtime.h>
#include <hip/hip_bf16.h>
#include <hip/hip_cooperative_groups.h>
#include <cstdio>
namespace cg = cooperative_groups;


typedef unsigned short bf16_t;
using bf16x8 = __attribute__((ext_vector_type(8))) short;
using f32x16 = __attribute__((ext_vector_type(16))) float;

#define DI __device__ __forceinline__

constexpr int T_ = 16384, S_ = 2048;
constexpr int NPAD = 4096;
constexpr int LDH = 1088, LDW = 1088, LDW1 = 2112, LDHID = 320, LDW2 = 320, LDKC = 136, VTS = 2112;

typedef __bf16 bf16x2_t __attribute__((ext_vector_type(2)));
typedef float f32x2_t __attribute__((ext_vector_type(2)));
DI unsigned pk2(float a, float b) {
  f32x2_t v = {a, b};
  return __builtin_bit_cast(unsigned, __builtin_convertvector(v, bf16x2_t));
}
DI bf16_t f2bf(float x) { return (bf16_t)(pk2(x, 0.f) & 0xffffu); }
DI float bf2f(bf16_t b) { return __uint_as_float(((unsigned)b) << 16); }
DI float sigmoidf_(float x) { return 1.f / (1.f + __expf(-x)); }
DI float siluf_(float x) { return x / (1.f + __expf(-x)); }
DI float wsum(float x) {
#pragma unroll
  for (int o = 32; o >= 1; o >>= 1) x += __shfl_xor(x, o);
  return x;
}
DI float wmax(float x) {
#pragma unroll
  for (int o = 32; o >= 1; o >>= 1) x = fmaxf(x, __shfl_xor(x, o));
  return x;
}
template <int CTRL> DI float dppf(float x) {
  return __int_as_float(__builtin_amdgcn_update_dpp(0, __float_as_int(x), CTRL, 0xf, 0xf, true));
}
DI float allred16(float x) {
  x += dppf<0xB1>(x);
  x += dppf<0x4E>(x);
  x += dppf<0x141>(x);
  x += dppf<0x128>(x);
  return x;
}

struct Params {
  const float *x, *norm_g, *w_in, *pos_k, *w1_k, *w2_k, *pos_v, *w1_v, *w2_v, *mu, *w0, *w_up, *a0, *a_up, *k_k, *k_a, *r_k,
      *gn_w, *gn_b, *w_out, *final_g;
  float* out;
  bf16_t *WinT, *WoutT, *W1Tk, *W1Tv, *W2Tk, *W2Tv, *WupT, *AupT;
  float *bias1k, *bias1v;
  float2* rope;
  bf16_t *qb, *kcb, *vcb, *ksb, *kwb, *vsb, *vwb, *vsT, *vwT;
  float* glb;
  bf16_t *gns, *rw, *grw, *hidk, *hidv, *kcmp, *vcmp, *vcmpT;
  bf16_t *rr, *kp, *vv, *kk, *bb;
  float *dec, *yraw;
  bf16_t* mix;
  bf16_t* hb;
  unsigned* ctr;
  unsigned* xbar;
};

DI void transpose_tile(const float* __restrict__ src, int ldsrc, bf16_t* __restrict__ dst, int ldd, int k0, int n0, const float* scale,
                       int mapmode, int nvalid, float* tile) {
  const int tid = threadIdx.x;
#pragma unroll
  for (int i = 0; i < 4; ++i) {
    const int idx = tid + 256 * i, kl = idx >> 4, ng = (idx & 15) * 4;
    const int n = n0 + ng;
    int on;
    if (mapmode == 1) on = (n < 1304) ? n : (n < 1408 ? -1 : n - 104);
    else on = (n < nvalid) ? n : -1;
    float4 v = make_float4(0.f, 0.f, 0.f, 0.f);
    if (on >= 0) {
      v = *(const float4*)(src + (size_t)(k0 + kl) * ldsrc + on);
      if (scale) {
        const float sc = scale[k0 + kl];
        v.x *= sc; v.y *= sc; v.z *= sc; v.w *= sc;
      }
    }
    float* t = tile + kl * 65 + ng;
    t[0] = v.x; t[1] = v.y; t[2] = v.z; t[3] = v.w;
  }
  __syncthreads();
#pragma unroll
  for (int i = 0; i < 2; ++i) {
    const int idx = tid + 256 * i, nl = idx >> 3, kg = (idx & 7) * 8;
    uint4 o;
    o.x = pk2(tile[(kg + 0) * 65 + nl], tile[(kg + 1) * 65 + nl]);
    o.y = pk2(tile[(kg + 2) * 65 + nl], tile[(kg + 3) * 65 + nl]);
    o.z = pk2(tile[(kg + 4) * 65 + nl], tile[(kg + 5) * 65 + nl]);
    o.w = pk2(tile[(kg + 6) * 65 + nl], tile[(kg + 7) * 65 + nl]);
    *(uint4*)(dst + (size_t)(n0 + nl) * ldd + k0 + kg) = o;
  }
  __syncthreads();
}

__device__ void phase_prep(const Params& p, char* smem) {
  float* tile = (float*)smem;
  const int nb = gridDim.x, bid = blockIdx.x, tid = threadIdx.x;
  {
    const int lane = tid & 63;
    for (int row = bid * 4 + (tid >> 6); row < T_; row += nb * 4) {
      const float4* x4 = (const float4*)(p.x + (size_t)row * 1024);
      float4 v[4];
      float ss = 0.f;
#pragma unroll
      for (int i = 0; i < 4; ++i) {
        v[i] = x4[i * 64 + lane];
        ss += v[i].x * v[i].x + v[i].y * v[i].y + v[i].z * v[i].z + v[i].w * v[i].w;
      }
      ss = wsum(ss);
      const float sc = rsqrtf(ss * (1.f / 1024.f) + 1e-6f);
      uint2* h2 = (uint2*)(p.hb + (size_t)row * LDH);
#pragma unroll
      for (int i = 0; i < 4; ++i) {
        uint2 o;
        o.x = pk2(v[i].x * sc, v[i].y * sc);
        o.y = pk2(v[i].z * sc, v[i].w * sc);
        h2[i * 64 + lane] = o;
      }
    }
  }
  const int n_win = 16 * 64, n_wout = 16 * 16, n_w1 = 32 * 4, n_w2 = 4 * 2, n_lora = 1 * 8;
  const int o1 = n_win, o2 = o1 + n_wout, o3 = o2 + n_w1, o4 = o3 + n_w1, o5 = o4 + n_w2, o6 = o5 + n_w2, o7 = o6 + n_lora,
            o8 = o7 + n_lora, o9 = o8 + 128, o10 = o9 + 16;
  for (int it = bid; it < o10; it += nb) {
    if (it < o1) {
      int kt = it & 15, nt = it >> 4;
      transpose_tile(p.w_in, 3992, p.WinT, LDW, kt * 64, nt * 64, p.norm_g, 1, 0, tile);
    } else if (it < o2) {
      int j = it - o1, kt = j & 15, nt = j >> 4;
      transpose_tile(p.w_out, 1024, p.WoutT, LDW, kt * 64, nt * 64, nullptr, 0, 1024, tile);
    } else if (it < o3) {
      int j = it - o2, kt = j & 31, nt = j >> 5;
      transpose_tile(p.w1_k, 256, p.W1Tk, LDW1, kt * 64, nt * 64, nullptr, 0, 256, tile);
    } else if (it < o4) {
      int j = it - o3, kt = j & 31, nt = j >> 5;
      transpose_tile(p.w1_v, 256, p.W1Tv, LDW1, kt * 64, nt * 64, nullptr, 0, 256, tile);
    } else if (it < o5) {
      int j = it - o4, kt = j & 3, nt = j >> 2;
      transpose_tile(p.w2_k, 64, p.W2Tk, LDW2, kt * 64, nt * 64, nullptr, 0, 64, tile);
    } else if (it < o6) {
      int j = it - o5, kt = j & 3, nt = j >> 2;
      transpose_tile(p.w2_v, 64, p.W2Tv, LDW2, kt * 64, nt * 64, nullptr, 0, 64, tile);
    } else if (it < o7) {
      int nt = it - o6;
      transpose_tile(p.w_up, 512, p.WupT, 64, 0, nt * 64, nullptr, 0, 512, tile);
    } else if (it < o8) {
      int nt = it - o7;
      transpose_tile(p.a_up, 512, p.AupT, 64, 0, nt * 64, nullptr, 0, 512, tile);
    } else if (it < o9) {
      const int j = it - o8, which = j >> 6, n0 = (j & 63) * 4;
      const float* pos = which ? p.pos_v : p.pos_k;
      const float* w1 = which ? p.w1_v : p.w1_k;
      float* bo = which ? p.bias1v : p.bias1k;
      const int kp = tid >> 2, nn = tid & 3;
      float a = 0.f;
#pragma unroll 16
      for (int k = kp * 32; k < kp * 32 + 32; ++k) a += pos[k] * w1[(size_t)k * 256 + n0 + nn];
      tile[tid] = a;
      __syncthreads();
      if (tid < 4) {
        float sum = 0.f;
        for (int q = 0; q < 64; ++q) sum += tile[q * 4 + tid];
        bo[n0 + tid] = sum;
      }
      __syncthreads();
    } else {
      int j = it - o9;
      for (int e = tid; e < 1024; e += 256) {
        int idx = j * 1024 + e;
        int pos = idx >> 3, i = idx & 7;
        float inv = powf(500000.0f, -(float)i / 8.0f);
        float ang = (float)pos * inv;
        float sn, cs;
        sincosf(ang, &sn, &cs);
        p.rope[idx] = make_float2(cs, sn);
      }
    }
  }
}

constexpr int LDT = 40;

DI int crow(int i, int h) { return (i & 3) + 8 * (i >> 2) + 4 * h; }

enum { G_PROJ = 0, G_CMP1 = 1, G_CMP2 = 2, G_OUT = 3 };

template <int MODE, bool EPI = true>
__device__ void gemm_tile(const Params& p, int mt, int nt, int which, char* smem) {
  constexpr int K = (MODE == G_PROJ) ? 1024 : (MODE == G_CMP1) ? 2048 : (MODE == G_CMP2) ? 256 : 1024;
  constexpr int LDA = (MODE == G_PROJ) ? LDH : (MODE == G_CMP1) ? LDKC : (MODE == G_CMP2) ? LDHID : LDH;
  constexpr int LDB = (MODE == G_PROJ) ? LDW : (MODE == G_CMP1) ? LDW1 : (MODE == G_CMP2) ? LDW2 : LDW;
  const int tid = threadIdx.x, lane = tid & 63, wave = tid >> 6;
  const int wm = wave >> 1, wn = wave & 1;
  const int m0 = mt * 128, n0 = nt * 128;

  const bf16_t* Bt;
  const bf16_t* Ab;
  if (MODE == G_PROJ) { Bt = p.WinT; Ab = p.hb; }
  else if (MODE == G_CMP1) { Bt = which ? p.W1Tv : p.W1Tk; Ab = which ? p.vcb : p.kcb; }
  else if (MODE == G_CMP2) { Bt = which ? p.W2Tv : p.W2Tk; Ab = which ? p.hidv : p.hidk; }
  else { Bt = p.WoutT; Ab = p.mix; }

  const int lrr = lane >> 2;
  const int lks = (lane & 3) ^ ((lane >> 4) & 3);
  const bf16_t* apA;
  const bf16_t* apB;
  const bf16_t* bpA;
  const bf16_t* bpB;
  {
    const int r0 = m0 + (2 * wave) * 16 + lrr, r1 = r0 + 16;
    size_t a0, a1;
    if (MODE == G_CMP1) {
      a0 = (size_t)(r0 >> 1) * (16 * LDA) + (r0 & 1) * 64;
      a1 = (size_t)(r1 >> 1) * (16 * LDA) + (r1 & 1) * 64;
    } else {
      a0 = (size_t)r0 * LDA;
      a1 = (size_t)r1 * LDA;
    }
    apA = Ab + a0;
    apB = Ab + a1;
    bpA = Bt + (size_t)(n0 + (2 * wave) * 16 + lrr) * LDB + lks * 8;
    bpB = bpA + (size_t)16 * LDB;
  }
  char* ldsw = smem + (2 * wave) * 1024;
  auto glds = [&](int kt) __attribute__((always_inline)) {
    char* st = ldsw + (kt & 3) * 16384;
    const int k_ = kt * 32 + lks * 8;
    const size_t ko_ = (MODE == G_CMP1) ? ((size_t)(k_ >> 6) * LDA + (k_ & 63)) : (size_t)k_;
    __builtin_amdgcn_global_load_lds((const unsigned*)(apA + ko_), (__attribute__((address_space(3))) unsigned*)(st), 16, 0, 0);
    __builtin_amdgcn_global_load_lds((const unsigned*)(apB + ko_), (__attribute__((address_space(3))) unsigned*)(st + 1024), 16, 0, 0);
    __builtin_amdgcn_global_load_lds((const unsigned*)(bpA + kt * 32), (__attribute__((address_space(3))) unsigned*)(st + 8192), 16, 0, 0);
    __builtin_amdgcn_global_load_lds((const unsigned*)(bpB + kt * 32), (__attribute__((address_space(3))) unsigned*)(st + 8192 + 1024), 16, 0, 0);
  };

  f32x16 acc[2][2];
#pragma unroll
  for (int a = 0; a < 2; ++a)
#pragma unroll
    for (int b = 0; b < 2; ++b)
#pragma unroll
      for (int i = 0; i < 16; ++i) acc[a][b][i] = 0.f;

  const int frr = lane & 15, fhi = (lane >> 4) & 1, fq = lane >> 5;
  int offA[2], offB[2];
#pragma unroll
  for (int i = 0; i < 2; ++i) {
    offA[i] = ((wm * 64 + i * 32) >> 4) * 1024 + fhi * 1024 + frr * 64;
    offB[i] = 8192 + ((wn * 64 + i * 32) >> 4) * 1024 + fhi * 1024 + frr * 64;
  }
  const int fsw = (frr >> 2) & 3;
  auto compute = [&](int stg) __attribute__((always_inline)) {
    const char* sb = smem + stg * 16384;
#pragma unroll
    for (int ks = 0; ks < 2; ++ks) {
      const int so = ((ks * 2 + fq) ^ fsw) * 16;
      bf16x8 af[2], bfr[2];
#pragma unroll
      for (int mi = 0; mi < 2; ++mi) af[mi] = *(const bf16x8*)(sb + offA[mi] + so);
#pragma unroll
      for (int ni = 0; ni < 2; ++ni) bfr[ni] = *(const bf16x8*)(sb + offB[ni] + so);
#pragma unroll
      for (int mi = 0; mi < 2; ++mi)
#pragma unroll
        for (int ni = 0; ni < 2; ++ni) acc[mi][ni] = __builtin_amdgcn_mfma_f32_32x32x16_bf16(af[mi], bfr[ni], acc[mi][ni], 0, 0, 0);
    }
  };

  constexpr int KT = K / 32;
  asm volatile("s_waitcnt vmcnt(0)" ::: "memory");
  glds(0);
  glds(1);
  glds(2);
#pragma unroll 1
  for (int kt = 0; kt < KT; ++kt) {
    if (kt <= KT - 3) asm volatile("s_waitcnt vmcnt(8)" ::: "memory");
    else if (kt == KT - 2) asm volatile("s_waitcnt vmcnt(4)" ::: "memory");
    else asm volatile("s_waitcnt vmcnt(0)" ::: "memory");
    asm volatile("s_waitcnt lgkmcnt(0)" ::: "memory");
    __builtin_amdgcn_s_barrier();
    if (kt + 3 < KT) glds(kt + 3);
    compute(kt & 3);
  }
  asm volatile("s_waitcnt lgkmcnt(0)" ::: "memory");
  __builtin_amdgcn_s_barrier();

  if (!EPI) {
    float sacc = 0.f;
#pragma unroll
    for (int a = 0; a < 2; ++a)
#pragma unroll
      for (int b = 0; b < 2; ++b)
#pragma unroll
        for (int i = 0; i < 16; ++i) sacc += acc[a][b][i];
    if (sacc == 12345.678f) p.ctr[8] = 1u;
    return;
  }
  const int h5 = lane >> 5, cl = lane & 31;
  auto each = [&](auto&& f) __attribute__((always_inline)) {
#pragma unroll
    for (int mi = 0; mi < 2; ++mi)
#pragma unroll
      for (int ni = 0; ni < 2; ++ni)
#pragma unroll
        for (int i = 0; i < 16; ++i) {
          const int rl = wm * 64 + mi * 32 + crow(i, h5);
          f(ni, rl, m0 + rl, n0 + wn * 64 + ni * 32 + cl, acc[mi][ni][i]);
        }
  };
  if (MODE == G_PROJ) {
    const int ct = nt;
    if (ct == 10) {
      each([&](int ni, int rl, int row, int col, float v) {
        const int c2 = col - 1280;
        if (c2 < 24) p.glb[(size_t)row * 24 + c2] = sigmoidf_(v);
      });
    } else {
      bf16_t* tl = (bf16_t*)smem;
      if (ct == 6 || ct == 8) {
        each([&](int ni, int rl, int row, int col, float v) {
          if (ni == 0) {
            float other = __shfl_xor(v, 8);
            if (cl < 16) {
              float2 cs = p.rope[(row & 2047) * 8 + (cl & 7)];
              v = (cl < 8) ? (v * cs.x - other * cs.y) : (v * cs.x + other * cs.y);
            }
          }
          tl[rl * 136 + (col - n0)] = f2bf(v);
        });
      } else if ((ct >= 11 && ct < 15) || ct >= 28) {
        each([&](int ni, int rl, int row, int col, float v) { tl[rl * 136 + (col - n0)] = f2bf(siluf_(v)); });
      } else {
        each([&](int ni, int rl, int row, int col, float v) { tl[rl * 136 + (col - n0)] = f2bf(v); });
      }
      __syncthreads();
      if (ct == 7 || ct == 9) {
        bf16_t* d2 = (ct == 7) ? p.vsT : p.vwT;
        const int b = m0 >> 11, s0 = m0 & 2047;
#pragma unroll
        for (int i = 0; i < 8; ++i) {
          const int idx = tid + 256 * i;
          const int c2 = idx & 127, rseg = idx >> 7;
          unsigned short e[8];
#pragma unroll
          for (int j = 0; j < 8; ++j) e[j] = tl[(rseg * 8 + j) * 136 + c2];
          uint4 o;
          o.x = e[0] | ((unsigned)e[1] << 16); o.y = e[2] | ((unsigned)e[3] << 16);
          o.z = e[4] | ((unsigned)e[5] << 16); o.w = e[6] | ((unsigned)e[7] << 16);
          *(uint4*)(d2 + ((size_t)((b * 2 + (c2 >> 6)) * 64 + (c2 & 63))) * VTS + s0 + rseg * 8) = o;
        }
      } else {
        bf16_t* dst;
        int ld, cb;
        if (ct < 4) { dst = p.qb; ld = 512; cb = n0; }
        else if (ct == 4) { dst = p.kcb; ld = LDKC; cb = 0; }
        else if (ct == 5) { dst = p.vcb; ld = LDKC; cb = 0; }
        else if (ct == 6) { dst = p.ksb; ld = 128; cb = 0; }
        else if (ct == 8) { dst = p.kwb; ld = 128; cb = 0; }
        else if (ct < 15) { dst = p.gns; ld = 512; cb = n0 - 1408; }
        else if (ct < 28) { dst = p.rw; ld = 1664; cb = n0 - 1920; }
        else { dst = p.grw; ld = 512; cb = n0 - 3584; }
#pragma unroll
        for (int i = 0; i < 8; ++i) {
          const int idx = tid + 256 * i;
          const int r = idx >> 4, sg = idx & 15;
          const uint4 v4 = *(const uint4*)(tl + r * 136 + sg * 8);
          *(uint4*)(dst + (size_t)(m0 + r) * ld + cb + sg * 8) = v4;
        }
      }
    }
  } else if (MODE == G_CMP1) {
    const float* bias = which ? p.bias1v : p.bias1k;
    bf16_t* hid = which ? p.hidv : p.hidk;
    each([&](int ni, int rl, int row, int col, float v) { hid[(size_t)row * LDHID + col] = f2bf(siluf_(v + bias[col])); });
  } else if (MODE == G_CMP2) {
    each([&](int ni, int rl, int row, int col, float v) {
      if (col < 64) {
        const int b = row >> 8, c = (row >> 1) & 127, g = row & 1;
        const int bg = b * 2 + g;
        bf16_t hv = (c < 127) ? f2bf(v) : (bf16_t)0;
        if (which == 0) {
          p.kcmp[((size_t)bg * 128 + c) * 64 + col] = hv;
        } else {
          p.vcmp[((size_t)bg * 128 + c) * 64 + col] = hv;
          p.vcmpT[((size_t)bg * 64 + col) * 128 + c] = hv;
        }
      }
    });
  } else {
    float xv[2][2][16];
#pragma unroll
    for (int mi = 0; mi < 2; ++mi)
#pragma unroll
      for (int ni = 0; ni < 2; ++ni)
#pragma unroll
        for (int i = 0; i < 16; ++i)
          xv[mi][ni][i] = p.x[(size_t)(m0 + wm * 64 + mi * 32 + crow(i, h5)) * 1024 + n0 + wn * 64 + ni * 32 + cl];
#pragma unroll
    for (int mi = 0; mi < 2; ++mi)
#pragma unroll
      for (int ni = 0; ni < 2; ++ni)
#pragma unroll
        for (int i = 0; i < 16; ++i)
          p.out[(size_t)(m0 + wm * 64 + mi * 32 + crow(i, h5)) * 1024 + n0 + wn * 64 + ni * 32 + cl] = xv[mi][ni][i] + acc[mi][ni][i];
  }
  __syncthreads();
}

DI float shiftv(const Params& p, int tok, int col) {
  float cur = bf2f(p.rw[(size_t)tok * 1664 + col]);
  float prev = (tok & 2047) ? bf2f(p.rw[(size_t)(tok - 1) * 1664 + col]) : 0.f;
  return cur + p.mu[col] * (prev - cur);
}

DI void unpack8(uint4 u, float (&f)[8]) {
  f[0] = __uint_as_float(u.x << 16); f[1] = __uint_as_float(u.x & 0xffff0000u);
  f[2] = __uint_as_float(u.y << 16); f[3] = __uint_as_float(u.y & 0xffff0000u);
  f[4] = __uint_as_float(u.z << 16); f[5] = __uint_as_float(u.z & 0xffff0000u);
  f[6] = __uint_as_float(u.w << 16); f[7] = __uint_as_float(u.w & 0xffff0000u);
}
DI uint4 pack8(const float (&f)[8]) {
  uint4 o;
  o.x = pk2(f[0], f[1]);
  o.y = pk2(f[2], f[3]);
  o.z = pk2(f[4], f[5]);
  o.w = pk2(f[6], f[7]);
  return o;
}
DI void ld8f(const float* ptr, float (&f)[8]) {
  const float4 a = *(const float4*)ptr, b = *(const float4*)(ptr + 4);
  f[0] = a.x; f[1] = a.y; f[2] = a.z; f[3] = a.w; f[4] = b.x; f[5] = b.y; f[6] = b.z; f[7] = b.w;
}
DI void shift8(const Params& p, int tok, int col, float (&o)[8]) {
  float c[8], pv[8], m[8];
  unpack8(*(const uint4*)(p.rw + (size_t)tok * 1664 + col), c);
  uint4 pu = make_uint4(0u, 0u, 0u, 0u);
  if (tok & 2047) pu = *(const uint4*)(p.rw + (size_t)(tok - 1) * 1664 + col);
  unpack8(pu, pv);
  ld8f(p.mu + col, m);
#pragma unroll
  for (int j = 0; j < 8; ++j) o[j] = c[j] + m[j] * (pv[j] - c[j]);
}

__device__ void rwkv_prep_tile(const Params& p, int tile, char* smem) {
  const int t0 = tile * 32;
  bf16_t* sW = (bf16_t*)smem;
  bf16_t* sAd = sW + 32 * 72;
  bf16_t* sA = sAd + 32 * 72;
  const int tid = threadIdx.x, lane = tid & 63, wave = tid >> 6;
#pragma unroll
  for (int i = 0; i < 2; ++i) {
    const int idx = tid + 256 * i, m = idx >> 4, sg = idx & 15;
    float v[8];
    shift8(p, t0 + m, 1536 + sg * 8, v);
    if (sg < 8) {
#pragma unroll
      for (int j = 0; j < 8; ++j) v[j] = tanhf(v[j]);
      *(uint4*)(sW + m * 72 + sg * 8) = pack8(v);
    } else {
      *(uint4*)(sAd + m * 72 + (sg - 8) * 8) = pack8(v);
    }
  }
  __syncthreads();
  const int h5 = lane >> 5, cl = lane & 31;
#pragma unroll 1
  for (int sp = 0; sp < 8; ++sp) {
    const int pass = sp >> 2, ni = sp & 3;
    const bf16_t* As = pass ? sAd : sW;
    const bf16_t* Bt = pass ? p.AupT : p.WupT;
    const int n = wave * 128 + ni * 32 + cl;
    f32x16 acc;
#pragma unroll
    for (int i = 0; i < 16; ++i) acc[i] = 0.f;
#pragma unroll
    for (int ks = 0; ks < 4; ++ks) {
      bf16x8 af = *(const bf16x8*)(As + cl * 72 + ks * 16 + h5 * 8);
      bf16x8 bfr = *(const bf16x8*)(Bt + (size_t)n * 64 + ks * 16 + h5 * 8);
      acc = __builtin_amdgcn_mfma_f32_32x32x16_bf16(af, bfr, acc, 0, 0, 0);
    }
    if (pass == 0) {
      const float w0n = p.w0[n];
#pragma unroll
      for (int i = 0; i < 16; ++i) {
        const int tok = t0 + crow(i, h5);
        const float sg = 1.f / (1.f + __expf(-(w0n + acc[i])));
        p.dec[(size_t)tok * 512 + n] = __expf(-0.6065306597126334f * sg);
      }
    } else {
      const float a0n = p.a0[n];
#pragma unroll
      for (int i = 0; i < 16; ++i) sA[crow(i, h5) * 520 + n] = f2bf(1.f / (1.f + __expf(-(a0n + acc[i]))));
    }
  }
  __syncthreads();
#pragma unroll 1
  for (int i = 0; i < 8; ++i) {
    const int idx = tid + 256 * i, m = idx >> 6, ch0 = (idx & 63) * 8;
    const int tok = t0 + m;
    const size_t o = (size_t)tok * 512 + ch0;
    float rs[8], ks[8], vs[8], a[8], kkc[8], kac[8];
    shift8(p, tok, ch0, rs);
    shift8(p, tok, 512 + ch0, ks);
    shift8(p, tok, 1024 + ch0, vs);
    unpack8(*(const uint4*)(sA + m * 520 + ch0), a);
    ld8f(p.k_k + ch0, kkc);
    ld8f(p.k_a + ch0, kac);
    float kkr[8], ssq = 0.f;
#pragma unroll
    for (int j = 0; j < 8; ++j) { kkr[j] = ks[j] * kkc[j]; ssq += kkr[j] * kkr[j]; }
    ssq += __shfl_xor(ssq, 1);
    ssq += __shfl_xor(ssq, 2);
    ssq += __shfl_xor(ssq, 4);
    const float inv = 1.0f / fmaxf(sqrtf(ssq), 1e-12f);
    float kp[8], bb[8];
#pragma unroll
    for (int j = 0; j < 8; ++j) {
      kkr[j] *= inv;
      kp[j] = ks[j] * (1.f + (a[j] - 1.f) * kac[j]);
      bb[j] = kkr[j] * a[j];
    }
    *(uint4*)(p.rr + o) = pack8(rs);
    *(uint4*)(p.kp + o) = pack8(kp);
    *(uint4*)(p.vv + o) = pack8(vs);
    *(uint4*)(p.kk + o) = pack8(kkr);
    *(uint4*)(p.bb + o) = pack8(bb);
  }
  __syncthreads();
}

constexpr int SCH = 16;
constexpr int SSTR = 336;

__device__ void scan_item(const Params& p, int item, char* smem) {
  const int xcd = item & 7, slot = item >> 3;
  const int bh = xcd * 8 + (slot >> 2), rg = slot & 3;
  const int b = bh >> 3, h = bh & 7, row0 = rg * 16;
  float* buf = (float*)smem;
  float* ybuf = buf + 2 * SCH * SSTR;
  const int tid = threadIdx.x, lane = tid & 63, wave = tid >> 6;
  const int q = lane >> 4, c = lane & 15, lr = wave * 4 + q;
  const size_t tokb = (size_t)b * 2048;

  const bf16_t* ap[2];
  int ast[2], aseg[2], aslot[2];
#pragma unroll
  for (int i = 0; i < 2; ++i) {
    int e = tid + 256 * i;
    int arr = e >> 7;
    ast[i] = (e >> 3) & 15;
    aseg[i] = e & 7;
    ap[i] = arr == 0 ? p.rr : arr == 1 ? p.kp : arr == 2 ? p.kk : p.bb;
    aslot[i] = arr == 0 ? 4 : arr;
  }
  const int dst_ = tid >> 4, dseg = tid & 15;
  const int vst = (tid >> 1) & 15, vseg = tid & 1;
  struct Stage { uint4 g0, g1, gv; float4 gd; };
  auto gload = [&](Stage& S, int ci) {
    const size_t s0 = tokb + (size_t)ci * SCH;
    S.g0 = *(const uint4*)(ap[0] + (s0 + ast[0]) * 512 + h * 64 + aseg[0] * 8);
    S.g1 = *(const uint4*)(ap[1] + (s0 + ast[1]) * 512 + h * 64 + aseg[1] * 8);
    S.gd = *(const float4*)(p.dec + (s0 + dst_) * 512 + h * 64 + dseg * 4);
    if (tid < 32) S.gv = *(const uint4*)(p.vv + (s0 + vst) * 512 + h * 64 + row0 + vseg * 8);
  };
  auto cvt8 = [&](uint4 u, float* d) {
    float4 a, b2;
    a.x = __uint_as_float(u.x << 16); a.y = __uint_as_float(u.x & 0xffff0000u);
    a.z = __uint_as_float(u.y << 16); a.w = __uint_as_float(u.y & 0xffff0000u);
    b2.x = __uint_as_float(u.z << 16); b2.y = __uint_as_float(u.z & 0xffff0000u);
    b2.z = __uint_as_float(u.w << 16); b2.w = __uint_as_float(u.w & 0xffff0000u);
    *(float4*)d = a;
    *(float4*)(d + 4) = b2;
  };
  auto sstore = [&](const Stage& S, int nbuf) {
    float* B = buf + nbuf * SCH * SSTR;
    cvt8(S.g0, B + ast[0] * SSTR + aslot[0] * 64 + aseg[0] * 8);
    cvt8(S.g1, B + ast[1] * SSTR + aslot[1] * 64 + aseg[1] * 8);
    *(float4*)(B + dst_ * SSTR + dseg * 4) = S.gd;
    if (tid < 32) cvt8(S.gv, B + vst * SSTR + 320 + vseg * 8);
  };

  f32x2_t sA = {0.f, 0.f}, sB = {0.f, 0.f};
  auto compute = [&](int ci, int cb) {
    const float* B = buf + cb * SCH * SSTR;
    float* Y = ybuf + cb * 256;
    const float* Lc = B + 4 * c;
    const float* Lv = B + 320 + lr;
    float4 w0_ = *(const float4*)(Lc), k0_ = *(const float4*)(Lc + 64), q0_ = *(const float4*)(Lc + 128),
           b0_ = *(const float4*)(Lc + 192), r0_ = *(const float4*)(Lc + 256);
    float v0_ = Lv[0];
    float4 w1_, k1_, q1_, b1_, r1_;
    float v1_;
    float pp;
    {
      const f32x2_t k0 = {q0_.x, q0_.y}, k1 = {q0_.z, q0_.w};
      f32x2_t pq = sA * k0;
      pq = sB * k1 + pq;
      pp = allred16(pq.x + pq.y);
    }
    float ysel = 0.f;
#define SCAN_STEP(W, K, BV, R, V, NW, NK, NQ, NB, NR, NV, ST)                                          \
  {                                                                                                    \
    if ((ST) + 1 < SCH) {                                                                              \
      NW = *(const float4*)(Lc + ((ST) + 1) * SSTR);                                                   \
      NK = *(const float4*)(Lc + ((ST) + 1) * SSTR + 64);                                              \
      NQ = *(const float4*)(Lc + ((ST) + 1) * SSTR + 128);                                             \
      NB = *(const float4*)(Lc + ((ST) + 1) * SSTR + 192);                                             \
      NR = *(const float4*)(Lc + ((ST) + 1) * SSTR + 256);                                             \
      NV = Lv[((ST) + 1) * SSTR];                                                                      \
    }                                                                                                  \
    const f32x2_t wa = {W.x, W.y}, wb = {W.z, W.w}, ka = {K.x, K.y}, kb = {K.z, K.w}, ba = {BV.x, BV.y}, \
                  bb2 = {BV.z, BV.w}, ra = {R.x, R.y}, rb = {R.z, R.w}, qa = {NQ.x, NQ.y}, qb = {NQ.z, NQ.w}; \
    const f32x2_t msa = {-pp, -pp}, vv2 = {V, V};                                                      \
    const f32x2_t t0 = ba * msa + ka * vv2, t1 = bb2 * msa + kb * vv2;                                 \
    sA = sA * wa + t0;                                                                                 \
    sB = sB * wb + t1;                                                                                 \
    f32x2_t yq = sA * ra;                                                                              \
    yq = sB * rb + yq;                                                                                 \
    f32x2_t pq = sA * qa;                                                                              \
    pq = sB * qb + pq;                                                                                 \
    float ys = yq.x + yq.y, ps = pq.x + pq.y;                                                          \
    ys += dppf<0xB1>(ys);  ps += dppf<0xB1>(ps);                                                       \
    ys += dppf<0x4E>(ys);  ps += dppf<0x4E>(ps);                                                       \
    ys += dppf<0x141>(ys); ps += dppf<0x141>(ps);                                                      \
    ys += dppf<0x128>(ys); ps += dppf<0x128>(ps);                                                      \
    pp = ps;                                                                                           \
    ysel = (c == (ST)) ? ys : ysel;                                                                    \
  }
#pragma unroll 2
    for (int st = 0; st < SCH; st += 2) {
      SCAN_STEP(w0_, k0_, b0_, r0_, v0_, w1_, k1_, q1_, b1_, r1_, v1_, st)
      SCAN_STEP(w1_, k1_, b1_, r1_, v1_, w0_, k0_, q0_, b0_, r0_, v0_, st + 1)
    }
#undef SCAN_STEP
    Y[c * 16 + lr] = ysel;
  };
  auto flush = [&](int ci, int cb) {
    const int st = tid >> 4, rr_ = tid & 15;
    p.yraw[(tokb + (size_t)ci * SCH + st) * 512 + h * 64 + row0 + rr_] = (ybuf + cb * 256)[tid];
  };

  constexpr int NCH = S_ / SCH;
  Stage SA, SB;
  gload(SA, 0);
  gload(SB, 1);
  sstore(SA, 0);
  __syncthreads();
  for (int ci = 0; ci < NCH; ci += 2) {
    if (ci + 2 < NCH) gload(SA, ci + 2);
    compute(ci, 0);
    sstore(SB, 1);
    __syncthreads();
    flush(ci, 0);
    if (ci + 3 < NCH) gload(SB, ci + 3);
    compute(ci + 1, 1);
    if (ci + 2 < NCH) sstore(SA, 0);
    __syncthreads();
    flush(ci + 1, 1);
  }
  __syncthreads();
}

using f32x4 = __attribute__((ext_vector_type(4))) float;
#define MFMA16(a, b, c) __builtin_amdgcn_mfma_f32_16x16x32_bf16((a), (b), (c), 0, 0, 0)
DI float ex2(float x) { return __builtin_amdgcn_exp2f(x); }
constexpr float SCL2 = 0.18033688011112042f;
constexpr float NEGB = -1e30f;

DI unsigned topk8(const float* imp, int tblk) {
  float v[32];
#pragma unroll
  for (int j = 0; j < 32; ++j) {
    float xv = imp[j];
    bool forced = (j == 0) | (j == tblk) | (j == tblk - 1);
    v[j] = (j <= tblk) ? (xv + (forced ? 1000.f : 0.f)) : -1.f;
  }
  unsigned sel = 0;
#pragma unroll
  for (int r = 0; r < 8; ++r) {
    float best = -3e38f;
    int bi = 0;
#pragma unroll
    for (int j = 0; j < 32; ++j) {
      bool ok = (((sel >> j) & 1u) == 0u) && (v[j] > best);
      best = ok ? v[j] : best;
      bi = ok ? j : bi;
    }
    sel |= 1u << bi;
  }
  return sel;
}

DI void head_step(const bf16x8& k00, const bf16x8& k01, const bf16x8& k10, const bf16x8& k11, const bf16x8& v0, const bf16x8& v1,
                  const bf16x8& v2, const bf16x8& v3, const bf16x8& q0, const bf16x8& q1, const float (&bias)[8], f32x4& O0,
                  f32x4& O1, f32x4& O2, f32x4& O3, float& m, float& l) {
  f32x4 sa = {0.f, 0.f, 0.f, 0.f}, sb = {0.f, 0.f, 0.f, 0.f};
  sa = MFMA16(k00, q0, sa);
  sb = MFMA16(k10, q0, sb);
  sa = MFMA16(k01, q1, sa);
  sb = MFMA16(k11, q1, sb);
  float sc[8];
  float cm = -3e38f;
#pragma unroll
  for (int e = 0; e < 8; ++e) {
    sc[e] = fmaf((e < 4) ? sa[e & 3] : sb[e & 3], SCL2, bias[e]);
    cm = fmaxf(cm, sc[e]);
  }
  if (__builtin_amdgcn_ballot_w64(cm > m) != 0ull) {
    cm = fmaxf(cm, __shfl_xor(cm, 16));
    cm = fmaxf(cm, __shfl_xor(cm, 32));
    const float mn = fmaxf(m, cm);
    const float alpha = ex2(m - mn);
    m = mn;
    l *= alpha;
    O0 *= alpha; O1 *= alpha; O2 *= alpha; O3 *= alpha;
  }
  float ps = 0.f;
  float pe[8];
#pragma unroll
  for (int e = 0; e < 8; ++e) {
    pe[e] = ex2(sc[e] - m);
    ps += pe[e];
  }
  l += ps;
  union { unsigned u[4]; bf16x8 v; } pk;
  pk.u[0] = pk2(pe[0], pe[1]); pk.u[1] = pk2(pe[2], pe[3]); pk.u[2] = pk2(pe[4], pe[5]); pk.u[3] = pk2(pe[6], pe[7]);
  O0 = MFMA16(v0, pk.v, O0);
  O1 = MFMA16(v1, pk.v, O1);
  O2 = MFMA16(v2, pk.v, O2);
  O3 = MFMA16(v3, pk.v, O3);
}

template <int MODE>
DI void attend(unsigned long long cmask, const bf16_t* __restrict__ Kb, const bf16_t* __restrict__ VT, const bf16x8* ql, int t,
               int t0, unsigned selmask, int n, int q4, f32x4 (&O)[4][4], float (&m)[4], float (&l)[4]) {
  const int krow = (n >> 2) * 8 + (n & 3);
  const bf16_t* Kl = Kb + (size_t)krow * 128 + q4 * 8;
  const bf16_t* Vl = VT + (size_t)n * VTS + q4 * 8;
  if (!cmask) return;
  int cur = __ffsll(cmask) - 1;
  cmask &= cmask - 1;
  bf16x8 k00, k01, k10, k11;
  {
    const bf16_t* kp_ = Kl + (size_t)cur * 32 * 128;
    k00 = *(const bf16x8*)(kp_); k01 = *(const bf16x8*)(kp_ + 32);
    k10 = *(const bf16x8*)(kp_ + 4 * 128); k11 = *(const bf16x8*)(kp_ + 4 * 128 + 32);
  }
  while (true) {
    int nxt = -1;
    if (cmask) { nxt = __ffsll(cmask) - 1; cmask &= cmask - 1; }
    bf16x8 n00, n01, n10, n11, v0, v1, v2, v3;
    {
      const bf16_t* vp_ = Vl + cur * 32;
      v0 = *(const bf16x8*)(vp_); v1 = *(const bf16x8*)(vp_ + 16 * VTS);
      v2 = *(const bf16x8*)(vp_ + 32 * VTS); v3 = *(const bf16x8*)(vp_ + 48 * VTS);
    }
    if (nxt >= 0) {
      const bf16_t* kp_ = Kl + (size_t)nxt * 32 * 128;
      n00 = *(const bf16x8*)(kp_); n01 = *(const bf16x8*)(kp_ + 32);
      n10 = *(const bf16x8*)(kp_ + 4 * 128); n11 = *(const bf16x8*)(kp_ + 4 * 128 + 32);
    }
    const int kb = cur * 32;
    const int key0 = kb + q4 * 8;
    bool blk = true;
    if (MODE == 1) blk = ((selmask >> (kb >> 6)) & 1u) != 0u;
    float bias[8];
#pragma unroll
    for (int e = 0; e < 8; ++e) {
      const int key = key0 + e;
      bool v = blk && (key <= t);
      if (MODE == 2) v = v && (key + 512 > t);
      bias[e] = v ? 0.f : NEGB;
    }
#pragma unroll
    for (int r = 0; r < 4; ++r) {
      const bf16x8 q0 = ql[(r * 2 + 0) * 64], q1 = ql[(r * 2 + 1) * 64];
      head_step(k00, k01, k10, k11, v0, v1, v2, v3, q0, q1, bias, O[r][0], O[r][1], O[r][2], O[r][3], m[r], l[r]);
      __builtin_amdgcn_sched_barrier(0);
    }
    if (nxt < 0) break;
    k00 = n00; k01 = n01; k10 = n10; k11 = n11;
    cur = nxt;
  }
}

constexpr int NSA_WFLOATS = 16 * 132 + 16 * 32;

__device__ void nsa_wave_item(const Params& p, int item, float* wl) {
  const int lane = threadIdx.x & 63, n = lane & 15, q4 = lane >> 4;
  const int bg = item & 15, tt = item >> 4;
  const int b = bg >> 1, g = bg & 1, t0 = tt * 16, t = t0 + n;
  const size_t tok = (size_t)b * 2048 + t;
  float* impb = wl + 2048;
  bf16x8* ql = (bf16x8*)wl + lane;
  const int krow = (n >> 2) * 8 + (n & 3);

#pragma unroll
  for (int r = 0; r < 4; ++r)
#pragma unroll
    for (int kd = 0; kd < 2; ++kd) ql[(r * 2 + kd) * 64] = *(const bf16x8*)(p.qb + tok * 512 + (g * 4 + r) * 64 + kd * 32 + q4 * 8);
  const float* gatep = p.glb + tok * 24 + g * 12;
  bf16_t* mixl = p.mix + tok * LDH + (g * 4) * 64 + q4 * 4;
  f32x4 Oc[4][4];

  {
    const bf16_t* Kc = p.kcmp + (size_t)bg * 128 * 64;
    const bf16_t* VcT = p.vcmpT + (size_t)bg * 64 * 128;
    const int nch = (t0 + 15 >= 31) ? ((min((t0 + 15 - 31) >> 4, 126) >> 5) + 1) : 0;
#pragma unroll
    for (int e = 0; e < 9; ++e) impb[lane * 9 + e] = 0.f;
    float m[4], l[4];
#pragma unroll
    for (int r = 0; r < 4; ++r) { m[r] = NEGB; l[r] = 0.f; }
#pragma unroll 1
    for (int ch = 0; ch < nch; ++ch) {
      const int kb = ch * 32;
      bf16x8 kf[2][2];
#pragma unroll
      for (int sub = 0; sub < 2; ++sub)
#pragma unroll
        for (int kd = 0; kd < 2; ++kd) kf[sub][kd] = *(const bf16x8*)(Kc + (size_t)(kb + krow + sub * 4) * 64 + kd * 32 + q4 * 8);
#pragma unroll
      for (int r = 0; r < 4; ++r) {
        f32x4 sa = {0.f, 0.f, 0.f, 0.f}, sb = {0.f, 0.f, 0.f, 0.f};
#pragma unroll
        for (int kd = 0; kd < 2; ++kd) {
          const bf16x8 qv = ql[(r * 2 + kd) * 64];
          sa = MFMA16(kf[0][kd], qv, sa);
          sb = MFMA16(kf[1][kd], qv, sb);
        }
        float sc[8];
        float cm = NEGB;
#pragma unroll
        for (int e = 0; e < 8; ++e) {
          const int c = kb + q4 * 8 + e;
          const bool v = (16 * c + 31 <= t);
          float x = ((e < 4) ? sa[e & 3] : sb[e & 3]) * SCL2;
          sc[e] = v ? x : NEGB;
          cm = fmaxf(cm, sc[e]);
        }
        cm = fmaxf(cm, __shfl_xor(cm, 16));
        cm = fmaxf(cm, __shfl_xor(cm, 32));
        const float mn = fmaxf(m[r], cm);
        float ps = 0.f;
#pragma unroll
        for (int e = 0; e < 8; ++e) ps += (sc[e] > -1e29f) ? ex2(sc[e] - mn) : 0.f;
        l[r] = l[r] * ex2(m[r] - mn) + ps;
        m[r] = mn;
        __builtin_amdgcn_sched_barrier(0);
      }
    }
    float inv[4];
#pragma unroll
    for (int r = 0; r < 4; ++r) {
      float lv = l[r];
      lv += __shfl_xor(lv, 16);
      lv += __shfl_xor(lv, 32);
      inv[r] = (lv > 0.f) ? 1.f / lv : 0.f;
    }
#pragma unroll
    for (int dt = 0; dt < 4; ++dt)
#pragma unroll
      for (int r = 0; r < 4; ++r) Oc[dt][r] = f32x4{0.f, 0.f, 0.f, 0.f};
#pragma unroll 1
    for (int ch = 0; ch < nch; ++ch) {
      const int kb = ch * 32;
      bf16x8 kf[2][2];
#pragma unroll
      for (int sub = 0; sub < 2; ++sub)
#pragma unroll
        for (int kd = 0; kd < 2; ++kd) kf[sub][kd] = *(const bf16x8*)(Kc + (size_t)(kb + krow + sub * 4) * 64 + kd * 32 + q4 * 8);
      bf16x8 vf[4];
#pragma unroll
      for (int dt = 0; dt < 4; ++dt) vf[dt] = *(const bf16x8*)(VcT + (size_t)(dt * 16 + n) * 128 + kb + q4 * 8);
      float psm[8];
#pragma unroll
      for (int e = 0; e < 8; ++e) psm[e] = 0.f;
      bf16x8 pf[4];
#pragma unroll
      for (int r = 0; r < 4; ++r) {
        f32x4 sa = {0.f, 0.f, 0.f, 0.f}, sb = {0.f, 0.f, 0.f, 0.f};
#pragma unroll
        for (int kd = 0; kd < 2; ++kd) {
          const bf16x8 qv = ql[(r * 2 + kd) * 64];
          sa = MFMA16(kf[0][kd], qv, sa);
          sb = MFMA16(kf[1][kd], qv, sb);
        }
        float pe[8];
#pragma unroll
        for (int e = 0; e < 8; ++e) {
          const int c = kb + q4 * 8 + e;
          const bool v = (16 * c + 31 <= t);
          float x = ((e < 4) ? sa[e & 3] : sb[e & 3]) * SCL2;
          pe[e] = v ? ex2(x - m[r]) * inv[r] : 0.f;
          psm[e] += pe[e];
        }
        union { unsigned u[4]; bf16x8 v; } pk;
        pk.u[0] = pk2(pe[0], pe[1]); pk.u[1] = pk2(pe[2], pe[3]); pk.u[2] = pk2(pe[4], pe[5]); pk.u[3] = pk2(pe[6], pe[7]);
        pf[r] = pk.v;
        __builtin_amdgcn_sched_barrier(0);
      }
      {
        float* ip = impb + n * 36 + (kb >> 2) + 2 * q4;
        ip[0] += psm[0] + psm[1] + psm[2] + 0.5f * psm[3];
        __builtin_amdgcn_fence(__ATOMIC_ACQ_REL, "workgroup");
        __builtin_amdgcn_wave_barrier();
        ip[1] += 0.5f * psm[3] + psm[4] + psm[5] + psm[6] + 0.5f * psm[7];
        __builtin_amdgcn_fence(__ATOMIC_ACQ_REL, "workgroup");
        __builtin_amdgcn_wave_barrier();
        ip[2] += 0.5f * psm[7];
        __builtin_amdgcn_fence(__ATOMIC_ACQ_REL, "workgroup");
        __builtin_amdgcn_wave_barrier();
      }
#pragma unroll
      for (int dt = 0; dt < 4; ++dt)
#pragma unroll
        for (int r = 0; r < 4; ++r) Oc[dt][r] = MFMA16(vf[dt], pf[r], Oc[dt][r]);
    }
  }
#pragma unroll
  for (int r = 0; r < 4; ++r) {
    const float gsc = gatep[r * 3 + 0];
#pragma unroll
    for (int dt = 0; dt < 4; ++dt) {
      uint2 o;
      o.x = pk2(Oc[dt][r][0] * gsc, Oc[dt][r][1] * gsc);
      o.y = pk2(Oc[dt][r][2] * gsc, Oc[dt][r][3] * gsc);
      *(uint2*)(mixl + r * 64 + dt * 16) = o;
    }
  }
  __builtin_amdgcn_fence(__ATOMIC_ACQ_REL, "workgroup");
  __builtin_amdgcn_wave_barrier();
  const int tblk = t0 >> 6;
  unsigned selmask = topk8(impb + n * 36, tblk);
  selmask &= (tblk >= 31) ? 0xffffffffu : ((1u << (tblk + 1)) - 1u);
  __builtin_amdgcn_wave_barrier();

#pragma unroll
  for (int r = 0; r < 4; ++r) {
    const bf16x8 q0 = ql[(r * 2 + 0) * 64];
    union { unsigned u[4]; bf16x8 v; } pk;
    float vals[8];
#pragma unroll
    for (int j = 0; j < 8; ++j) {
      float xv = bf2f((bf16_t)q0[j]);
      float ov = __shfl_xor(xv, 16);
      float2 cs = p.rope[t * 8 + j];
      vals[j] = (q4 == 0) ? (xv * cs.x - ov * cs.y) : ((q4 == 1) ? (xv * cs.x + ov * cs.y) : xv);
    }
    pk.u[0] = pk2(vals[0], vals[1]); pk.u[1] = pk2(vals[2], vals[3]); pk.u[2] = pk2(vals[4], vals[5]); pk.u[3] = pk2(vals[6], vals[7]);
    ql[(r * 2 + 0) * 64] = pk.v;
  }

#pragma unroll 1
  for (int br = 1; br <= 2; ++br) {
    unsigned long long cmask = 0ull;
    const int hic = (t0 + 15) >> 5;
    if (br == 1) {
      unsigned any = selmask;
#pragma unroll
      for (int o = 32; o >= 1; o >>= 1) any |= (unsigned)__shfl_xor((int)any, o);
      any = __builtin_amdgcn_readfirstlane(any);
      for (int j = 0; j <= tblk; ++j)
        if ((any >> j) & 1u) cmask |= 3ull << (2 * j);
      if (hic < 63) cmask &= (1ull << (hic + 1)) - 1ull;
    } else {
      const int lo = max(0, t0 - 511) >> 5;
      cmask = (hic < 63) ? ((1ull << (hic + 1)) - 1ull) : ~0ull;
      cmask &= ~((1ull << lo) - 1ull);
    }
    f32x4 O[4][4];
    float m[4], l[4];
#pragma unroll
    for (int dt = 0; dt < 4; ++dt)
#pragma unroll
      for (int r = 0; r < 4; ++r) O[r][dt] = f32x4{0.f, 0.f, 0.f, 0.f};
#pragma unroll
    for (int r = 0; r < 4; ++r) { m[r] = -1e29f; l[r] = 0.f; }
    if (br == 1)
      attend<1>(cmask, p.ksb + (size_t)b * 2048 * 128 + g * 64, p.vsT + (size_t)bg * 64 * VTS, ql, t, t0, selmask, n, q4, O, m, l);
    else
      attend<2>(cmask, p.kwb + (size_t)b * 2048 * 128 + g * 64, p.vwT + (size_t)bg * 64 * VTS, ql, t, t0, selmask, n, q4, O, m, l);
#pragma unroll
    for (int r = 0; r < 4; ++r) {
      float lv = l[r];
      lv += __shfl_xor(lv, 16);
      lv += __shfl_xor(lv, 32);
      const float gsc = gatep[r * 3 + br] * ((lv > 0.f) ? 1.f / lv : 0.f);
#pragma unroll
      for (int dt = 0; dt < 4; ++dt) {
        uint2* mp = (uint2*)(mixl + r * 64 + dt * 16);
        const uint2 u = *mp;
        float a0 = __uint_as_float(u.x << 16) + O[r][dt][0] * gsc, a1 = __uint_as_float(u.x & 0xffff0000u) + O[r][dt][1] * gsc;
        float a2 = __uint_as_float(u.y << 16) + O[r][dt][2] * gsc, a3 = __uint_as_float(u.y & 0xffff0000u) + O[r][dt][3] * gsc;
        if (br == 2) {
          const uint2 gg = *(const uint2*)(p.gns + tok * 512 + (g * 4 + r) * 64 + dt * 16 + q4 * 4);
          a0 *= __uint_as_float(gg.x << 16); a1 *= __uint_as_float(gg.x & 0xffff0000u);
          a2 *= __uint_as_float(gg.y << 16); a3 *= __uint_as_float(gg.y & 0xffff0000u);
        }
        uint2 o;
        o.x = pk2(a0, a1);
        o.y = pk2(a2, a3);
        *mp = o;
      }
    }
  }
}

__device__ void phase_mix_rwkv(const Params& p) {
  int tx = threadIdx.x;
  asm volatile("" : "+v"(tx));
  const int lane = tx & 63, sub = lane >> 4, c = lane & 15;
  const int gw = blockIdx.x * 4 + (tx >> 6), nw = gridDim.x * 4;
  for (int it = gw; it < T_ * 2; it += nw) {
    const int ph = it * 4 + sub;
    const int tok = ph >> 3, h = ph & 7;
    const int ch = h * 64 + c * 4;
    const size_t idx = (size_t)tok * 512 + ch;
    const float4 y = *(const float4*)(p.yraw + idx);
    const float mean = allred16(y.x + y.y + y.z + y.w) * (1.f / 64.f);
    const float d0 = y.x - mean, d1 = y.y - mean, d2 = y.z - mean, d3 = y.w - mean;
    const float var = allred16(d0 * d0 + d1 * d1 + d2 * d2 + d3 * d3) * (1.f / 64.f);
    const float rs = rsqrtf(var + 64e-5f);
    const float4 gw4 = *(const float4*)(p.gn_w + ch), gb4 = *(const float4*)(p.gn_b + ch), rk4 = *(const float4*)(p.r_k + ch);
    const uint2 ru = *(const uint2*)(p.rr + idx), ku = *(const uint2*)(p.kp + idx), vu = *(const uint2*)(p.vv + idx),
                gu = *(const uint2*)(p.grw + idx);
    const float r0 = __uint_as_float(ru.x << 16), r1 = __uint_as_float(ru.x & 0xffff0000u), r2 = __uint_as_float(ru.y << 16),
                r3 = __uint_as_float(ru.y & 0xffff0000u);
    const float k0 = __uint_as_float(ku.x << 16), k1 = __uint_as_float(ku.x & 0xffff0000u), k2 = __uint_as_float(ku.y << 16),
                k3 = __uint_as_float(ku.y & 0xffff0000u);
    const float v0 = __uint_as_float(vu.x << 16), v1 = __uint_as_float(vu.x & 0xffff0000u), v2 = __uint_as_float(vu.y << 16),
                v3 = __uint_as_float(vu.y & 0xffff0000u);
    const float g0 = __uint_as_float(gu.x << 16), g1 = __uint_as_float(gu.x & 0xffff0000u), g2 = __uint_as_float(gu.y << 16),
                g3 = __uint_as_float(gu.y & 0xffff0000u);
    const float bonus = allred16(r0 * k0 * rk4.x + r1 * k1 * rk4.y + r2 * k2 * rk4.z + r3 * k3 * rk4.w);
    uint2 o;
    o.x = pk2((d0 * rs * gw4.x + gb4.x + bonus * v0) * g0, (d1 * rs * gw4.y + gb4.y + bonus * v1) * g1);
    o.y = pk2((d2 * rs * gw4.z + gb4.z + bonus * v2) * g2, (d3 * rs * gw4.w + gb4.w + bonus * v3) * g3);
    *(uint2*)(p.mix + (size_t)tok * LDH + 512 + ch) = o;
  }
}

__device__ void phase_final_norm(const Params& p) {
  int tx = threadIdx.x;
  asm volatile("" : "+v"(tx));
  const int lane = tx & 63;
  const int gw = blockIdx.x * 4 + (tx >> 6), nw = gridDim.x * 4;
  const float4* fg = (const float4*)p.final_g;
  for (int row = gw; row < T_; row += nw) {
    float4* o4 = (float4*)(p.out + (size_t)row * 1024);
    float4 v[4];
    float ss = 0.f;
#pragma unroll
    for (int i = 0; i < 4; ++i) {
      v[i] = o4[i * 64 + lane];
      ss += v[i].x * v[i].x + v[i].y * v[i].y + v[i].z * v[i].z + v[i].w * v[i].w;
    }
    ss = wsum(ss);
    const float sc = rsqrtf(ss * (1.f / 1024.f) + 1e-6f);
#pragma unroll
    for (int i = 0; i < 4; ++i) {
      float4 gq = fg[i * 64 + lane];
      v[i].x *= sc * gq.x; v[i].y *= sc * gq.y; v[i].z *= sc * gq.z; v[i].w *= sc * gq.w;
      o4[i * 64 + lane] = v[i];
    }
  }
}

constexpr int NPHASE = 8;
constexpr int SMEM_BYTES = 65536;

template <int PH> DI void run_phase(const Params& p, char* smem) {
  const int bid = blockIdx.x, nb = gridDim.x;
  if (PH == 0) phase_prep(p, smem);
  if (PH == 1)
    for (int t = bid; t < 128 * 32; t += nb) gemm_tile<G_PROJ>(p, t >> 5, t & 31, 0, smem);
  if (PH == 2)
    if (nb > 128) {
      if (bid < 64) gemm_tile<G_CMP1>(p, (bid & 31) >> 1, bid & 1, bid >> 5, smem);
      else
        for (int t = bid - 64; t < 512; t += nb - 64) rwkv_prep_tile(p, t, smem);
    } else {
      for (int t = bid; t < 512 + 64; t += nb) {
        if (t < 64) gemm_tile<G_CMP1>(p, (t & 31) >> 1, t & 1, t >> 5, smem);
        else rwkv_prep_tile(p, t - 64, smem);
      }
    }
  if (PH == 3) {
    if (nb != 512)
      for (int t = bid; t < 32; t += nb) gemm_tile<G_CMP2>(p, t & 15, 0, t >> 4, smem);
  }
  if (PH == 4) {
    unsigned* flag = p.ctr + 40;
    if (nb == 512 && bid >= 256 && bid < 288) {
      const int t = bid - 256;
      gemm_tile<G_CMP2>(p, t & 15, 0, t >> 4, smem);
      asm volatile("s_waitcnt vmcnt(0)" ::: "memory");
      __syncthreads();
      if (threadIdx.x == 0) {
        __builtin_amdgcn_fence(__ATOMIC_RELEASE, "agent");
        asm volatile("s_waitcnt vmcnt(0)" ::: "memory");
        __hip_atomic_fetch_add(flag, 1u, __ATOMIC_RELAXED, __HIP_MEMORY_SCOPE_AGENT);
      }
    }
    for (int t = bid; t < 256; t += nb) scan_item(p, t, smem);
    if (nb == 512) {
      if (threadIdx.x == 0) {
        while (__hip_atomic_load(flag, __ATOMIC_RELAXED, __HIP_MEMORY_SCOPE_AGENT) < 32u) __builtin_amdgcn_s_sleep(2);
        __builtin_amdgcn_fence(__ATOMIC_ACQUIRE, "agent");
        asm volatile("s_waitcnt vmcnt(0)" ::: "memory");
      }
      __syncthreads();
    }
    float* wl = (float*)smem + (threadIdx.x >> 6) * NSA_WFLOATS;
    while (true) {
      int it = 0;
      if ((threadIdx.x & 63) == 0) it = (int)atomicAdd(p.ctr, 1u);
      it = __builtin_amdgcn_readfirstlane(it);
      if (it >= 2048) break;
      nsa_wave_item(p, (127 - (it >> 4)) * 16 + (it & 15), wl);
    }
  }
  if (PH == 5) phase_mix_rwkv(p);
  if (PH == 6)
    for (int t = bid; t < 128 * 8; t += nb) gemm_tile<G_OUT>(p, t >> 3, t & 7, 0, smem);
  if (PH == 7) phase_final_norm(p);
}

template <int PH> __global__ void __launch_bounds__(256, 2) phk(Params p) {
  __shared__ __attribute__((aligned(16))) char smem[SMEM_BYTES];
  run_phase<PH>(p, smem);
}

#ifndef PROBE_PH
#define PROBE_PH -1
#endif
#define XB_CNT(j) (256 + 64 * (j))
#define XB_SUB(j) (1280 + 64 * (j))
#define XB_GEN(j) (2304 + 64 * (j))
#define XB_TOP 3328
#define XB_TOPGEN 3392
DI unsigned xb_ld(unsigned* q) { return __hip_atomic_load(q, __ATOMIC_RELAXED, __HIP_MEMORY_SCOPE_AGENT); }
DI unsigned xb_add(unsigned* q, unsigned v) { return __hip_atomic_fetch_add(q, v, __ATOMIC_RELAXED, __HIP_MEMORY_SCOPE_AGENT); }
DI unsigned xb_xcc() { return (unsigned)__builtin_amdgcn_s_getreg((3 << 11) | 20) & 0xFu; }
DI void fast_barrier(unsigned* bar) {
  asm volatile("s_waitcnt vmcnt(0)" ::: "memory");
  __syncthreads();
  if (threadIdx.x == 0) {
    const unsigned x = xb_xcc();
    unsigned nloc, nx;
    for (;;) {
      unsigned sum = 0u;
      nloc = 1u;
      nx = 0u;
#pragma unroll
      for (unsigned j = 0; j < 16; ++j) {
        const unsigned c = xb_ld(&bar[XB_CNT(j)]);
        sum += c;
        nx += (c > 0u) ? 1u : 0u;
        nloc = (j == x) ? c : nloc;
      }
      if (sum == gridDim.x) break;
      __builtin_amdgcn_s_sleep(1);
    }
    const unsigned old = xb_add(&bar[XB_SUB(x)], 1u);
    const unsigned gen = old / nloc;
    if (old + 1u == (gen + 1u) * nloc) {
      __builtin_amdgcn_fence(__ATOMIC_RELEASE, "agent");
      asm volatile("s_waitcnt vmcnt(0)" ::: "memory");
      const unsigned og = xb_add(&bar[XB_TOP], 1u);
      const unsigned tg = og / nx;
      if (og + 1u == (tg + 1u) * nx) xb_add(&bar[XB_TOPGEN], 1u);
      else
        while (xb_ld(&bar[XB_TOPGEN]) == tg) __builtin_amdgcn_s_sleep(1);
      __builtin_amdgcn_fence(__ATOMIC_ACQUIRE, "agent");
      xb_add(&bar[XB_GEN(x)], 1u);
      asm volatile("s_waitcnt vmcnt(0)" ::: "memory");
    } else {
      while (xb_ld(&bar[XB_GEN(x)]) == gen) __builtin_amdgcn_s_sleep(1);
      __builtin_amdgcn_fence(__ATOMIC_ACQUIRE, "agent");
      asm volatile("s_waitcnt vmcnt(0)" ::: "memory");
    }
  }
  __syncthreads();
}

__global__ void __launch_bounds__(256, 2) mega(Params p) {
  __shared__ __attribute__((aligned(16))) char smem[SMEM_BYTES];
  cg::grid_group grid = cg::this_grid();
  unsigned* bar = p.xbar;
  const unsigned nblk = gridDim.x;
  if (p.ctr == nullptr) grid.sync();
  if (threadIdx.x == 0) (void)xb_add(&bar[XB_CNT(xb_xcc())], 1u);
  run_phase<0>(p, smem); fast_barrier(bar);
  run_phase<1>(p, smem); fast_barrier(bar);
  run_phase<2>(p, smem); fast_barrier(bar);
  if (nblk != 512u) { run_phase<3>(p, smem); fast_barrier(bar); }
  run_phase<4>(p, smem); fast_barrier(bar);
  run_phase<5>(p, smem); fast_barrier(bar);
  run_phase<6>(p, smem); fast_barrier(bar);
  run_phase<7>(p, smem);
}

extern "C" void kernel_launch(void* const* d_in, const int* in_sizes, int n_in, void* d_out, int out_size, void* d_ws, size_t ws_size,
                              hipStream_t stream) {
  Params p{};
  const float** pin = (const float**)&p;
  for (int i = 0; i < 21; ++i) pin[i] = (const float*)d_in[i];
  p.out = (float*)d_out;
  char* w = (char*)d_ws;
  size_t off = 0;
  auto alloc = [&](size_t bytes) { void* r = w + off; off += (bytes + 255) & ~(size_t)255; return r; };
  p.WinT = (bf16_t*)alloc((size_t)NPAD * LDW * 2);
  p.WoutT = (bf16_t*)alloc((size_t)1024 * LDW * 2);
  p.W1Tk = (bf16_t*)alloc((size_t)256 * LDW1 * 2);
  p.W1Tv = (bf16_t*)alloc((size_t)256 * LDW1 * 2);
  p.W2Tk = (bf16_t*)alloc((size_t)128 * LDW2 * 2);
  p.W2Tv = (bf16_t*)alloc((size_t)128 * LDW2 * 2);
  p.WupT = (bf16_t*)alloc((size_t)512 * 64 * 2);
  p.AupT = (bf16_t*)alloc((size_t)512 * 64 * 2);
  p.bias1k = (float*)alloc(256 * 4);
  p.bias1v = (float*)alloc(256 * 4);
  p.rope = (float2*)alloc((size_t)2048 * 8 * 8);
  p.qb = (bf16_t*)alloc((size_t)T_ * 512 * 2);
  p.kcb = (bf16_t*)alloc((size_t)(T_ + 16) * LDKC * 2);
  p.vcb = (bf16_t*)alloc((size_t)(T_ + 16) * LDKC * 2);
  p.ksb = (bf16_t*)alloc((size_t)T_ * 128 * 2);
  p.kwb = (bf16_t*)alloc((size_t)T_ * 128 * 2);
  p.vsb = nullptr;
  p.vwb = nullptr;
  p.vsT = (bf16_t*)alloc((size_t)16 * 64 * VTS * 2);
  p.vwT = (bf16_t*)alloc((size_t)16 * 64 * VTS * 2);
  p.glb = (float*)alloc((size_t)T_ * 24 * 4);
  p.gns = (bf16_t*)alloc((size_t)T_ * 512 * 2);
  p.rw = (bf16_t*)alloc((size_t)T_ * 1664 * 2);
  p.yraw = (float*)p.rw;
  p.grw = (bf16_t*)alloc((size_t)T_ * 512 * 2);
  p.hidk = (bf16_t*)alloc((size_t)2048 * LDHID * 2);
  p.hidv = (bf16_t*)alloc((size_t)2048 * LDHID * 2);
  p.kcmp = (bf16_t*)alloc((size_t)16 * 128 * 64 * 2);
  p.vcmp = (bf16_t*)alloc((size_t)16 * 128 * 64 * 2);
  p.vcmpT = (bf16_t*)alloc((size_t)16 * 128 * 64 * 2);
  p.rr = (bf16_t*)alloc((size_t)T_ * 512 * 2);
  p.kp = (bf16_t*)alloc((size_t)T_ * 512 * 2);
  p.vv = (bf16_t*)alloc((size_t)T_ * 512 * 2);
  p.mix = (bf16_t*)alloc((size_t)T_ * LDH * 2);
  p.hb = p.mix;
  p.ctr = (unsigned*)alloc(256);
  p.xbar = (unsigned*)alloc(16384);
  p.dec = (float*)d_out;
  p.kk = (bf16_t*)((char*)d_out + (size_t)T_ * 512 * 4);
  p.bb = (bf16_t*)((char*)d_out + (size_t)T_ * 512 * 6);
  if (off > ws_size) {
    fprintf(stderr, "workspace too small: need %zu have %zu\n", off, ws_size);
    return;
  }
#ifdef MULTI_LAUNCH
  hipLaunchKernelGGL(phk<0>, dim3(512), dim3(256), 0, stream, p);
  hipLaunchKernelGGL(phk<1>, dim3(512), dim3(256), 0, stream, p);
  hipLaunchKernelGGL(phk<2>, dim3(512), dim3(256), 0, stream, p);
  hipLaunchKernelGGL(phk<3>, dim3(512), dim3(256), 0, stream, p);
  hipLaunchKernelGGL(phk<4>, dim3(512), dim3(256), 0, stream, p);
  hipLaunchKernelGGL(phk<5>, dim3(512), dim3(256), 0, stream, p);
  hipLaunchKernelGGL(phk<6>, dim3(512), dim3(256), 0, stream, p);
  hipLaunchKernelGGL(phk<7>, dim3(512), dim3(256), 0, stream, p);
#else
  static int grid_blocks = 0;
  if (!grid_blocks) {
    int dev = 0, cus = 0, per_cu = 0;
    hipGetDevice(&dev);
    hipDeviceGetAttribute(&cus, hipDeviceAttributeMultiprocessorCount, dev);
    hipOccupancyMaxActiveBlocksPerMultiprocessor(&per_cu, mega, 256, 0);
    if (per_cu > 2) per_cu = 2;
    if (per_cu < 1) per_cu = 1;
    grid_blocks = cus * per_cu;
  }
  hipMemsetAsync(p.ctr, 0, 256 + 16384, stream);
  void* args[] = {&p};
  hipError_t e = hipLaunchCooperativeKernel((void*)mega, dim3(grid_blocks), dim3(256), args, 0, stream);
  if (e != hipSuccess) fprintf(stderr, "cooperative launch failed: %s (grid %d)\n", hipGetErrorString(e), grid_blocks);
#endif
}
```

```cpp
#include <hip/hip_runtime.h>
#include <hip/hip_bf16.h>
#include <hip/hip_cooperative_groups.h>
#include <cstdio>
namespace cg = cooperative_groups;


typedef unsigned short bf16_t;
using bf16x8 = __attribute__((ext_vector_type(8))) short;
using f32x16 = __attribute__((ext_vector_type(16))) float;

#define DI __device__ __forceinline__

constexpr int T_ = 16384, S_ = 2048;
constexpr int NPAD = 4096;
constexpr int LDH = 1088, LDW = 1088, LDW1 = 2112, LDHID = 320, LDW2 = 320, LDKC = 136, VTS = 2112;

typedef __bf16 bf16x2_t __attribute__((ext_vector_type(2)));
typedef float f32x2_t __attribute__((ext_vector_type(2)));
DI unsigned pk2(float a, float b) {
  f32x2_t v = {a, b};
  return __builtin_bit_cast(unsigned, __builtin_convertvector(v, bf16x2_t));
}
DI bf16_t f2bf(float x) { return (bf16_t)(pk2(x, 0.f) & 0xffffu); }
DI float bf2f(bf16_t b) { return __uint_as_float(((unsigned)b) << 16); }
DI float sigmoidf_(float x) { return 1.f / (1.f + __expf(-x)); }
DI float siluf_(float x) { return x / (1.f + __expf(-x)); }
DI float wsum(float x) {
#pragma unroll
  for (int o = 32; o >= 1; o >>= 1) x += __shfl_xor(x, o);
  return x;
}
DI float wmax(float x) {
#pragma unroll
  for (int o = 32; o >= 1; o >>= 1) x = fmaxf(x, __shfl_xor(x, o));
  return x;
}
template <int CTRL> DI float dppf(float x) {
  return __int_as_float(__builtin_amdgcn_update_dpp(0, __float_as_int(x), CTRL, 0xf, 0xf, true));
}
DI float allred16(float x) {
  x += dppf<0xB1>(x);
  x += dppf<0x4E>(x);
  x += dppf<0x141>(x);
  x += dppf<0x128>(x);
  return x;
}

struct Params {
  const float *x, *norm_g, *w_in, *pos_k, *w1_k, *w2_k, *pos_v, *w1_v, *w2_v, *mu, *w0, *w_up, *a0, *a_up, *k_k, *k_a, *r_k,
      *gn_w, *gn_b, *w_out, *final_g;
  float* out;
  bf16_t *WinT, *WoutT, *W1Tk, *W1Tv, *W2Tk, *W2Tv, *WupT, *AupT;
  float *bias1k, *bias1v;
  float2* rope;
  bf16_t *qb, *kcb, *vcb, *ksb, *kwb, *vsb, *vwb, *vsT, *vwT;
  float* glb;
  bf16_t *gns, *rw, *grw, *hidk, *hidv, *kcmp, *vcmp, *vcmpT;
  bf16_t *rr, *kp, *vv, *kk, *bb;
  float *dec, *yraw;
  bf16_t* mix;
  bf16_t* hb;
  unsigned* ctr;
  unsigned* xbar;
};

DI void transpose_tile(const float* __restrict__ src, int ldsrc, bf16_t* __restrict__ dst, int ldd, int k0, int n0, const float* scale,
                       int mapmode, int nvalid, float* tile) {
  const int tid = threadIdx.x;
#pragma unroll
  for (int i = 0; i < 4; ++i) {
    const int idx = tid + 256 * i, kl = idx >> 4, ng = (idx & 15) * 4;
    const int n = n0 + ng;
    int on;
    if (mapmode == 1) on = (n < 1304) ? n : (n < 1408 ? -1 : n - 104);
    else on = (n < nvalid) ? n : -1;
    float4 v = make_float4(0.f, 0.f, 0.f, 0.f);
    if (on >= 0) {
      v = *(const float4*)(src + (size_t)(k0 + kl) * ldsrc + on);
      if (scale) {
        const float sc = scale[k0 + kl];
        v.x *= sc; v.y *= sc; v.z *= sc; v.w *= sc;
      }
    }
    float* t = tile + kl * 65 + ng;
    t[0] = v.x; t[1] = v.y; t[2] = v.z; t[3] = v.w;
  }
  __syncthreads();
#pragma unroll
  for (int i = 0; i < 2; ++i) {
    const int idx = tid + 256 * i, nl = idx >> 3, kg = (idx & 7) * 8;
    uint4 o;
    o.x = pk2(tile[(kg + 0) * 65 + nl], tile[(kg + 1) * 65 + nl]);
    o.y = pk2(tile[(kg + 2) * 65 + nl], tile[(kg + 3) * 65 + nl]);
    o.z = pk2(tile[(kg + 4) * 65 + nl], tile[(kg + 5) * 65 + nl]);
    o.w = pk2(tile[(kg + 6) * 65 + nl], tile[(kg + 7) * 65 + nl]);
    *(uint4*)(dst + (size_t)(n0 + nl) * ldd + k0 + kg) = o;
  }
  __syncthreads();
}

DI void phase_prep(const Params& p, char* smem) {
  float* tile = (float*)smem;
  const int nb = gridDim.x, bid = blockIdx.x, tid = threadIdx.x;
  {
    const int lane = tid & 63;
    for (int row = bid * 4 + (tid >> 6); row < T_; row += nb * 4) {
      const float4* x4 = (const float4*)(p.x + (size_t)row * 1024);
      float4 v[4];
      float ss = 0.f;
#pragma unroll
      for (int i = 0; i < 4; ++i) {
        v[i] = x4[i * 64 + lane];
        ss += v[i].x * v[i].x + v[i].y * v[i].y + v[i].z * v[i].z + v[i].w * v[i].w;
      }
      ss = wsum(ss);
      const float sc = rsqrtf(ss * (1.f / 1024.f) + 1e-6f);
      uint2* h2 = (uint2*)(p.hb + (size_t)row * LDH);
#pragma unroll
      for (int i = 0; i < 4; ++i) {
        uint2 o;
        o.x = pk2(v[i].x * sc, v[i].y * sc);
        o.y = pk2(v[i].z * sc, v[i].w * sc);
        h2[i * 64 + lane] = o;
      }
    }
  }
  const int n_win = 16 * 64, n_wout = 16 * 16, n_w1 = 32 * 4, n_w2 = 4 * 2, n_lora = 1 * 8;
  const int o1 = n_win, o2 = o1 + n_wout, o3 = o2 + n_w1, o4 = o3 + n_w1, o5 = o4 + n_w2, o6 = o5 + n_w2, o7 = o6 + n_lora,
            o8 = o7 + n_lora, o9 = o8 + 128, o10 = o9 + 16;
  for (int it = bid; it < o10; it += nb) {
    if (it < o1) {
      int kt = it & 15, nt = it >> 4;
      transpose_tile(p.w_in, 3992, p.WinT, LDW, kt * 64, nt * 64, p.norm_g, 1, 0, tile);
    } else if (it < o2) {
      int j = it - o1, kt = j & 15, nt = j >> 4;
      transpose_tile(p.w_out, 1024, p.WoutT, LDW, kt * 64, nt * 64, nullptr, 0, 1024, tile);
    } else if (it < o3) {
      int j = it - o2, kt = j & 31, nt = j >> 5;
      transpose_tile(p.w1_k, 256, p.W1Tk, LDW1, kt * 64, nt * 64, nullptr, 0, 256, tile);
    } else if (it < o4) {
      int j = it - o3, kt = j & 31, nt = j >> 5;
      transpose_tile(p.w1_v, 256, p.W1Tv, LDW1, kt * 64, nt * 64, nullptr, 0, 256, tile);
    } else if (it < o5) {
      int j = it - o4, kt = j & 3, nt = j >> 2;
      transpose_tile(p.w2_k, 64, p.W2Tk, LDW2, kt * 64, nt * 64, nullptr, 0, 64, tile);
    } else if (it < o6) {
      int j = it - o5, kt = j & 3, nt = j >> 2;
      transpose_tile(p.w2_v, 64, p.W2Tv, LDW2, kt * 64, nt * 64, nullptr, 0, 64, tile);
    } else if (it < o7) {
      int nt = it - o6;
      transpose_tile(p.w_up, 512, p.WupT, 64, 0, nt * 64, nullptr, 0, 512, tile);
    } else if (it < o8) {
      int nt = it - o7;
      transpose_tile(p.a_up, 512, p.AupT, 64, 0, nt * 64, nullptr, 0, 512, tile);
    } else if (it < o9) {
      const int j = it - o8, which = j >> 6, n0 = (j & 63) * 4;
      const float* pos = which ? p.pos_v : p.pos_k;
      const float* w1 = which ? p.w1_v : p.w1_k;
      float* bo = which ? p.bias1v : p.bias1k;
      const int kp = tid >> 2, nn = tid & 3;
      float a = 0.f;
#pragma unroll 16
      for (int k = kp * 32; k < kp * 32 + 32; ++k) a += pos[k] * w1[(size_t)k * 256 + n0 + nn];
      tile[tid] = a;
      __syncthreads();
      if (tid < 4) {
        float sum = 0.f;
        for (int q = 0; q < 64; ++q) sum += tile[q * 4 + tid];
        bo[n0 + tid] = sum;
      }
      __syncthreads();
    } else {
      int j = it - o9;
      for (int e = tid; e < 1024; e += 256) {
        int idx = j * 1024 + e;
        int pos = idx >> 3, i = idx & 7;
        float inv = powf(500000.0f, -(float)i / 8.0f);
        float ang = (float)pos * inv;
        float sn, cs;
        sincosf(ang, &sn, &cs);
        p.rope[idx] = make_float2(cs, sn);
      }
    }
  }
}

constexpr int LDT = 40;

DI int crow(int i, int h) { return (i & 3) + 8 * (i >> 2) + 4 * h; }

enum { G_PROJ = 0, G_CMP1 = 1, G_CMP2 = 2, G_OUT = 3 };

template <int MODE, bool EPI = true>
DI void gemm_tile(const Params& p, int mt, int nt, int which, char* smem) {
  constexpr int K = (MODE == G_PROJ) ? 1024 : (MODE == G_CMP1) ? 2048 : (MODE == G_CMP2) ? 256 : 1024;
  constexpr int LDA = (MODE == G_PROJ) ? LDH : (MODE == G_CMP1) ? LDKC : (MODE == G_CMP2) ? LDHID : LDH;
  constexpr int LDB = (MODE == G_PROJ) ? LDW : (MODE == G_CMP1) ? LDW1 : (MODE == G_CMP2) ? LDW2 : LDW;
  const int tid = threadIdx.x, lane = tid & 63, wave = tid >> 6;
  const int wm = wave >> 1, wn = wave & 1;
  const int m0 = mt * 128, n0 = nt * 128;

  const bf16_t* Bt;
  const bf16_t* Ab;
  if (MODE == G_PROJ) { Bt = p.WinT; Ab = p.hb; }
  else if (MODE == G_CMP1) { Bt = which ? p.W1Tv : p.W1Tk; Ab = which ? p.vcb : p.kcb; }
  else if (MODE == G_CMP2) { Bt = which ? p.W2Tv : p.W2Tk; Ab = which ? p.hidv : p.hidk; }
  else { Bt = p.WoutT; Ab = p.mix; }

  const int lrr = lane >> 2;
  const int lks = (lane & 3) ^ ((lane >> 4) & 3);
  unsigned aoA, aoB, boA;
  {
    const int r0 = m0 + (2 * wave) * 16 + lrr, r1 = r0 + 16;
    if (MODE == G_CMP1) {
      aoA = (unsigned)(r0 >> 1) * (16 * LDA) + (r0 & 1) * 64;
      aoB = (unsigned)(r1 >> 1) * (16 * LDA) + (r1 & 1) * 64;
    } else {
      aoA = (unsigned)r0 * LDA;
      aoB = (unsigned)r1 * LDA;
    }
    boA = (unsigned)(n0 + (2 * wave) * 16 + lrr) * LDB + lks * 8;
  }
  char* ldsw = smem + (2 * wave) * 1024;
  auto glds = [&](int kt) __attribute__((always_inline)) {
    char* st = ldsw + (kt & 3) * 16384;
    const int k_ = kt * 32 + lks * 8;
    const unsigned ko_ = (MODE == G_CMP1) ? ((unsigned)(k_ >> 6) * LDA + (k_ & 63)) : (unsigned)k_;
    __builtin_amdgcn_global_load_lds((const unsigned*)(Ab + (aoA + ko_)), (__attribute__((address_space(3))) unsigned*)(st), 16, 0, 0);
    __builtin_amdgcn_global_load_lds((const unsigned*)(Ab + (aoB + ko_)), (__attribute__((address_space(3))) unsigned*)(st + 1024), 16, 0, 0);
    __builtin_amdgcn_global_load_lds((const unsigned*)(Bt + (boA + kt * 32)), (__attribute__((address_space(3))) unsigned*)(st + 8192), 16, 0, 0);
    __builtin_amdgcn_global_load_lds((const unsigned*)(Bt + (boA + 16 * LDB + kt * 32)), (__attribute__((address_space(3))) unsigned*)(st + 8192 + 1024), 16, 0, 0);
  };

  f32x16 acc[2][2];
#pragma unroll
  for (int a = 0; a < 2; ++a)
#pragma unroll
    for (int b = 0; b < 2; ++b)
#pragma unroll
      for (int i = 0; i < 16; ++i) acc[a][b][i] = 0.f;

  const int frr = lane & 15, fhi = (lane >> 4) & 1, fq = lane >> 5;
  const int offA0 = ((wm * 64) >> 4) * 1024 + fhi * 1024 + frr * 64;
  const int offB0 = 8192 + ((wn * 64) >> 4) * 1024 + fhi * 1024 + frr * 64;
  const int fsw = (frr >> 2) & 3;
  bf16x8 fa0_0, fa0_1, fb0_0, fb0_1, fa1_0, fa1_1, fb1_0, fb1_1;
  bf16x8 ga0_0, ga0_1, gb0_0, gb0_1, ga1_0, ga1_1, gb1_0, gb1_1;
  const unsigned lbase = (unsigned)(size_t)(__attribute__((address_space(3))) char*)smem;
  const unsigned adA0 = lbase + offA0 + ((0 * 2 + fq) ^ fsw) * 16, adA1 = lbase + offA0 + ((1 * 2 + fq) ^ fsw) * 16;
  const unsigned adB0 = lbase + offB0 + ((0 * 2 + fq) ^ fsw) * 16, adB1 = lbase + offB0 + ((1 * 2 + fq) ^ fsw) * 16;
#define DSR(DST, AD, OFF) asm volatile("ds_read_b128 %0, %1 offset:%2" : "=v"(DST) : "v"(AD), "n"(OFF))
#define FRAG_LOAD_STG(P, SO)                \
  {                                         \
    DSR(P##a0_0, adA0, (SO));               \
    DSR(P##a0_1, adA0, (SO) + 2048);        \
    DSR(P##b0_0, adB0, (SO));               \
    DSR(P##b0_1, adB0, (SO) + 2048);        \
    DSR(P##a1_0, adA1, (SO));               \
    DSR(P##a1_1, adA1, (SO) + 2048);        \
    DSR(P##b1_0, adB1, (SO));               \
    DSR(P##b1_1, adB1, (SO) + 2048);        \
  }
#define FRAG_LOAD(P, STG)                               \
  {                                                     \
    const int stg_ = (STG);                             \
    if (stg_ == 0) FRAG_LOAD_STG(P, 0)                  \
    else if (stg_ == 1) FRAG_LOAD_STG(P, 16384)         \
    else if (stg_ == 2) FRAG_LOAD_STG(P, 32768)         \
    else FRAG_LOAD_STG(P, 49152)                        \
  }
#define FRAG_MMA(P)                                                                                     \
  {                                                                                                     \
    acc[0][0] = __builtin_amdgcn_mfma_f32_32x32x16_bf16(P##a0_0, P##b0_0, acc[0][0], 0, 0, 0);          \
    acc[0][1] = __builtin_amdgcn_mfma_f32_32x32x16_bf16(P##a0_0, P##b0_1, acc[0][1], 0, 0, 0);          \
    acc[1][0] = __builtin_amdgcn_mfma_f32_32x32x16_bf16(P##a0_1, P##b0_0, acc[1][0], 0, 0, 0);          \
    acc[1][1] = __builtin_amdgcn_mfma_f32_32x32x16_bf16(P##a0_1, P##b0_1, acc[1][1], 0, 0, 0);          \
    acc[0][0] = __builtin_amdgcn_mfma_f32_32x32x16_bf16(P##a1_0, P##b1_0, acc[0][0], 0, 0, 0);          \
    acc[0][1] = __builtin_amdgcn_mfma_f32_32x32x16_bf16(P##a1_0, P##b1_1, acc[0][1], 0, 0, 0);          \
    acc[1][0] = __builtin_amdgcn_mfma_f32_32x32x16_bf16(P##a1_1, P##b1_0, acc[1][0], 0, 0, 0);          \
    acc[1][1] = __builtin_amdgcn_mfma_f32_32x32x16_bf16(P##a1_1, P##b1_1, acc[1][1], 0, 0, 0);          \
  }
#define NEXT_TILE(P, KT1, STG)                                                     \
  {                                                                                \
    if ((KT1) + 2 <= KT - 1) asm volatile("s_waitcnt vmcnt(8)" ::: "memory");      \
    else if ((KT1) + 1 == KT - 1) asm volatile("s_waitcnt vmcnt(4)" ::: "memory"); \
    else asm volatile("s_waitcnt vmcnt(0)" ::: "memory");                          \
    asm volatile("s_waitcnt lgkmcnt(0)" ::: "memory");                             \
    __builtin_amdgcn_s_barrier();                                                  \
    if ((KT1) + 3 < KT) glds((KT1) + 3);                                           \
    FRAG_LOAD(P, STG)                                                              \
  }

  constexpr int KT = K / 32;
  static_assert(KT % 2 == 0, "k-tile count must be even");
  asm volatile("s_waitcnt vmcnt(0)" ::: "memory");
  glds(0);
  glds(1);
  glds(2);
  asm volatile("s_waitcnt vmcnt(8)" ::: "memory");
  asm volatile("s_waitcnt lgkmcnt(0)" ::: "memory");
  __builtin_amdgcn_s_barrier();
  glds(3);
  FRAG_LOAD(f, 0)
  static_assert(KT % 4 == 0, "k-tile count must be a multiple of the ring depth");
#pragma unroll 1
  for (int kt = 0; kt < KT; kt += 4) {
    NEXT_TILE(g, kt + 1, 1)
    FRAG_MMA(f)
    NEXT_TILE(f, kt + 2, 2)
    FRAG_MMA(g)
    NEXT_TILE(g, kt + 3, 3)
    FRAG_MMA(f)
    if (kt + 4 < KT) {
      NEXT_TILE(f, kt + 4, 0)
    } else {
      asm volatile("s_waitcnt lgkmcnt(0)" ::: "memory");
    }
    FRAG_MMA(g)
  }
#undef NEXT_TILE
#undef FRAG_MMA
#undef FRAG_LOAD
#undef FRAG_LOAD_STG
#undef DSR
  asm volatile("s_waitcnt lgkmcnt(0)" ::: "memory");
  __builtin_amdgcn_s_barrier();

  if (!EPI) {
    float sacc = 0.f;
#pragma unroll
    for (int a = 0; a < 2; ++a)
#pragma unroll
      for (int b = 0; b < 2; ++b)
#pragma unroll
        for (int i = 0; i < 16; ++i) sacc += acc[a][b][i];
    if (sacc == 12345.678f) p.ctr[8] = 1u;
    return;
  }
  int tide = tid;
  asm volatile("" : "+v"(tide));
  const int lane_e = tide & 63;
  const int h5 = lane_e >> 5, cl = lane_e & 31;
  auto each = [&](auto&& f) __attribute__((always_inline)) {
#pragma unroll
    for (int mi = 0; mi < 2; ++mi)
#pragma unroll
      for (int ni = 0; ni < 2; ++ni)
#pragma unroll
        for (int i = 0; i < 16; ++i) {
          const int rl = wm * 64 + mi * 32 + crow(i, h5);
          f(ni, rl, m0 + rl, n0 + wn * 64 + ni * 32 + cl, acc[mi][ni][i]);
        }
  };
  if (MODE == G_PROJ) {
    const int ct = nt;
    if (ct == 10) {
      each([&](int ni, int rl, int row, int col, float v) {
        const int c2 = col - 1280;
        if (c2 < 24) p.glb[(size_t)row * 24 + c2] = sigmoidf_(v);
      });
    } else {
      bf16_t* tl = (bf16_t*)smem;
      if (ct == 6 || ct == 8) {
        each([&](int ni, int rl, int row, int col, float v) {
          if (ni == 0) {
            float other = __shfl_xor(v, 8);
            if (cl < 16) {
              float2 cs = p.rope[(row & 2047) * 8 + (cl & 7)];
              v = (cl < 8) ? (v * cs.x - other * cs.y) : (v * cs.x + other * cs.y);
            }
          }
          tl[rl * 136 + (col - n0)] = f2bf(v);
        });
      } else if ((ct >= 11 && ct < 15) || ct >= 28) {
        each([&](int ni, int rl, int row, int col, float v) { tl[rl * 136 + (col - n0)] = f2bf(siluf_(v)); });
      } else {
        each([&](int ni, int rl, int row, int col, float v) { tl[rl * 136 + (col - n0)] = f2bf(v); });
      }
      __syncthreads();
      if (ct == 7 || ct == 9) {
        bf16_t* d2 = (ct == 7) ? p.vsT : p.vwT;
        const int b = m0 >> 11, s0 = m0 & 2047;
#pragma unroll
        for (int i = 0; i < 8; ++i) {
          const int idx = tide + 256 * i;
          const int c2 = idx & 127, rseg = idx >> 7;
          unsigned short e[8];
#pragma unroll
          for (int j = 0; j < 8; ++j) e[j] = tl[(rseg * 8 + j) * 136 + c2];
          uint4 o;
          o.x = e[0] | ((unsigned)e[1] << 16); o.y = e[2] | ((unsigned)e[3] << 16);
          o.z = e[4] | ((unsigned)e[5] << 16); o.w = e[6] | ((unsigned)e[7] << 16);
          *(uint4*)(d2 + ((size_t)((b * 2 + (c2 >> 6)) * 64 + (c2 & 63))) * VTS + s0 + rseg * 8) = o;
        }
      } else {
        bf16_t* dst;
        int ld, cb;
        if (ct < 4) { dst = p.qb; ld = 512; cb = n0; }
        else if (ct == 4) { dst = p.kcb; ld = LDKC; cb = 0; }
        else if (ct == 5) { dst = p.vcb; ld = LDKC; cb = 0; }
        else if (ct == 6) { dst = p.ksb; ld = 128; cb = 0; }
        else if (ct == 8) { dst = p.kwb; ld = 128; cb = 0; }
        else if (ct < 15) { dst = p.gns; ld = 512; cb = n0 - 1408; }
        else if (ct < 28) { dst = p.rw; ld = 1664; cb = n0 - 1920; }
        else { dst = p.grw; ld = 512; cb = n0 - 3584; }
#pragma unroll
        for (int i = 0; i < 8; ++i) {
          const int idx = tide + 256 * i;
          const int r = idx >> 4, sg = idx & 15;
          const uint4 v4 = *(const uint4*)(tl + r * 136 + sg * 8);
          *(uint4*)(dst + (size_t)(m0 + r) * ld + cb + sg * 8) = v4;
        }
      }
    }
  } else if (MODE == G_CMP1) {
    const float* bias = which ? p.bias1v : p.bias1k;
    bf16_t* hid = which ? p.hidv : p.hidk;
    each([&](int ni, int rl, int row, int col, float v) { hid[(size_t)row * LDHID + col] = f2bf(siluf_(v + bias[col])); });
  } else if (MODE == G_CMP2) {
    each([&](int ni, int rl, int row, int col, float v) {
      if (col < 64) {
        const int b = row >> 8, c = (row >> 1) & 127, g = row & 1;
        const int bg = b * 2 + g;
        bf16_t hv = (c < 127) ? f2bf(v) : (bf16_t)0;
        if (which == 0) {
          p.kcmp[((size_t)bg * 128 + c) * 64 + col] = hv;
        } else {
          p.vcmp[((size_t)bg * 128 + c) * 64 + col] = hv;
          p.vcmpT[((size_t)bg * 64 + col) * 128 + c] = hv;
        }
      }
    });
  } else {
    float xv[2][2][16];
#pragma unroll
    for (int mi = 0; mi < 2; ++mi)
#pragma unroll
      for (int ni = 0; ni < 2; ++ni)
#pragma unroll
        for (int i = 0; i < 16; ++i)
          xv[mi][ni][i] = p.x[(size_t)(m0 + wm * 64 + mi * 32 + crow(i, h5)) * 1024 + n0 + wn * 64 + ni * 32 + cl];
#pragma unroll
    for (int mi = 0; mi < 2; ++mi)
#pragma unroll
      for (int ni = 0; ni < 2; ++ni)
#pragma unroll
        for (int i = 0; i < 16; ++i)
          p.out[(size_t)(m0 + wm * 64 + mi * 32 + crow(i, h5)) * 1024 + n0 + wn * 64 + ni * 32 + cl] = xv[mi][ni][i] + acc[mi][ni][i];
  }
  __syncthreads();
}

DI float shiftv(const Params& p, int tok, int col) {
  float cur = bf2f(p.rw[(size_t)tok * 1664 + col]);
  float prev = (tok & 2047) ? bf2f(p.rw[(size_t)(tok - 1) * 1664 + col]) : 0.f;
  return cur + p.mu[col] * (prev - cur);
}

DI void unpack8(uint4 u, float (&f)[8]) {
  f[0] = __uint_as_float(u.x << 16); f[1] = __uint_as_float(u.x & 0xffff0000u);
  f[2] = __uint_as_float(u.y << 16); f[3] = __uint_as_float(u.y & 0xffff0000u);
  f[4] = __uint_as_float(u.z << 16); f[5] = __uint_as_float(u.z & 0xffff0000u);
  f[6] = __uint_as_float(u.w << 16); f[7] = __uint_as_float(u.w & 0xffff0000u);
}
DI uint4 pack8(const float (&f)[8]) {
  uint4 o;
  o.x = pk2(f[0], f[1]);
  o.y = pk2(f[2], f[3]);
  o.z = pk2(f[4], f[5]);
  o.w = pk2(f[6], f[7]);
  return o;
}
DI void ld8f(const float* ptr, float (&f)[8]) {
  const float4 a = *(const float4*)ptr, b = *(const float4*)(ptr + 4);
  f[0] = a.x; f[1] = a.y; f[2] = a.z; f[3] = a.w; f[4] = b.x; f[5] = b.y; f[6] = b.z; f[7] = b.w;
}
DI void shift8(const Params& p, int tok, int col, float (&o)[8]) {
  float c[8], pv[8], m[8];
  unpack8(*(const uint4*)(p.rw + (size_t)tok * 1664 + col), c);
  uint4 pu = make_uint4(0u, 0u, 0u, 0u);
  if (tok & 2047) pu = *(const uint4*)(p.rw + (size_t)(tok - 1) * 1664 + col);
  unpack8(pu, pv);
  ld8f(p.mu + col, m);
#pragma unroll
  for (int j = 0; j < 8; ++j) o[j] = c[j] + m[j] * (pv[j] - c[j]);
}

DI void rwkv_prep_tile(const Params& p, int tile, char* smem) {
  const int t0 = tile * 32;
  bf16_t* sW = (bf16_t*)smem;
  bf16_t* sAd = sW + 32 * 72;
  bf16_t* sA = sAd + 32 * 72;
  int tid = threadIdx.x;
  asm volatile("" : "+v"(tid));
  const int lane = tid & 63, wave = tid >> 6;
#pragma unroll
  for (int i = 0; i < 2; ++i) {
    const int idx = tid + 256 * i, m = idx >> 4, sg = idx & 15;
    float v[8];
    shift8(p, t0 + m, 1536 + sg * 8, v);
    if (sg < 8) {
#pragma unroll
      for (int j = 0; j < 8; ++j) v[j] = tanhf(v[j]);
      *(uint4*)(sW + m * 72 + sg * 8) = pack8(v);
    } else {
      *(uint4*)(sAd + m * 72 + (sg - 8) * 8) = pack8(v);
    }
  }
  __syncthreads();
  const int h5 = lane >> 5, cl = lane & 31;
#pragma unroll 1
  for (int sp = 0; sp < 8; ++sp) {
    const int pass = sp >> 2, ni = sp & 3;
    const bf16_t* As = pass ? sAd : sW;
    const bf16_t* Bt = pass ? p.AupT : p.WupT;
    const int n = wave * 128 + ni * 32 + cl;
    f32x16 acc;
#pragma unroll
    for (int i = 0; i < 16; ++i) acc[i] = 0.f;
#pragma unroll
    for (int ks = 0; ks < 4; ++ks) {
      bf16x8 af = *(const bf16x8*)(As + cl * 72 + ks * 16 + h5 * 8);
      bf16x8 bfr = *(const bf16x8*)(Bt + (size_t)n * 64 + ks * 16 + h5 * 8);
      acc = __builtin_amdgcn_mfma_f32_32x32x16_bf16(af, bfr, acc, 0, 0, 0);
    }
    if (pass == 0) {
      const float w0n = p.w0[n];
#pragma unroll
      for (int i = 0; i < 16; ++i) {
        const int tok = t0 + crow(i, h5);
        const float sg = 1.f / (1.f + __expf(-(w0n + acc[i])));
        p.dec[(size_t)tok * 512 + n] = __expf(-0.6065306597126334f * sg);
      }
    } else {
      const float a0n = p.a0[n];
#pragma unroll
      for (int i = 0; i < 16; ++i) sA[crow(i, h5) * 520 + n] = f2bf(1.f / (1.f + __expf(-(a0n + acc[i]))));
    }
  }
  __syncthreads();
#pragma unroll 1
  for (int i = 0; i < 8; ++i) {
    const int idx = tid + 256 * i, m = idx >> 6, ch0 = (idx & 63) * 8;
    const int tok = t0 + m;
    const size_t o = (size_t)tok * 512 + ch0;
    float rs[8], ks[8], vs[8], a[8], kkc[8], kac[8];
    shift8(p, tok, ch0, rs);
    shift8(p, tok, 512 + ch0, ks);
    shift8(p, tok, 1024 + ch0, vs);
    unpack8(*(const uint4*)(sA + m * 520 + ch0), a);
    ld8f(p.k_k + ch0, kkc);
    ld8f(p.k_a + ch0, kac);
    float kkr[8], ssq = 0.f;
#pragma unroll
    for (int j = 0; j < 8; ++j) { kkr[j] = ks[j] * kkc[j]; ssq += kkr[j] * kkr[j]; }
    ssq += __shfl_xor(ssq, 1);
    ssq += __shfl_xor(ssq, 2);
    ssq += __shfl_xor(ssq, 4);
    const float inv = 1.0f / fmaxf(sqrtf(ssq), 1e-12f);
    float kp[8], bb[8];
#pragma unroll
    for (int j = 0; j < 8; ++j) {
      kkr[j] *= inv;
      kp[j] = ks[j] * (1.f + (a[j] - 1.f) * kac[j]);
      bb[j] = kkr[j] * a[j];
    }
    *(uint4*)(p.rr + o) = pack8(rs);
    *(uint4*)(p.kp + o) = pack8(kp);
    *(uint4*)(p.vv + o) = pack8(vs);
    *(uint4*)(p.kk + o) = pack8(kkr);
    *(uint4*)(p.bb + o) = pack8(bb);
  }
  __syncthreads();
}

constexpr int SCH = 16;
constexpr int SSTR = 336;

DI void scan_item(const Params& p, int item, char* smem) {
  const int xcd = item & 7, slot = item >> 3;
  const int bh = xcd * 8 + (slot >> 2), rg = slot & 3;
  const int b = bh >> 3, h = bh & 7, row0 = rg * 16;
  float* buf = (float*)smem;
  float* ybuf = buf + 2 * SCH * SSTR;
  int tid = threadIdx.x;
  asm volatile("" : "+v"(tid));
  const int lane = tid & 63, wave = tid >> 6;
  const int q = lane >> 4, c = lane & 15, lr = wave * 4 + q;
  const size_t tokb = (size_t)b * 2048;

  const bf16_t* ap[2];
  int ast[2], aseg[2], aslot[2];
#pragma unroll
  for (int i = 0; i < 2; ++i) {
    int e = tid + 256 * i;
    int arr = e >> 7;
    ast[i] = (e >> 3) & 15;
    aseg[i] = e & 7;
    ap[i] = arr == 0 ? p.rr : arr == 1 ? p.kp : arr == 2 ? p.kk : p.bb;
    aslot[i] = arr == 0 ? 4 : arr;
  }
  const int dst_ = tid >> 4, dseg = tid & 15;
  const int vst = (tid >> 1) & 15, vseg = tid & 1;
  struct Stage { uint4 g0, g1, gv; float4 gd; };
  auto gload = [&](Stage& S, int ci) {
    const size_t s0 = tokb + (size_t)ci * SCH;
    S.g0 = *(const uint4*)(ap[0] + (s0 + ast[0]) * 512 + h * 64 + aseg[0] * 8);
    S.g1 = *(const uint4*)(ap[1] + (s0 + ast[1]) * 512 + h * 64 + aseg[1] * 8);
    S.gd = *(const float4*)(p.dec + (s0 + dst_) * 512 + h * 64 + dseg * 4);
    if (tid < 32) S.gv = *(const uint4*)(p.vv + (s0 + vst) * 512 + h * 64 + row0 + vseg * 8);
  };
  auto cvt8 = [&](uint4 u, float* d) {
    float4 a, b2;
    a.x = __uint_as_float(u.x << 16); a.y = __uint_as_float(u.x & 0xffff0000u);
    a.z = __uint_as_float(u.y << 16); a.w = __uint_as_float(u.y & 0xffff0000u);
    b2.x = __uint_as_float(u.z << 16); b2.y = __uint_as_float(u.z & 0xffff0000u);
    b2.z = __uint_as_float(u.w << 16); b2.w = __uint_as_float(u.w & 0xffff0000u);
    *(float4*)d = a;
    *(float4*)(d + 4) = b2;
  };
  auto sstore = [&](const Stage& S, int nbuf) {
    float* B = buf + nbuf * SCH * SSTR;
    cvt8(S.g0, B + ast[0] * SSTR + aslot[0] * 64 + aseg[0] * 8);
    cvt8(S.g1, B + ast[1] * SSTR + aslot[1] * 64 + aseg[1] * 8);
    *(float4*)(B + dst_ * SSTR + dseg * 4) = S.gd;
    if (tid < 32) cvt8(S.gv, B + vst * SSTR + 320 + vseg * 8);
  };

  f32x2_t sA = {0.f, 0.f}, sB = {0.f, 0.f};
  auto compute = [&](int ci, int cb) {
    const float* B = buf + cb * SCH * SSTR;
    float* Y = ybuf + cb * 256;
    const float* Lc = B + 4 * c;
    const float* Lv = B + 320 + lr;
    float4 w0_ = *(const float4*)(Lc), k0_ = *(const float4*)(Lc + 64), q0_ = *(const float4*)(Lc + 128),
           b0_ = *(const float4*)(Lc + 192), r0_ = *(const float4*)(Lc + 256);
    float v0_ = Lv[0];
    float4 w1_, k1_, q1_, b1_, r1_;
    float v1_;
    float pp;
    {
      const f32x2_t k0 = {q0_.x, q0_.y}, k1 = {q0_.z, q0_.w};
      f32x2_t pq = sA * k0;
      pq = sB * k1 + pq;
      pp = allred16(pq.x + pq.y);
    }
    float ysel = 0.f;
#define SCAN_STEP(W, K, BV, R, V, NW, NK, NQ, NB, NR, NV, ST)                                          \
  {                                                                                                    \
    if ((ST) + 1 < SCH) {                                                                              \
      NW = *(const float4*)(Lc + ((ST) + 1) * SSTR);                                                   \
      NK = *(const float4*)(Lc + ((ST) + 1) * SSTR + 64);                                              \
      NQ = *(const float4*)(Lc + ((ST) + 1) * SSTR + 128);                                             \
      NB = *(const float4*)(Lc + ((ST) + 1) * SSTR + 192);                                             \
      NR = *(const float4*)(Lc + ((ST) + 1) * SSTR + 256);                                             \
      NV = Lv[((ST) + 1) * SSTR];                                                                      \
    }                                                                                                  \
    const f32x2_t wa = {W.x, W.y}, wb = {W.z, W.w}, ka = {K.x, K.y}, kb = {K.z, K.w}, ba = {BV.x, BV.y}, \
                  bb2 = {BV.z, BV.w}, ra = {R.x, R.y}, rb = {R.z, R.w}, qa = {NQ.x, NQ.y}, qb = {NQ.z, NQ.w}; \
    const f32x2_t msa = {-pp, -pp}, vv2 = {V, V};                                                      \
    const f32x2_t t0 = ba * msa + ka * vv2, t1 = bb2 * msa + kb * vv2;                                 \
    sA = sA * wa + t0;                                                                                 \
    sB = sB * wb + t1;                                                                                 \
    f32x2_t yq = sA * ra;                                                                              \
    yq = sB * rb + yq;                                                                                 \
    f32x2_t pq = sA * qa;                                                                              \
    pq = sB * qb + pq;                                                                                 \
    float ys = yq.x + yq.y, ps = pq.x + pq.y;                                                          \
    ys += dppf<0xB1>(ys);  ps += dppf<0xB1>(ps);                                                       \
    ys += dppf<0x4E>(ys);  ps += dppf<0x4E>(ps);                                                       \
    ys += dppf<0x141>(ys); ps += dppf<0x141>(ps);                                                      \
    ys += dppf<0x128>(ys); ps += dppf<0x128>(ps);                                                      \
    pp = ps;                                                                                           \
    ysel = (c == (ST)) ? ys : ysel;                                                                    \
  }
#pragma unroll 2
    for (int st = 0; st < SCH; st += 2) {
      SCAN_STEP(w0_, k0_, b0_, r0_, v0_, w1_, k1_, q1_, b1_, r1_, v1_, st)
      SCAN_STEP(w1_, k1_, b1_, r1_, v1_, w0_, k0_, q0_, b0_, r0_, v0_, st + 1)
    }
#undef SCAN_STEP
    Y[c * 16 + lr] = ysel;
  };
  auto flush = [&](int ci, int cb) {
    const int st = tid >> 4, rr_ = tid & 15;
    p.yraw[(tokb + (size_t)ci * SCH + st) * 512 + h * 64 + row0 + rr_] = (ybuf + cb * 256)[tid];
  };

  constexpr int NCH = S_ / SCH;
  Stage SA, SB;
  gload(SA, 0);
  gload(SB, 1);
  sstore(SA, 0);
  __syncthreads();
  for (int ci = 0; ci < NCH; ci += 2) {
    if (ci + 2 < NCH) gload(SA, ci + 2);
    compute(ci, 0);
    sstore(SB, 1);
    __syncthreads();
    flush(ci, 0);
    if (ci + 3 < NCH) gload(SB, ci + 3);
    compute(ci + 1, 1);
    if (ci + 2 < NCH) sstore(SA, 0);
    __syncthreads();
    flush(ci + 1, 1);
  }
  __syncthreads();
}

using f32x4 = __attribute__((ext_vector_type(4))) float;
#define MFMA16(a, b, c) __builtin_amdgcn_mfma_f32_16x16x32_bf16((a), (b), (c), 0, 0, 0)
DI float ex2(float x) { return __builtin_amdgcn_exp2f(x); }
constexpr float SCL2 = 0.18033688011112042f;
constexpr float NEGB = -1e30f;

DI unsigned topk8(const float* imp, int tblk) {
  float v[32];
#pragma unroll
  for (int j = 0; j < 32; ++j) {
    float xv = imp[j];
    bool forced = (j == 0) | (j == tblk) | (j == tblk - 1);
    v[j] = (j <= tblk) ? (xv + (forced ? 1000.f : 0.f)) : -1.f;
  }
  unsigned sel = 0;
#pragma unroll
  for (int r = 0; r < 8; ++r) {
    float best = -3e38f;
    int bi = 0;
#pragma unroll
    for (int j = 0; j < 32; ++j) {
      bool ok = (((sel >> j) & 1u) == 0u) && (v[j] > best);
      best = ok ? v[j] : best;
      bi = ok ? j : bi;
    }
    sel |= 1u << bi;
  }
  return sel;
}

DI void head_step(const bf16x8& k00, const bf16x8& k01, const bf16x8& k10, const bf16x8& k11, const bf16x8& v0, const bf16x8& v1,
                  const bf16x8& v2, const bf16x8& v3, const bf16x8& q0, const bf16x8& q1, const float (&bias)[8], f32x4& O0,
                  f32x4& O1, f32x4& O2, f32x4& O3, float& m, float& l) {
  f32x4 sa = {0.f, 0.f, 0.f, 0.f}, sb = {0.f, 0.f, 0.f, 0.f};
  sa = MFMA16(k00, q0, sa);
  sb = MFMA16(k10, q0, sb);
  sa = MFMA16(k01, q1, sa);
  sb = MFMA16(k11, q1, sb);
  float sc[8];
  float cm = -3e38f;
#pragma unroll
  for (int e = 0; e < 8; ++e) {
    sc[e] = fmaf((e < 4) ? sa[e & 3] : sb[e & 3], SCL2, bias[e]);
    cm = fmaxf(cm, sc[e]);
  }
  if (__builtin_amdgcn_ballot_w64(cm > m) != 0ull) {
    cm = fmaxf(cm, __shfl_xor(cm, 16));
    cm = fmaxf(cm, __shfl_xor(cm, 32));
    const float mn = fmaxf(m, cm);
    const float alpha = ex2(m - mn);
    m = mn;
    l *= alpha;
    O0 *= alpha; O1 *= alpha; O2 *= alpha; O3 *= alpha;
  }
  float ps = 0.f;
  float pe[8];
#pragma unroll
  for (int e = 0; e < 8; ++e) {
    pe[e] = ex2(sc[e] - m);
    ps += pe[e];
  }
  l += ps;
  union { unsigned u[4]; bf16x8 v; } pk;
  pk.u[0] = pk2(pe[0], pe[1]); pk.u[1] = pk2(pe[2], pe[3]); pk.u[2] = pk2(pe[4], pe[5]); pk.u[3] = pk2(pe[6], pe[7]);
  O0 = MFMA16(v0, pk.v, O0);
  O1 = MFMA16(v1, pk.v, O1);
  O2 = MFMA16(v2, pk.v, O2);
  O3 = MFMA16(v3, pk.v, O3);
}

template <int MODE>
DI void attend(unsigned long long cmask, const bf16_t* __restrict__ Kb, const bf16_t* __restrict__ VT, const bf16x8* ql, int t,
               int t0, unsigned selmask, int n, int q4, f32x4 (&O)[4][4], float (&m)[4], float (&l)[4]) {
  const int krow = (n >> 2) * 8 + (n & 3);
  const bf16_t* Kl = Kb + (size_t)krow * 128 + q4 * 8;
  const bf16_t* Vl = VT + (size_t)n * VTS + q4 * 8;
  if (!cmask) return;
  int cur = __ffsll(cmask) - 1;
  cmask &= cmask - 1;
  bf16x8 k00, k01, k10, k11;
  {
    const bf16_t* kp_ = Kl + (size_t)cur * 32 * 128;
    k00 = *(const bf16x8*)(kp_); k01 = *(const bf16x8*)(kp_ + 32);
    k10 = *(const bf16x8*)(kp_ + 4 * 128); k11 = *(const bf16x8*)(kp_ + 4 * 128 + 32);
  }
  while (true) {
    int nxt = -1;
    if (cmask) { nxt = __ffsll(cmask) - 1; cmask &= cmask - 1; }
    bf16x8 n00, n01, n10, n11, v0, v1, v2, v3;
    {
      const bf16_t* vp_ = Vl + cur * 32;
      v0 = *(const bf16x8*)(vp_); v1 = *(const bf16x8*)(vp_ + 16 * VTS);
      v2 = *(const bf16x8*)(vp_ + 32 * VTS); v3 = *(const bf16x8*)(vp_ + 48 * VTS);
    }
    if (nxt >= 0) {
      const bf16_t* kp_ = Kl + (size_t)nxt * 32 * 128;
      n00 = *(const bf16x8*)(kp_); n01 = *(const bf16x8*)(kp_ + 32);
      n10 = *(const bf16x8*)(kp_ + 4 * 128); n11 = *(const bf16x8*)(kp_ + 4 * 128 + 32);
    }
    const int kb = cur * 32;
    const int key0 = kb + q4 * 8;
    bool blk = true;
    if (MODE == 1) blk = ((selmask >> (kb >> 6)) & 1u) != 0u;
    float bias[8];
#pragma unroll
    for (int e = 0; e < 8; ++e) {
      const int key = key0 + e;
      bool v = blk && (key <= t);
      if (MODE == 2) v = v && (key + 512 > t);
      bias[e] = v ? 0.f : NEGB;
    }
#pragma unroll
    for (int r = 0; r < 4; ++r) {
      const bf16x8 q0 = ql[(r * 2 + 0) * 64], q1 = ql[(r * 2 + 1) * 64];
      head_step(k00, k01, k10, k11, v0, v1, v2, v3, q0, q1, bias, O[r][0], O[r][1], O[r][2], O[r][3], m[r], l[r]);
      __builtin_amdgcn_sched_barrier(0);
    }
    if (nxt < 0) break;
    k00 = n00; k01 = n01; k10 = n10; k11 = n11;
    cur = nxt;
  }
}

constexpr int NSA_WFLOATS = 16 * 132 + 16 * 32;

__device__ void nsa_wave_item(const Params& p, int item, float* wl) {
  int tx_ = threadIdx.x;
  asm volatile("" : "+v"(tx_));
  const int lane = tx_ & 63, n = lane & 15, q4 = lane >> 4;
  const int bg = item & 15, tt = item >> 4;
  const int b = bg >> 1, g = bg & 1, t0 = tt * 16, t = t0 + n;
  const size_t tok = (size_t)b * 2048 + t;
  float* impb = wl + 2048;
  bf16x8* ql = (bf16x8*)wl + lane;
  const int krow = (n >> 2) * 8 + (n & 3);

#pragma unroll
  for (int r = 0; r < 4; ++r)
#pragma unroll
    for (int kd = 0; kd < 2; ++kd) ql[(r * 2 + kd) * 64] = *(const bf16x8*)(p.qb + tok * 512 + (g * 4 + r) * 64 + kd * 32 + q4 * 8);
  const float* gatep = p.glb + tok * 24 + g * 12;
  bf16_t* mixl = p.mix + tok * LDH + (g * 4) * 64 + q4 * 4;
  f32x4 Oc[4][4];

  {
    const bf16_t* Kc = p.kcmp + (size_t)bg * 128 * 64;
    const bf16_t* VcT = p.vcmpT + (size_t)bg * 64 * 128;
    const int nch = (t0 + 15 >= 31) ? ((min((t0 + 15 - 31) >> 4, 126) >> 5) + 1) : 0;
#pragma unroll
    for (int e = 0; e < 9; ++e) impb[lane * 9 + e] = 0.f;
    float m[4], l[4];
#pragma unroll
    for (int r = 0; r < 4; ++r) { m[r] = NEGB; l[r] = 0.f; }
#pragma unroll 1
    for (int ch = 0; ch < nch; ++ch) {
      const int kb = ch * 32;
      bf16x8 kf[2][2];
#pragma unroll
      for (int sub = 0; sub < 2; ++sub)
#pragma unroll
        for (int kd = 0; kd < 2; ++kd) kf[sub][kd] = *(const bf16x8*)(Kc + (size_t)(kb + krow + sub * 4) * 64 + kd * 32 + q4 * 8);
#pragma unroll
      for (int r = 0; r < 4; ++r) {
        f32x4 sa = {0.f, 0.f, 0.f, 0.f}, sb = {0.f, 0.f, 0.f, 0.f};
#pragma unroll
        for (int kd = 0; kd < 2; ++kd) {
          const bf16x8 qv = ql[(r * 2 + kd) * 64];
          sa = MFMA16(kf[0][kd], qv, sa);
          sb = MFMA16(kf[1][kd], qv, sb);
        }
        float sc[8];
        float cm = NEGB;
#pragma unroll
        for (int e = 0; e < 8; ++e) {
          const int c = kb + q4 * 8 + e;
          const bool v = (16 * c + 31 <= t);
          float x = ((e < 4) ? sa[e & 3] : sb[e & 3]) * SCL2;
          sc[e] = v ? x : NEGB;
          cm = fmaxf(cm, sc[e]);
        }
        cm = fmaxf(cm, __shfl_xor(cm, 16));
        cm = fmaxf(cm, __shfl_xor(cm, 32));
        const float mn = fmaxf(m[r], cm);
        float ps = 0.f;
#pragma unroll
        for (int e = 0; e < 8; ++e) ps += (sc[e] > -1e29f) ? ex2(sc[e] - mn) : 0.f;
        l[r] = l[r] * ex2(m[r] - mn) + ps;
        m[r] = mn;
        __builtin_amdgcn_sched_barrier(0);
      }
    }
    float inv[4];
#pragma unroll
    for (int r = 0; r < 4; ++r) {
      float lv = l[r];
      lv += __shfl_xor(lv, 16);
      lv += __shfl_xor(lv, 32);
      inv[r] = (lv > 0.f) ? 1.f / lv : 0.f;
    }
#pragma unroll
    for (int dt = 0; dt < 4; ++dt)
#pragma unroll
      for (int r = 0; r < 4; ++r) Oc[dt][r] = f32x4{0.f, 0.f, 0.f, 0.f};
#pragma unroll 1
    for (int ch = 0; ch < nch; ++ch) {
      const int kb = ch * 32;
      bf16x8 kf[2][2];
#pragma unroll
      for (int sub = 0; sub < 2; ++sub)
#pragma unroll
        for (int kd = 0; kd < 2; ++kd) kf[sub][kd] = *(const bf16x8*)(Kc + (size_t)(kb + krow + sub * 4) * 64 + kd * 32 + q4 * 8);
      bf16x8 vf[4];
#pragma unroll
      for (int dt = 0; dt < 4; ++dt) vf[dt] = *(const bf16x8*)(VcT + (size_t)(dt * 16 + n) * 128 + kb + q4 * 8);
      float psm[8];
#pragma unroll
      for (int e = 0; e < 8; ++e) psm[e] = 0.f;
      bf16x8 pf[4];
#pragma unroll
      for (int r = 0; r < 4; ++r) {
        f32x4 sa = {0.f, 0.f, 0.f, 0.f}, sb = {0.f, 0.f, 0.f, 0.f};
#pragma unroll
        for (int kd = 0; kd < 2; ++kd) {
          const bf16x8 qv = ql[(r * 2 + kd) * 64];
          sa = MFMA16(kf[0][kd], qv, sa);
          sb = MFMA16(kf[1][kd], qv, sb);
        }
        float pe[8];
#pragma unroll
        for (int e = 0; e < 8; ++e) {
          const int c = kb + q4 * 8 + e;
          const bool v = (16 * c + 31 <= t);
          float x = ((e < 4) ? sa[e & 3] : sb[e & 3]) * SCL2;
          pe[e] = v ? ex2(x - m[r]) * inv[r] : 0.f;
          psm[e] += pe[e];
        }
        union { unsigned u[4]; bf16x8 v; } pk;
        pk.u[0] = pk2(pe[0], pe[1]); pk.u[1] = pk2(pe[2], pe[3]); pk.u[2] = pk2(pe[4], pe[5]); pk.u[3] = pk2(pe[6], pe[7]);
        pf[r] = pk.v;
        __builtin_amdgcn_sched_barrier(0);
      }
      {
        float* ip = impb + n * 36 + (kb >> 2) + 2 * q4;
        ip[0] += psm[0] + psm[1] + psm[2] + 0.5f * psm[3];
        __builtin_amdgcn_fence(__ATOMIC_ACQ_REL, "workgroup");
        __builtin_amdgcn_wave_barrier();
        ip[1] += 0.5f * psm[3] + psm[4] + psm[5] + psm[6] + 0.5f * psm[7];
        __builtin_amdgcn_fence(__ATOMIC_ACQ_REL, "workgroup");
        __builtin_amdgcn_wave_barrier();
        ip[2] += 0.5f * psm[7];
        __builtin_amdgcn_fence(__ATOMIC_ACQ_REL, "workgroup");
        __builtin_amdgcn_wave_barrier();
      }
#pragma unroll
      for (int dt = 0; dt < 4; ++dt)
#pragma unroll
        for (int r = 0; r < 4; ++r) Oc[dt][r] = MFMA16(vf[dt], pf[r], Oc[dt][r]);
    }
  }
#pragma unroll
  for (int r = 0; r < 4; ++r) {
    const float gsc = gatep[r * 3 + 0];
#pragma unroll
    for (int dt = 0; dt < 4; ++dt) {
      uint2 o;
      o.x = pk2(Oc[dt][r][0] * gsc, Oc[dt][r][1] * gsc);
      o.y = pk2(Oc[dt][r][2] * gsc, Oc[dt][r][3] * gsc);
      *(uint2*)(mixl + r * 64 + dt * 16) = o;
    }
  }
  __builtin_amdgcn_fence(__ATOMIC_ACQ_REL, "workgroup");
  __builtin_amdgcn_wave_barrier();
  const int tblk = t0 >> 6;
  unsigned selmask = topk8(impb + n * 36, tblk);
  selmask &= (tblk >= 31) ? 0xffffffffu : ((1u << (tblk + 1)) - 1u);
  __builtin_amdgcn_wave_barrier();

#pragma unroll
  for (int r = 0; r < 4; ++r) {
    const bf16x8 q0 = ql[(r * 2 + 0) * 64];
    union { unsigned u[4]; bf16x8 v; } pk;
    float vals[8];
#pragma unroll
    for (int j = 0; j < 8; ++j) {
      float xv = bf2f((bf16_t)q0[j]);
      float ov = __shfl_xor(xv, 16);
      float2 cs = p.rope[t * 8 + j];
      vals[j] = (q4 == 0) ? (xv * cs.x - ov * cs.y) : ((q4 == 1) ? (xv * cs.x + ov * cs.y) : xv);
    }
    pk.u[0] = pk2(vals[0], vals[1]); pk.u[1] = pk2(vals[2], vals[3]); pk.u[2] = pk2(vals[4], vals[5]); pk.u[3] = pk2(vals[6], vals[7]);
    ql[(r * 2 + 0) * 64] = pk.v;
  }

#pragma unroll 1
  for (int br = 1; br <= 2; ++br) {
    unsigned long long cmask = 0ull;
    const int hic = (t0 + 15) >> 5;
    if (br == 1) {
      unsigned any = selmask;
#pragma unroll
      for (int o = 32; o >= 1; o >>= 1) any |= (unsigned)__shfl_xor((int)any, o);
      any = __builtin_amdgcn_readfirstlane(any);
      for (int j = 0; j <= tblk; ++j)
        if ((any >> j) & 1u) cmask |= 3ull << (2 * j);
      if (hic < 63) cmask &= (1ull << (hic + 1)) - 1ull;
    } else {
      const int lo = max(0, t0 - 511) >> 5;
      cmask = (hic < 63) ? ((1ull << (hic + 1)) - 1ull) : ~0ull;
      cmask &= ~((1ull << lo) - 1ull);
    }
    f32x4 O[4][4];
    float m[4], l[4];
#pragma unroll
    for (int dt = 0; dt < 4; ++dt)
#pragma unroll
      for (int r = 0; r < 4; ++r) O[r][dt] = f32x4{0.f, 0.f, 0.f, 0.f};
#pragma unroll
    for (int r = 0; r < 4; ++r) { m[r] = -1e29f; l[r] = 0.f; }
    if (br == 1)
      attend<1>(cmask, p.ksb + (size_t)b * 2048 * 128 + g * 64, p.vsT + (size_t)bg * 64 * VTS, ql, t, t0, selmask, n, q4, O, m, l);
    else
      attend<2>(cmask, p.kwb + (size_t)b * 2048 * 128 + g * 64, p.vwT + (size_t)bg * 64 * VTS, ql, t, t0, selmask, n, q4, O, m, l);
#pragma unroll
    for (int r = 0; r < 4; ++r) {
      float lv = l[r];
      lv += __shfl_xor(lv, 16);
      lv += __shfl_xor(lv, 32);
      const float gsc = gatep[r * 3 + br] * ((lv > 0.f) ? 1.f / lv : 0.f);
#pragma unroll
      for (int dt = 0; dt < 4; ++dt) {
        uint2* mp = (uint2*)(mixl + r * 64 + dt * 16);
        const uint2 u = *mp;
        float a0 = __uint_as_float(u.x << 16) + O[r][dt][0] * gsc, a1 = __uint_as_float(u.x & 0xffff0000u) + O[r][dt][1] * gsc;
        float a2 = __uint_as_float(u.y << 16) + O[r][dt][2] * gsc, a3 = __uint_as_float(u.y & 0xffff0000u) + O[r][dt][3] * gsc;
        if (br == 2) {
          const uint2 gg = *(const uint2*)(p.gns + tok * 512 + (g * 4 + r) * 64 + dt * 16 + q4 * 4);
          a0 *= __uint_as_float(gg.x << 16); a1 *= __uint_as_float(gg.x & 0xffff0000u);
          a2 *= __uint_as_float(gg.y << 16); a3 *= __uint_as_float(gg.y & 0xffff0000u);
        }
        uint2 o;
        o.x = pk2(a0, a1);
        o.y = pk2(a2, a3);
        *mp = o;
      }
    }
  }
}

DI void phase_mix_rwkv(const Params& p) {
  int tx = threadIdx.x;
  asm volatile("" : "+v"(tx));
  const int lane = tx & 63, sub = lane >> 4, c = lane & 15;
  const int gw = blockIdx.x * 4 + (tx >> 6), nw = gridDim.x * 4;
  for (int it = gw; it < T_ * 2; it += nw) {
    const int ph = it * 4 + sub;
    const int tok = ph >> 3, h = ph & 7;
    const int ch = h * 64 + c * 4;
    const size_t idx = (size_t)tok * 512 + ch;
    const float4 y = *(const float4*)(p.yraw + idx);
    const float mean = allred16(y.x + y.y + y.z + y.w) * (1.f / 64.f);
    const float d0 = y.x - mean, d1 = y.y - mean, d2 = y.z - mean, d3 = y.w - mean;
    const float var = allred16(d0 * d0 + d1 * d1 + d2 * d2 + d3 * d3) * (1.f / 64.f);
    const float rs = rsqrtf(var + 64e-5f);
    const float4 gw4 = *(const float4*)(p.gn_w + ch), gb4 = *(const float4*)(p.gn_b + ch), rk4 = *(const float4*)(p.r_k + ch);
    const uint2 ru = *(const uint2*)(p.rr + idx), ku = *(const uint2*)(p.kp + idx), vu = *(const uint2*)(p.vv + idx),
                gu = *(const uint2*)(p.grw + idx);
    const float r0 = __uint_as_float(ru.x << 16), r1 = __uint_as_float(ru.x & 0xffff0000u), r2 = __uint_as_float(ru.y << 16),
                r3 = __uint_as_float(ru.y & 0xffff0000u);
    const float k0 = __uint_as_float(ku.x << 16), k1 = __uint_as_float(ku.x & 0xffff0000u), k2 = __uint_as_float(ku.y << 16),
                k3 = __uint_as_float(ku.y & 0xffff0000u);
    const float v0 = __uint_as_float(vu.x << 16), v1 = __uint_as_float(vu.x & 0xffff0000u), v2 = __uint_as_float(vu.y << 16),
                v3 = __uint_as_float(vu.y & 0xffff0000u);
    const float g0 = __uint_as_float(gu.x << 16), g1 = __uint_as_float(gu.x & 0xffff0000u), g2 = __uint_as_float(gu.y << 16),
                g3 = __uint_as_float(gu.y & 0xffff0000u);
    const float bonus = allred16(r0 * k0 * rk4.x + r1 * k1 * rk4.y + r2 * k2 * rk4.z + r3 * k3 * rk4.w);
    uint2 o;
    o.x = pk2((d0 * rs * gw4.x + gb4.x + bonus * v0) * g0, (d1 * rs * gw4.y + gb4.y + bonus * v1) * g1);
    o.y = pk2((d2 * rs * gw4.z + gb4.z + bonus * v2) * g2, (d3 * rs * gw4.w + gb4.w + bonus * v3) * g3);
    *(uint2*)(p.mix + (size_t)tok * LDH + 512 + ch) = o;
  }
}

DI void phase_final_norm(const Params& p) {
  int tx = threadIdx.x;
  asm volatile("" : "+v"(tx));
  const int lane = tx & 63;
  const int gw = blockIdx.x * 4 + (tx >> 6), nw = gridDim.x * 4;
  const float4* fg = (const float4*)p.final_g;
  for (int row = gw; row < T_; row += nw) {
    float4* o4 = (float4*)(p.out + (size_t)row * 1024);
    float4 v[4];
    float ss = 0.f;
#pragma unroll
    for (int i = 0; i < 4; ++i) {
      v[i] = o4[i * 64 + lane];
      ss += v[i].x * v[i].x + v[i].y * v[i].y + v[i].z * v[i].z + v[i].w * v[i].w;
    }
    ss = wsum(ss);
    const float sc = rsqrtf(ss * (1.f / 1024.f) + 1e-6f);
#pragma unroll
    for (int i = 0; i < 4; ++i) {
      float4 gq = fg[i * 64 + lane];
      v[i].x *= sc * gq.x; v[i].y *= sc * gq.y; v[i].z *= sc * gq.z; v[i].w *= sc * gq.w;
      o4[i * 64 + lane] = v[i];
    }
  }
}

constexpr int NPHASE = 8;
constexpr int SMEM_BYTES = 65536;

template <int PH> DI void run_phase(const Params& p, char* smem) {
  const int bid = blockIdx.x, nb = gridDim.x;
  if (PH == 0) phase_prep(p, smem);
  if (PH == 1)
    for (int t = bid; t < 128 * 32; t += nb) gemm_tile<G_PROJ>(p, t >> 5, t & 31, 0, smem);
  if (PH == 2)
    if (nb > 128) {
      if (bid < 64) gemm_tile<G_CMP1>(p, (bid & 31) >> 1, bid & 1, bid >> 5, smem);
      else
        for (int t = bid - 64; t < 512; t += nb - 64) rwkv_prep_tile(p, t, smem);
    } else {
      for (int t = bid; t < 512 + 64; t += nb) {
        if (t < 64) gemm_tile<G_CMP1>(p, (t & 31) >> 1, t & 1, t >> 5, smem);
        else rwkv_prep_tile(p, t - 64, smem);
      }
    }
  if (PH == 3) {
    if (nb != 512)
      for (int t = bid; t < 32; t += nb) gemm_tile<G_CMP2>(p, t & 15, 0, t >> 4, smem);
  }
  if (PH == 4) {
    unsigned* flag = p.ctr + 40;
    if (nb == 512 && bid >= 256 && bid < 288) {
      const int t = bid - 256;
      gemm_tile<G_CMP2>(p, t & 15, 0, t >> 4, smem);
      asm volatile("s_waitcnt vmcnt(0)" ::: "memory");
      __syncthreads();
      if (threadIdx.x == 0) {
        __builtin_amdgcn_fence(__ATOMIC_RELEASE, "agent");
        asm volatile("s_waitcnt vmcnt(0)" ::: "memory");
        __hip_atomic_fetch_add(flag, 1u, __ATOMIC_RELAXED, __HIP_MEMORY_SCOPE_AGENT);
      }
    }
    for (int t = bid; t < 256; t += nb) scan_item(p, t, smem);
    if (nb == 512) {
      if (threadIdx.x == 0) {
        while (__hip_atomic_load(flag, __ATOMIC_RELAXED, __HIP_MEMORY_SCOPE_AGENT) < 32u) __builtin_amdgcn_s_sleep(2);
        __builtin_amdgcn_fence(__ATOMIC_ACQUIRE, "agent");
        asm volatile("s_waitcnt vmcnt(0)" ::: "memory");
      }
      __syncthreads();
    }
    float* wl = (float*)smem + (threadIdx.x >> 6) * NSA_WFLOATS;
    while (true) {
      int it = 0;
      if ((threadIdx.x & 63) == 0) it = (int)atomicAdd(p.ctr, 1u);
      it = __builtin_amdgcn_readfirstlane(it);
      if (it >= 2048) break;
      nsa_wave_item(p, (127 - (it >> 4)) * 16 + (it & 15), wl);
    }
  }
  if (PH == 5) phase_mix_rwkv(p);
  if (PH == 6)
    for (int t = bid; t < 128 * 8; t += nb) gemm_tile<G_OUT>(p, t >> 3, t & 7, 0, smem);
  if (PH == 7) phase_final_norm(p);
}

template <int PH> __global__ void __launch_bounds__(256, 2) phk(Params p) {
  __shared__ __attribute__((aligned(16))) char smem[SMEM_BYTES];
  run_phase<PH>(p, smem);
}

#ifndef PROBE_PH
#define PROBE_PH -1
#endif
#define XB_CNT(j) (256 + 64 * (j))
#define XB_SUB(j) (1280 + 64 * (j))
#define XB_GEN(j) (2304 + 64 * (j))
#define XB_TOP 3328
#define XB_TOPGEN 3392
DI unsigned xb_ld(unsigned* q) { return __hip_atomic_load(q, __ATOMIC_RELAXED, __HIP_MEMORY_SCOPE_AGENT); }
DI unsigned xb_add(unsigned* q, unsigned v) { return __hip_atomic_fetch_add(q, v, __ATOMIC_RELAXED, __HIP_MEMORY_SCOPE_AGENT); }
DI unsigned xb_xcc() { return (unsigned)__builtin_amdgcn_s_getreg((3 << 11) | 20) & 0xFu; }
DI void fast_barrier(unsigned* bar) {
  asm volatile("s_waitcnt vmcnt(0)" ::: "memory");
  __syncthreads();
  if (threadIdx.x == 0) {
    const unsigned x = xb_xcc();
    unsigned nloc, nx;
    for (;;) {
      unsigned sum = 0u;
      nloc = 1u;
      nx = 0u;
#pragma unroll
      for (unsigned j = 0; j < 16; ++j) {
        const unsigned c = xb_ld(&bar[XB_CNT(j)]);
        sum += c;
        nx += (c > 0u) ? 1u : 0u;
        nloc = (j == x) ? c : nloc;
      }
      if (sum == gridDim.x) break;
      __builtin_amdgcn_s_sleep(1);
    }
    const unsigned old = xb_add(&bar[XB_SUB(x)], 1u);
    const unsigned gen = old / nloc;
    if (old + 1u == (gen + 1u) * nloc) {
      __builtin_amdgcn_fence(__ATOMIC_RELEASE, "agent");
      asm volatile("s_waitcnt vmcnt(0)" ::: "memory");
      const unsigned og = xb_add(&bar[XB_TOP], 1u);
      const unsigned tg = og / nx;
      if (og + 1u == (tg + 1u) * nx) xb_add(&bar[XB_TOPGEN], 1u);
      else
        while (xb_ld(&bar[XB_TOPGEN]) == tg) __builtin_amdgcn_s_sleep(1);
      __builtin_amdgcn_fence(__ATOMIC_ACQUIRE, "agent");
      xb_add(&bar[XB_GEN(x)], 1u);
      asm volatile("s_waitcnt vmcnt(0)" ::: "memory");
    } else {
      while (xb_ld(&bar[XB_GEN(x)]) == gen) __builtin_amdgcn_s_sleep(1);
      __builtin_amdgcn_fence(__ATOMIC_ACQUIRE, "agent");
      asm volatile("s_waitcnt vmcnt(0)" ::: "memory");
    }
  }
  __syncthreads();
}

__global__ void __launch_bounds__(256, 2) mega(Params p) {
  __shared__ __attribute__((aligned(16))) char smem[SMEM_BYTES];
  cg::grid_group grid = cg::this_grid();
  unsigned* bar = p.xbar;
  const unsigned nblk = gridDim.x;
  if (p.ctr == nullptr) grid.sync();
  if (threadIdx.x == 0) (void)xb_add(&bar[XB_CNT(xb_xcc())], 1u);
  run_phase<0>(p, smem); fast_barrier(bar);
  run_phase<1>(p, smem); fast_barrier(bar);
  run_phase<2>(p, smem); fast_barrier(bar);
  if (nblk != 512u) { run_phase<3>(p, smem); fast_barrier(bar); }
  run_phase<4>(p, smem); fast_barrier(bar);
  run_phase<5>(p, smem); fast_barrier(bar);
  run_phase<6>(p, smem); fast_barrier(bar);
  run_phase<7>(p, smem);
}

extern "C" void kernel_launch(void* const* d_in, const int* in_sizes, int n_in, void* d_out, int out_size, void* d_ws, size_t ws_size,
                              hipStream_t stream) {
  Params p{};
  const float** pin = (const float**)&p;
  for (int i = 0; i < 21; ++i) pin[i] = (const float*)d_in[i];
  p.out = (float*)d_out;
  char* w = (char*)d_ws;
  size_t off = 0;
  auto alloc = [&](size_t bytes) { void* r = w + off; off += (bytes + 255) & ~(size_t)255; return r; };
  p.WinT = (bf16_t*)alloc((size_t)NPAD * LDW * 2);
  p.WoutT = (bf16_t*)alloc((size_t)1024 * LDW * 2);
  p.W1Tk = (bf16_t*)alloc((size_t)256 * LDW1 * 2);
  p.W1Tv = (bf16_t*)alloc((size_t)256 * LDW1 * 2);
  p.W2Tk = (bf16_t*)alloc((size_t)128 * LDW2 * 2);
  p.W2Tv = (bf16_t*)alloc((size_t)128 * LDW2 * 2);
  p.WupT = (bf16_t*)alloc((size_t)512 * 64 * 2);
  p.AupT = (bf16_t*)alloc((size_t)512 * 64 * 2);
  p.bias1k = (float*)alloc(256 * 4);
  p.bias1v = (float*)alloc(256 * 4);
  p.rope = (float2*)alloc((size_t)2048 * 8 * 8);
  p.qb = (bf16_t*)alloc((size_t)T_ * 512 * 2);
  p.kcb = (bf16_t*)alloc((size_t)(T_ + 16) * LDKC * 2);
  p.vcb = (bf16_t*)alloc((size_t)(T_ + 16) * LDKC * 2);
  p.ksb = (bf16_t*)alloc((size_t)T_ * 128 * 2);
  p.kwb = (bf16_t*)alloc((size_t)T_ * 128 * 2);
  p.vsb = nullptr;
  p.vwb = nullptr;
  p.vsT = (bf16_t*)alloc((size_t)16 * 64 * VTS * 2);
  p.vwT = (bf16_t*)alloc((size_t)16 * 64 * VTS * 2);
  p.glb = (float*)alloc((size_t)T_ * 24 * 4);
  p.gns = (bf16_t*)alloc((size_t)T_ * 512 * 2);
  p.rw = (bf16_t*)alloc((size_t)T_ * 1664 * 2);
  p.yraw = (float*)p.rw;
  p.grw = (bf16_t*)alloc((size_t)T_ * 512 * 2);
  p.hidk = (bf16_t*)alloc((size_t)2048 * LDHID * 2);
  p.hidv = (bf16_t*)alloc((size_t)2048 * LDHID * 2);
  p.kcmp = (bf16_t*)alloc((size_t)16 * 128 * 64 * 2);
  p.vcmp = (bf16_t*)alloc((size_t)16 * 128 * 64 * 2);
  p.vcmpT = (bf16_t*)alloc((size_t)16 * 128 * 64 * 2);
  p.rr = (bf16_t*)alloc((size_t)T_ * 512 * 2);
  p.kp = (bf16_t*)alloc((size_t)T_ * 512 * 2);
  p.vv = (bf16_t*)alloc((size_t)T_ * 512 * 2);
  p.mix = (bf16_t*)alloc((size_t)T_ * LDH * 2);
  p.hb = p.mix;
  p.ctr = (unsigned*)alloc(256);
  p.xbar = (unsigned*)alloc(16384);
  p.dec = (float*)d_out;
  p.kk = (bf16_t*)((char*)d_out + (size_t)T_ * 512 * 4);
  p.bb = (bf16_t*)((char*)d_out + (size_t)T_ * 512 * 6);
  if (off > ws_size) {
    fprintf(stderr, "workspace too small: need %zu have %zu\n", off, ws_size);
    return;
  }
#ifdef MULTI_LAUNCH
  hipLaunchKernelGGL(phk<0>, dim3(512), dim3(256), 0, stream, p);
  hipLaunchKernelGGL(phk<1>, dim3(512), dim3(256), 0, stream, p);
  hipLaunchKernelGGL(phk<2>, dim3(512), dim3(256), 0, stream, p);
  hipLaunchKernelGGL(phk<3>, dim3(512), dim3(256), 0, stream, p);
  hipLaunchKernelGGL(phk<4>, dim3(512), dim3(256), 0, stream, p);
  hipLaunchKernelGGL(phk<5>, dim3(512), dim3(256), 0, stream, p);
  hipLaunchKernelGGL(phk<6>, dim3(512), dim3(256), 0, stream, p);
  hipLaunchKernelGGL(phk<7>, dim3(512), dim3(256), 0, stream, p);
#else
  static int grid_blocks = 0;
  if (!grid_blocks) {
    int dev = 0, cus = 0, per_cu = 0;
    hipGetDevice(&dev);
    hipDeviceGetAttribute(&cus, hipDeviceAttributeMultiprocessorCount, dev);
    hipOccupancyMaxActiveBlocksPerMultiprocessor(&per_cu, mega, 256, 0);
    if (per_cu > 2) per_cu = 2;
    if (per_cu < 1) per_cu = 1;
    grid_blocks = cus * per_cu;
  }
  hipMemsetAsync(p.ctr, 0, 256 + 16384, stream);
  void* args[] = {&p};
  hipError_t e = hipLaunchCooperativeKernel((void*)mega, dim3(grid_blocks), dim3(256), args, 0, stream);
  if (e != hipSuccess) fprintf(stderr, "cooperative launch failed: %s (grid %d)\n", hipGetErrorString(e), grid_blocks);
#endif
}
```

```cpp
#include <hip/hip_runtime.h>
#include <hip/hip_bf16.h>
#include <hip/hip_cooperative_groups.h>
#include <cstdio>
namespace cg = cooperative_groups;


typedef unsigned short bf16_t;
using bf16x8 = __attribute__((ext_vector_type(8))) short;
using f32x16 = __attribute__((ext_vector_type(16))) float;

#define DI __device__ __forceinline__

constexpr int T_ = 16384, S_ = 2048;
constexpr int NPAD = 4096;
constexpr int LDH = 1088, LDW = 1088, LDW1 = 2112, LDHID = 320, LDW2 = 320, LDKC = 136, VTS = 2112;

typedef __bf16 bf16x2_t __attribute__((ext_vector_type(2)));
typedef float f32x2_t __attribute__((ext_vector_type(2)));
DI unsigned pk2(float a, float b) {
  f32x2_t v = {a, b};
  return __builtin_bit_cast(unsigned, __builtin_convertvector(v, bf16x2_t));
}
DI bf16_t f2bf(float x) { return (bf16_t)(pk2(x, 0.f) & 0xffffu); }
DI float bf2f(bf16_t b) { return __uint_as_float(((unsigned)b) << 16); }
DI float sigmoidf_(float x) { return 1.f / (1.f + __expf(-x)); }
DI float siluf_(float x) { return x / (1.f + __expf(-x)); }
DI float wsum(float x) {
#pragma unroll
  for (int o = 32; o >= 1; o >>= 1) x += __shfl_xor(x, o);
  return x;
}
DI float wmax(float x) {
#pragma unroll
  for (int o = 32; o >= 1; o >>= 1) x = fmaxf(x, __shfl_xor(x, o));
  return x;
}
template <int CTRL> DI float dppf(float x) {
  return __int_as_float(__builtin_amdgcn_update_dpp(0, __float_as_int(x), CTRL, 0xf, 0xf, true));
}
DI float allred16(float x) {
  x += dppf<0xB1>(x);
  x += dppf<0x4E>(x);
  x += dppf<0x141>(x);
  x += dppf<0x128>(x);
  return x;
}

struct Params {
  const float *x, *norm_g, *w_in, *pos_k, *w1_k, *w2_k, *pos_v, *w1_v, *w2_v, *mu, *w0, *w_up, *a0, *a_up, *k_k, *k_a, *r_k,
      *gn_w, *gn_b, *w_out, *final_g;
  float* out;
  bf16_t *WinT, *WoutT, *W1Tk, *W1Tv, *W2Tk, *W2Tv, *WupT, *AupT;
  float *bias1k, *bias1v;
  float2* rope;
  bf16_t *qb, *kcb, *vcb, *ksb, *kwb, *vsb, *vwb, *vsT, *vwT;
  float* glb;
  bf16_t *gns, *rw, *grw, *hidk, *hidv, *kcmp, *vcmp, *vcmpT;
  bf16_t *rr, *kp, *vv, *kk, *bb;
  float *dec, *yraw;
  bf16_t* mix;
  bf16_t* hb;
  unsigned* ctr;
  unsigned* xbar;
};

DI void transpose_tile(const float* __restrict__ src, int ldsrc, bf16_t* __restrict__ dst, int ldd, int k0, int n0, const float* scale,
                       int mapmode, int nvalid, float* tile) {
  const int tid = threadIdx.x;
#pragma unroll
  for (int i = 0; i < 4; ++i) {
    const int idx = tid + 256 * i, kl = idx >> 4, ng = (idx & 15) * 4;
    const int n = n0 + ng;
    int on;
    if (mapmode == 1) on = (n < 1304) ? n : (n < 1408 ? -1 : n - 104);
    else on = (n < nvalid) ? n : -1;
    float4 v = make_float4(0.f, 0.f, 0.f, 0.f);
    if (on >= 0) {
      v = *(const float4*)(src + (size_t)(k0 + kl) * ldsrc + on);
      if (scale) {
        const float sc = scale[k0 + kl];
        v.x *= sc; v.y *= sc; v.z *= sc; v.w *= sc;
      }
    }
    float* t = tile + kl * 65 + ng;
    t[0] = v.x; t[1] = v.y; t[2] = v.z; t[3] = v.w;
  }
  __syncthreads();
#pragma unroll
  for (int i = 0; i < 2; ++i) {
    const int idx = tid + 256 * i, nl = idx >> 3, kg = (idx & 7) * 8;
    uint4 o;
    o.x = pk2(tile[(kg + 0) * 65 + nl], tile[(kg + 1) * 65 + nl]);
    o.y = pk2(tile[(kg + 2) * 65 + nl], tile[(kg + 3) * 65 + nl]);
    o.z = pk2(tile[(kg + 4) * 65 + nl], tile[(kg + 5) * 65 + nl]);
    o.w = pk2(tile[(kg + 6) * 65 + nl], tile[(kg + 7) * 65 + nl]);
    *(uint4*)(dst + (size_t)(n0 + nl) * ldd + k0 + kg) = o;
  }
  __syncthreads();
}

DI void phase_prep(const Params& p, char* smem) {
  float* tile = (float*)smem;
  const int nb = gridDim.x, bid = blockIdx.x, tid = threadIdx.x;
  {
    const int lane = tid & 63;
    for (int row = bid * 4 + (tid >> 6); row < T_; row += nb * 4) {
      const float4* x4 = (const float4*)(p.x + (size_t)row * 1024);
      float4 v[4];
      float ss = 0.f;
#pragma unroll
      for (int i = 0; i < 4; ++i) {
        v[i] = x4[i * 64 + lane];
        ss += v[i].x * v[i].x + v[i].y * v[i].y + v[i].z * v[i].z + v[i].w * v[i].w;
      }
      ss = wsum(ss);
      const float sc = rsqrtf(ss * (1.f / 1024.f) + 1e-6f);
      uint2* h2 = (uint2*)(p.hb + (size_t)row * LDH);
#pragma unroll
      for (int i = 0; i < 4; ++i) {
        uint2 o;
        o.x = pk2(v[i].x * sc, v[i].y * sc);
        o.y = pk2(v[i].z * sc, v[i].w * sc);
        h2[i * 64 + lane] = o;
      }
    }
  }
  const int n_win = 16 * 64, n_wout = 16 * 16, n_w1 = 32 * 4, n_w2 = 4 * 2, n_lora = 1 * 8;
  const int o1 = n_win, o2 = o1 + n_wout, o3 = o2 + n_w1, o4 = o3 + n_w1, o5 = o4 + n_w2, o6 = o5 + n_w2, o7 = o6 + n_lora,
            o8 = o7 + n_lora, o9 = o8 + 128, o10 = o9 + 16;
  for (int it = bid; it < o10; it += nb) {
    if (it < o1) {
      int kt = it & 15, nt = it >> 4;
      transpose_tile(p.w_in, 3992, p.WinT, LDW, kt * 64, nt * 64, p.norm_g, 1, 0, tile);
    } else if (it < o2) {
      int j = it - o1, kt = j & 15, nt = j >> 4;
      transpose_tile(p.w_out, 1024, p.WoutT, LDW, kt * 64, nt * 64, nullptr, 0, 1024, tile);
    } else if (it < o3) {
      int j = it - o2, kt = j & 31, nt = j >> 5;
      transpose_tile(p.w1_k, 256, p.W1Tk, LDW1, kt * 64, nt * 64, nullptr, 0, 256, tile);
    } else if (it < o4) {
      int j = it - o3, kt = j & 31, nt = j >> 5;
      transpose_tile(p.w1_v, 256, p.W1Tv, LDW1, kt * 64, nt * 64, nullptr, 0, 256, tile);
    } else if (it < o5) {
      int j = it - o4, kt = j & 3, nt = j >> 2;
      transpose_tile(p.w2_k, 64, p.W2Tk, LDW2, kt * 64, nt * 64, nullptr, 0, 64, tile);
    } else if (it < o6) {
      int j = it - o5, kt = j & 3, nt = j >> 2;
      transpose_tile(p.w2_v, 64, p.W2Tv, LDW2, kt * 64, nt * 64, nullptr, 0, 64, tile);
    } else if (it < o7) {
      int nt = it - o6;
      transpose_tile(p.w_up, 512, p.WupT, 64, 0, nt * 64, nullptr, 0, 512, tile);
    } else if (it < o8) {
      int nt = it - o7;
      transpose_tile(p.a_up, 512, p.AupT, 64, 0, nt * 64, nullptr, 0, 512, tile);
    } else if (it < o9) {
      const int j = it - o8, which = j >> 6, n0 = (j & 63) * 4;
      const float* pos = which ? p.pos_v : p.pos_k;
      const float* w1 = which ? p.w1_v : p.w1_k;
      float* bo = which ? p.bias1v : p.bias1k;
      const int kp = tid >> 2, nn = tid & 3;
      float a = 0.f;
#pragma unroll 16
      for (int k = kp * 32; k < kp * 32 + 32; ++k) a += pos[k] * w1[(size_t)k * 256 + n0 + nn];
      tile[tid] = a;
      __syncthreads();
      if (tid < 4) {
        float sum = 0.f;
        for (int q = 0; q < 64; ++q) sum += tile[q * 4 + tid];
        bo[n0 + tid] = sum;
      }
      __syncthreads();
    } else {
      int j = it - o9;
      for (int e = tid; e < 1024; e += 256) {
        int idx = j * 1024 + e;
        int pos = idx >> 3, i = idx & 7;
        float inv = powf(500000.0f, -(float)i / 8.0f);
        float ang = (float)pos * inv;
        float sn, cs;
        sincosf(ang, &sn, &cs);
        p.rope[idx] = make_float2(cs, sn);
      }
    }
  }
}

constexpr int LDT = 40;

DI int crow(int i, int h) { return (i & 3) + 8 * (i >> 2) + 4 * h; }

enum { G_PROJ = 0, G_CMP1 = 1, G_CMP2 = 2, G_OUT = 3 };

template <int MODE, bool EPI = true>
DI void gemm_tile(const Params& p, int mt, int nt, int which, char* smem) {
  constexpr int K = (MODE == G_PROJ) ? 1024 : (MODE == G_CMP1) ? 2048 : (MODE == G_CMP2) ? 256 : 1024;
  constexpr int LDA = (MODE == G_PROJ) ? LDH : (MODE == G_CMP1) ? LDKC : (MODE == G_CMP2) ? LDHID : LDH;
  constexpr int LDB = (MODE == G_PROJ) ? LDW : (MODE == G_CMP1) ? LDW1 : (MODE == G_CMP2) ? LDW2 : LDW;
  const int tid = threadIdx.x, lane = tid & 63, wave = tid >> 6;
  const int wm = wave >> 1, wn = wave & 1;
  const int m0 = mt * 128, n0 = nt * 128;

  const bf16_t* Bt;
  const bf16_t* Ab;
  if (MODE == G_PROJ) { Bt = p.WinT; Ab = p.hb; }
  else if (MODE == G_CMP1) { Bt = which ? p.W1Tv : p.W1Tk; Ab = which ? p.vcb : p.kcb; }
  else if (MODE == G_CMP2) { Bt = which ? p.W2Tv : p.W2Tk; Ab = which ? p.hidv : p.hidk; }
  else { Bt = p.WoutT; Ab = p.mix; }

  const int lrr = lane >> 2;
  const int lks = (lane & 3) ^ ((lane >> 4) & 3);
  unsigned aoA, aoB, boA;
  {
    const int r0 = m0 + (2 * wave) * 16 + lrr, r1 = r0 + 16;
    if (MODE == G_CMP1) {
      aoA = (unsigned)(r0 >> 1) * (16 * LDA) + (r0 & 1) * 64;
      aoB = (unsigned)(r1 >> 1) * (16 * LDA) + (r1 & 1) * 64;
    } else {
      aoA = (unsigned)r0 * LDA;
      aoB = (unsigned)r1 * LDA;
    }
    boA = (unsigned)(n0 + (2 * wave) * 16 + lrr) * LDB + lks * 8;
  }
  char* ldsw = smem + (2 * wave) * 1024;
  auto glds = [&](int kt) __attribute__((always_inline)) {
    char* st = ldsw + (kt & 3) * 16384;
    const int k_ = kt * 32 + lks * 8;
    const unsigned ko_ = (MODE == G_CMP1) ? ((unsigned)(k_ >> 6) * LDA + (k_ & 63)) : (unsigned)k_;
    __builtin_amdgcn_global_load_lds((const unsigned*)(Ab + (aoA + ko_)), (__attribute__((address_space(3))) unsigned*)(st), 16, 0, 0);
    __builtin_amdgcn_global_load_lds((const unsigned*)(Ab + (aoB + ko_)), (__attribute__((address_space(3))) unsigned*)(st + 1024), 16, 0, 0);
    __builtin_amdgcn_global_load_lds((const unsigned*)(Bt + (boA + kt * 32)), (__attribute__((address_space(3))) unsigned*)(st + 8192), 16, 0, 0);
    __builtin_amdgcn_global_load_lds((const unsigned*)(Bt + (boA + 16 * LDB + kt * 32)), (__attribute__((address_space(3))) unsigned*)(st + 8192 + 1024), 16, 0, 0);
  };

  f32x16 acc[2][2];
#pragma unroll
  for (int a = 0; a < 2; ++a)
#pragma unroll
    for (int b = 0; b < 2; ++b)
#pragma unroll
      for (int i = 0; i < 16; ++i) acc[a][b][i] = 0.f;

  const int frr = lane & 15, fhi = (lane >> 4) & 1, fq = lane >> 5;
  const int offA0 = ((wm * 64) >> 4) * 1024 + fhi * 1024 + frr * 64;
  const int offB0 = 8192 + ((wn * 64) >> 4) * 1024 + fhi * 1024 + frr * 64;
  const int fsw = (frr >> 2) & 3;
  bf16x8 fa0_0, fa0_1, fb0_0, fb0_1, fa1_0, fa1_1, fb1_0, fb1_1;
  bf16x8 ga0_0, ga0_1, gb0_0, gb0_1, ga1_0, ga1_1, gb1_0, gb1_1;
  const unsigned lbase = (unsigned)(size_t)(__attribute__((address_space(3))) char*)smem;
  const unsigned adA0 = lbase + offA0 + ((0 * 2 + fq) ^ fsw) * 16, adA1 = lbase + offA0 + ((1 * 2 + fq) ^ fsw) * 16;
  const unsigned adB0 = lbase + offB0 + ((0 * 2 + fq) ^ fsw) * 16, adB1 = lbase + offB0 + ((1 * 2 + fq) ^ fsw) * 16;
#define DSR(DST, AD, OFF) asm volatile("ds_read_b128 %0, %1 offset:%2" : "=v"(DST) : "v"(AD), "n"(OFF))
#define FRAG_LOAD_STG(P, SO)                \
  {                                         \
    DSR(P##a0_0, adA0, (SO));               \
    DSR(P##a0_1, adA0, (SO) + 2048);        \
    DSR(P##b0_0, adB0, (SO));               \
    DSR(P##b0_1, adB0, (SO) + 2048);        \
    DSR(P##a1_0, adA1, (SO));               \
    DSR(P##a1_1, adA1, (SO) + 2048);        \
    DSR(P##b1_0, adB1, (SO));               \
    DSR(P##b1_1, adB1, (SO) + 2048);        \
  }
#define FRAG_LOAD(P, STG)                               \
  {                                                     \
    const int stg_ = (STG);                             \
    if (stg_ == 0) FRAG_LOAD_STG(P, 0)                  \
    else if (stg_ == 1) FRAG_LOAD_STG(P, 16384)         \
    else if (stg_ == 2) FRAG_LOAD_STG(P, 32768)         \
    else FRAG_LOAD_STG(P, 49152)                        \
  }
#define FRAG_MMA(P)                                                                                     \
  {                                                                                                     \
    acc[0][0] = __builtin_amdgcn_mfma_f32_32x32x16_bf16(P##a0_0, P##b0_0, acc[0][0], 0, 0, 0);          \
    acc[0][1] = __builtin_amdgcn_mfma_f32_32x32x16_bf16(P##a0_0, P##b0_1, acc[0][1], 0, 0, 0);          \
    acc[1][0] = __builtin_amdgcn_mfma_f32_32x32x16_bf16(P##a0_1, P##b0_0, acc[1][0], 0, 0, 0);          \
    acc[1][1] = __builtin_amdgcn_mfma_f32_32x32x16_bf16(P##a0_1, P##b0_1, acc[1][1], 0, 0, 0);          \
    acc[0][0] = __builtin_amdgcn_mfma_f32_32x32x16_bf16(P##a1_0, P##b1_0, acc[0][0], 0, 0, 0);          \
    acc[0][1] = __builtin_amdgcn_mfma_f32_32x32x16_bf16(P##a1_0, P##b1_1, acc[0][1], 0, 0, 0);          \
    acc[1][0] = __builtin_amdgcn_mfma_f32_32x32x16_bf16(P##a1_1, P##b1_0, acc[1][0], 0, 0, 0);          \
    acc[1][1] = __builtin_amdgcn_mfma_f32_32x32x16_bf16(P##a1_1, P##b1_1, acc[1][1], 0, 0, 0);          \
  }
#define NEXT_TILE(P, KT1, STG)                                                     \
  {                                                                                \
    if ((KT1) + 2 <= KT - 1) asm volatile("s_waitcnt vmcnt(8)" ::: "memory");      \
    else if ((KT1) + 1 == KT - 1) asm volatile("s_waitcnt vmcnt(4)" ::: "memory"); \
    else asm volatile("s_waitcnt vmcnt(0)" ::: "memory");                          \
    asm volatile("s_waitcnt lgkmcnt(0)" ::: "memory");                             \
    __builtin_amdgcn_s_barrier();                                                  \
    if ((KT1) + 3 < KT) glds((KT1) + 3);                                           \
    FRAG_LOAD(P, STG)                                                              \
  }

  constexpr int KT = K / 32;
  static_assert(KT % 2 == 0, "k-tile count must be even");
  asm volatile("s_waitcnt vmcnt(0)" ::: "memory");
  glds(0);
  glds(1);
  glds(2);
  asm volatile("s_waitcnt vmcnt(8)" ::: "memory");
  asm volatile("s_waitcnt lgkmcnt(0)" ::: "memory");
  __builtin_amdgcn_s_barrier();
  glds(3);
  FRAG_LOAD(f, 0)
  static_assert(KT % 4 == 0, "k-tile count must be a multiple of the ring depth");
#pragma unroll 1
  for (int kt = 0; kt < KT; kt += 4) {
    NEXT_TILE(g, kt + 1, 1)
    FRAG_MMA(f)
    NEXT_TILE(f, kt + 2, 2)
    FRAG_MMA(g)
    NEXT_TILE(g, kt + 3, 3)
    FRAG_MMA(f)
    if (kt + 4 < KT) {
      NEXT_TILE(f, kt + 4, 0)
    } else {
      asm volatile("s_waitcnt lgkmcnt(0)" ::: "memory");
    }
    FRAG_MMA(g)
  }
#undef NEXT_TILE
#undef FRAG_MMA
#undef FRAG_LOAD
#undef FRAG_LOAD_STG
#undef DSR
  asm volatile("s_waitcnt lgkmcnt(0)" ::: "memory");
  __builtin_amdgcn_s_barrier();

  if (!EPI) {
    float sacc = 0.f;
#pragma unroll
    for (int a = 0; a < 2; ++a)
#pragma unroll
      for (int b = 0; b < 2; ++b)
#pragma unroll
        for (int i = 0; i < 16; ++i) sacc += acc[a][b][i];
    if (sacc == 12345.678f) p.ctr[8] = 1u;
    return;
  }
  int tide = tid;
  asm volatile("" : "+v"(tide));
  const int lane_e = tide & 63;
  const int h5 = lane_e >> 5, cl = lane_e & 31;
  auto each = [&](auto&& f) __attribute__((always_inline)) {
#pragma unroll
    for (int mi = 0; mi < 2; ++mi)
#pragma unroll
      for (int ni = 0; ni < 2; ++ni)
#pragma unroll
        for (int i = 0; i < 16; ++i) {
          const int rl = wm * 64 + mi * 32 + crow(i, h5);
          f(ni, rl, m0 + rl, n0 + wn * 64 + ni * 32 + cl, acc[mi][ni][i]);
        }
  };
  if (MODE == G_PROJ) {
    const int ct = nt;
    if (ct == 10) {
      each([&](int ni, int rl, int row, int col, float v) {
        const int c2 = col - 1280;
        if (c2 < 24) p.glb[(size_t)row * 24 + c2] = sigmoidf_(v);
      });
    } else {
      bf16_t* tl = (bf16_t*)smem;
      if (ct == 6 || ct == 8) {
        each([&](int ni, int rl, int row, int col, float v) {
          if (ni == 0) {
            float other = __shfl_xor(v, 8);
            if (cl < 16) {
              float2 cs = p.rope[(row & 2047) * 8 + (cl & 7)];
              v = (cl < 8) ? (v * cs.x - other * cs.y) : (v * cs.x + other * cs.y);
            }
          }
          tl[rl * 136 + (col - n0)] = f2bf(v);
        });
      } else if ((ct >= 11 && ct < 15) || ct >= 28) {
        each([&](int ni, int rl, int row, int col, float v) { tl[rl * 136 + (col - n0)] = f2bf(siluf_(v)); });
      } else {
        each([&](int ni, int rl, int row, int col, float v) { tl[rl * 136 + (col - n0)] = f2bf(v); });
      }
      __syncthreads();
      if (ct == 7 || ct == 9) {
        bf16_t* d2 = (ct == 7) ? p.vsT : p.vwT;
        const int b = m0 >> 11, s0 = m0 & 2047;
#pragma unroll
        for (int i = 0; i < 8; ++i) {
          const int idx = tide + 256 * i;
          const int c2 = idx & 127, rseg = idx >> 7;
          unsigned short e[8];
#pragma unroll
          for (int j = 0; j < 8; ++j) e[j] = tl[(rseg * 8 + j) * 136 + c2];
          uint4 o;
          o.x = e[0] | ((unsigned)e[1] << 16); o.y = e[2] | ((unsigned)e[3] << 16);
          o.z = e[4] | ((unsigned)e[5] << 16); o.w = e[6] | ((unsigned)e[7] << 16);
          *(uint4*)(d2 + ((size_t)((b * 2 + (c2 >> 6)) * 64 + (c2 & 63))) * VTS + s0 + rseg * 8) = o;
        }
      } else {
        bf16_t* dst;
        int ld, cb;
        if (ct < 4) { dst = p.qb; ld = 512; cb = n0; }
        else if (ct == 4) { dst = p.kcb; ld = LDKC; cb = 0; }
        else if (ct == 5) { dst = p.vcb; ld = LDKC; cb = 0; }
        else if (ct == 6) { dst = p.ksb; ld = 128; cb = 0; }
        else if (ct == 8) { dst = p.kwb; ld = 128; cb = 0; }
        else if (ct < 15) { dst = p.gns; ld = 512; cb = n0 - 1408; }
        else if (ct < 28) { dst = p.rw; ld = 1664; cb = n0 - 1920; }
        else { dst = p.grw; ld = 512; cb = n0 - 3584; }
#pragma unroll
        for (int i = 0; i < 8; ++i) {
          const int idx = tide + 256 * i;
          const int r = idx >> 4, sg = idx & 15;
          const uint4 v4 = *(const uint4*)(tl + r * 136 + sg * 8);
          *(uint4*)(dst + (size_t)(m0 + r) * ld + cb + sg * 8) = v4;
        }
      }
    }
  } else if (MODE == G_CMP1) {
    const float* bias = which ? p.bias1v : p.bias1k;
    bf16_t* hid = which ? p.hidv : p.hidk;
    each([&](int ni, int rl, int row, int col, float v) { hid[(size_t)row * LDHID + col] = f2bf(siluf_(v + bias[col])); });
  } else if (MODE == G_CMP2) {
    each([&](int ni, int rl, int row, int col, float v) {
      if (col < 64) {
        const int b = row >> 8, c = (row >> 1) & 127, g = row & 1;
        const int bg = b * 2 + g;
        bf16_t hv = (c < 127) ? f2bf(v) : (bf16_t)0;
        if (which == 0) {
          p.kcmp[((size_t)bg * 128 + c) * 64 + col] = hv;
        } else {
          p.vcmp[((size_t)bg * 128 + c) * 64 + col] = hv;
          p.vcmpT[((size_t)bg * 64 + col) * 128 + c] = hv;
        }
      }
    });
  } else {
    float xv[2][2][16];
#pragma unroll
    for (int mi = 0; mi < 2; ++mi)
#pragma unroll
      for (int ni = 0; ni < 2; ++ni)
#pragma unroll
        for (int i = 0; i < 16; ++i)
          xv[mi][ni][i] = p.x[(size_t)(m0 + wm * 64 + mi * 32 + crow(i, h5)) * 1024 + n0 + wn * 64 + ni * 32 + cl];
#pragma unroll
    for (int mi = 0; mi < 2; ++mi)
#pragma unroll
      for (int ni = 0; ni < 2; ++ni)
#pragma unroll
        for (int i = 0; i < 16; ++i)
          p.out[(size_t)(m0 + wm * 64 + mi * 32 + crow(i, h5)) * 1024 + n0 + wn * 64 + ni * 32 + cl] = xv[mi][ni][i] + acc[mi][ni][i];
  }
  __syncthreads();
}

DI float shiftv(const Params& p, int tok, int col) {
  float cur = bf2f(p.rw[(size_t)tok * 1664 + col]);
  float prev = (tok & 2047) ? bf2f(p.rw[(size_t)(tok - 1) * 1664 + col]) : 0.f;
  return cur + p.mu[col] * (prev - cur);
}

DI void unpack8(uint4 u, float (&f)[8]) {
  f[0] = __uint_as_float(u.x << 16); f[1] = __uint_as_float(u.x & 0xffff0000u);
  f[2] = __uint_as_float(u.y << 16); f[3] = __uint_as_float(u.y & 0xffff0000u);
  f[4] = __uint_as_float(u.z << 16); f[5] = __uint_as_float(u.z & 0xffff0000u);
  f[6] = __uint_as_float(u.w << 16); f[7] = __uint_as_float(u.w & 0xffff0000u);
}
DI uint4 pack8(const float (&f)[8]) {
  uint4 o;
  o.x = pk2(f[0], f[1]);
  o.y = pk2(f[2], f[3]);
  o.z = pk2(f[4], f[5]);
  o.w = pk2(f[6], f[7]);
  return o;
}
DI void ld8f(const float* ptr, float (&f)[8]) {
  const float4 a = *(const float4*)ptr, b = *(const float4*)(ptr + 4);
  f[0] = a.x; f[1] = a.y; f[2] = a.z; f[3] = a.w; f[4] = b.x; f[5] = b.y; f[6] = b.z; f[7] = b.w;
}
DI void shift8(const Params& p, int tok, int col, float (&o)[8]) {
  float c[8], pv[8], m[8];
  unpack8(*(const uint4*)(p.rw + (size_t)tok * 1664 + col), c);
  uint4 pu = make_uint4(0u, 0u, 0u, 0u);
  if (tok & 2047) pu = *(const uint4*)(p.rw + (size_t)(tok - 1) * 1664 + col);
  unpack8(pu, pv);
  ld8f(p.mu + col, m);
#pragma unroll
  for (int j = 0; j < 8; ++j) o[j] = c[j] + m[j] * (pv[j] - c[j]);
}

DI void rwkv_prep_tile(const Params& p, int tile, char* smem) {
  const int t0 = tile * 32;
  bf16_t* sW = (bf16_t*)smem;
  bf16_t* sAd = sW + 32 * 72;
  bf16_t* sA = sAd + 32 * 72;
  int tid = threadIdx.x;
  asm volatile("" : "+v"(tid));
  const int lane = tid & 63, wave = tid >> 6;
#pragma unroll
  for (int i = 0; i < 2; ++i) {
    const int idx = tid + 256 * i, m = idx >> 4, sg = idx & 15;
    float v[8];
    shift8(p, t0 + m, 1536 + sg * 8, v);
    if (sg < 8) {
#pragma unroll
      for (int j = 0; j < 8; ++j) v[j] = tanhf(v[j]);
      *(uint4*)(sW + m * 72 + sg * 8) = pack8(v);
    } else {
      *(uint4*)(sAd + m * 72 + (sg - 8) * 8) = pack8(v);
    }
  }
  __syncthreads();
  const int h5 = lane >> 5, cl = lane & 31;
#pragma unroll 1
  for (int sp = 0; sp < 8; ++sp) {
    const int pass = sp >> 2, ni = sp & 3;
    const bf16_t* As = pass ? sAd : sW;
    const bf16_t* Bt = pass ? p.AupT : p.WupT;
    const int n = wave * 128 + ni * 32 + cl;
    f32x16 acc;
#pragma unroll
    for (int i = 0; i < 16; ++i) acc[i] = 0.f;
#pragma unroll
    for (int ks = 0; ks < 4; ++ks) {
      bf16x8 af = *(const bf16x8*)(As + cl * 72 + ks * 16 + h5 * 8);
      bf16x8 bfr = *(const bf16x8*)(Bt + (size_t)n * 64 + ks * 16 + h5 * 8);
      acc = __builtin_amdgcn_mfma_f32_32x32x16_bf16(af, bfr, acc, 0, 0, 0);
    }
    if (pass == 0) {
      const float w0n = p.w0[n];
#pragma unroll
      for (int i = 0; i < 16; ++i) {
        const int tok = t0 + crow(i, h5);
        const float sg = 1.f / (1.f + __expf(-(w0n + acc[i])));
        p.dec[(size_t)tok * 512 + n] = __expf(-0.6065306597126334f * sg);
      }
    } else {
      const float a0n = p.a0[n];
#pragma unroll
      for (int i = 0; i < 16; ++i) sA[crow(i, h5) * 520 + n] = f2bf(1.f / (1.f + __expf(-(a0n + acc[i]))));
    }
  }
  __syncthreads();
#pragma unroll 1
  for (int i = 0; i < 8; ++i) {
    const int idx = tid + 256 * i, m = idx >> 6, ch0 = (idx & 63) * 8;
    const int tok = t0 + m;
    const size_t o = (size_t)tok * 512 + ch0;
    float rs[8], ks[8], vs[8], a[8], kkc[8], kac[8];
    shift8(p, tok, ch0, rs);
    shift8(p, tok, 512 + ch0, ks);
    shift8(p, tok, 1024 + ch0, vs);
    unpack8(*(const uint4*)(sA + m * 520 + ch0), a);
    ld8f(p.k_k + ch0, kkc);
    ld8f(p.k_a + ch0, kac);
    float kkr[8], ssq = 0.f;
#pragma unroll
    for (int j = 0; j < 8; ++j) { kkr[j] = ks[j] * kkc[j]; ssq += kkr[j] * kkr[j]; }
    ssq += __shfl_xor(ssq, 1);
    ssq += __shfl_xor(ssq, 2);
    ssq += __shfl_xor(ssq, 4);
    const float inv = 1.0f / fmaxf(sqrtf(ssq), 1e-12f);
    float kp[8], bb[8];
#pragma unroll
    for (int j = 0; j < 8; ++j) {
      kkr[j] *= inv;
      kp[j] = ks[j] * (1.f + (a[j] - 1.f) * kac[j]);
      bb[j] = kkr[j] * a[j];
    }
    *(uint4*)(p.rr + o) = pack8(rs);
    *(uint4*)(p.kp + o) = pack8(kp);
    *(uint4*)(p.vv + o) = pack8(vs);
    *(uint4*)(p.kk + o) = pack8(kkr);
    *(uint4*)(p.bb + o) = pack8(bb);
  }
  __syncthreads();
}

constexpr int SCH = 16;
constexpr int SSTR = 336;

DI void scan_item(const Params& p, int item, char* smem) {
  const int xcd = item & 7, slot = item >> 3;
  const int bh = xcd * 8 + (slot >> 2), rg = slot & 3;
  const int b = bh >> 3, h = bh & 7, row0 = rg * 16;
  float* buf = (float*)smem;
  float* ybuf = buf + 2 * SCH * SSTR;
  int tid = threadIdx.x;
  asm volatile("" : "+v"(tid));
  const int lane = tid & 63, wave = tid >> 6;
  const int q = lane >> 4, c = lane & 15, lr = wave * 4 + q;
  const size_t tokb = (size_t)b * 2048;

  const bf16_t* ap[2];
  int ast[2], aseg[2], aslot[2];
#pragma unroll
  for (int i = 0; i < 2; ++i) {
    int e = tid + 256 * i;
    int arr = e >> 7;
    ast[i] = (e >> 3) & 15;
    aseg[i] = e & 7;
    ap[i] = arr == 0 ? p.rr : arr == 1 ? p.kp : arr == 2 ? p.kk : p.bb;
    aslot[i] = arr == 0 ? 4 : arr;
  }
  const int dst_ = tid >> 4, dseg = tid & 15;
  const int vst = (tid >> 1) & 15, vseg = tid & 1;
  struct Stage { uint4 g0, g1, gv; float4 gd; };
  auto gload = [&](Stage& S, int ci) {
    const size_t s0 = tokb + (size_t)ci * SCH;
    S.g0 = *(const uint4*)(ap[0] + (s0 + ast[0]) * 512 + h * 64 + aseg[0] * 8);
    S.g1 = *(const uint4*)(ap[1] + (s0 + ast[1]) * 512 + h * 64 + aseg[1] * 8);
    S.gd = *(const float4*)(p.dec + (s0 + dst_) * 512 + h * 64 + dseg * 4);
    if (tid < 32) S.gv = *(const uint4*)(p.vv + (s0 + vst) * 512 + h * 64 + row0 + vseg * 8);
  };
  auto cvt8 = [&](uint4 u, float* d) {
    float4 a, b2;
    a.x = __uint_as_float(u.x << 16); a.y = __uint_as_float(u.x & 0xffff0000u);
    a.z = __uint_as_float(u.y << 16); a.w = __uint_as_float(u.y & 0xffff0000u);
    b2.x = __uint_as_float(u.z << 16); b2.y = __uint_as_float(u.z & 0xffff0000u);
    b2.z = __uint_as_float(u.w << 16); b2.w = __uint_as_float(u.w & 0xffff0000u);
    *(float4*)d = a;
    *(float4*)(d + 4) = b2;
  };
  auto sstore = [&](const Stage& S, int nbuf) {
    float* B = buf + nbuf * SCH * SSTR;
    cvt8(S.g0, B + ast[0] * SSTR + aslot[0] * 64 + aseg[0] * 8);
    cvt8(S.g1, B + ast[1] * SSTR + aslot[1] * 64 + aseg[1] * 8);
    *(float4*)(B + dst_ * SSTR + dseg * 4) = S.gd;
    if (tid < 32) cvt8(S.gv, B + vst * SSTR + 320 + vseg * 8);
  };

  f32x2_t sA = {0.f, 0.f}, sB = {0.f, 0.f};
  auto compute = [&](int ci, int cb) {
    const float* B = buf + cb * SCH * SSTR;
    float* Y = ybuf + cb * 256;
    const float* Lc = B + 4 * c;
    const float* Lv = B + 320 + lr;
    float4 w0_ = *(const float4*)(Lc), k0_ = *(const float4*)(Lc + 64), q0_ = *(const float4*)(Lc + 128),
           b0_ = *(const float4*)(Lc + 192), r0_ = *(const float4*)(Lc + 256);
    float v0_ = Lv[0];
    float4 w1_, k1_, q1_, b1_, r1_;
    float v1_;
    float pp;
    {
      const f32x2_t k0 = {q0_.x, q0_.y}, k1 = {q0_.z, q0_.w};
      f32x2_t pq = sA * k0;
      pq = sB * k1 + pq;
      pp = allred16(pq.x + pq.y);
    }
    float ysel = 0.f;
#define SCAN_STEP(W, K, BV, R, V, NW, NK, NQ, NB, NR, NV, ST)                                          \
  {                                                                                                    \
    if ((ST) + 1 < SCH) {                                                                              \
      NW = *(const float4*)(Lc + ((ST) + 1) * SSTR);                                                   \
      NK = *(const float4*)(Lc + ((ST) + 1) * SSTR + 64);                                              \
      NQ = *(const float4*)(Lc + ((ST) + 1) * SSTR + 128);                                             \
      NB = *(const float4*)(Lc + ((ST) + 1) * SSTR + 192);                                             \
      NR = *(const float4*)(Lc + ((ST) + 1) * SSTR + 256);                                             \
      NV = Lv[((ST) + 1) * SSTR];                                                                      \
    }                                                                                                  \
    const f32x2_t wa = {W.x, W.y}, wb = {W.z, W.w}, ka = {K.x, K.y}, kb = {K.z, K.w}, ba = {BV.x, BV.y}, \
                  bb2 = {BV.z, BV.w}, ra = {R.x, R.y}, rb = {R.z, R.w}, qa = {NQ.x, NQ.y}, qb = {NQ.z, NQ.w}; \
    const f32x2_t msa = {-pp, -pp}, vv2 = {V, V};                                                      \
    const f32x2_t t0 = ba * msa + ka * vv2, t1 = bb2 * msa + kb * vv2;                                 \
    sA = sA * wa + t0;                                                                                 \
    sB = sB * wb + t1;                                                                                 \
    f32x2_t yq = sA * ra;                                                                              \
    yq = sB * rb + yq;                                                                                 \
    f32x2_t pq = sA * qa;                                                                              \
    pq = sB * qb + pq;                                                                                 \
    float ys = yq.x + yq.y, ps = pq.x + pq.y;                                                          \
    ys += dppf<0xB1>(ys);  ps += dppf<0xB1>(ps);                                                       \
    ys += dppf<0x4E>(ys);  ps += dppf<0x4E>(ps);                                                       \
    ys += dppf<0x141>(ys); ps += dppf<0x141>(ps);                                                      \
    ys += dppf<0x128>(ys); ps += dppf<0x128>(ps);                                                      \
    pp = ps;                                                                                           \
    ysel = (c == (ST)) ? ys : ysel;                                                                    \
  }
#pragma unroll 2
    for (int st = 0; st < SCH; st += 2) {
      SCAN_STEP(w0_, k0_, b0_, r0_, v0_, w1_, k1_, q1_, b1_, r1_, v1_, st)
      SCAN_STEP(w1_, k1_, b1_, r1_, v1_, w0_, k0_, q0_, b0_, r0_, v0_, st + 1)
    }
#undef SCAN_STEP
    Y[c * 16 + lr] = ysel;
  };
  auto flush = [&](int ci, int cb) {
    const int st = tid >> 4, rr_ = tid & 15;
    p.yraw[(tokb + (size_t)ci * SCH + st) * 512 + h * 64 + row0 + rr_] = (ybuf + cb * 256)[tid];
  };

  constexpr int NCH = S_ / SCH;
  Stage SA, SB;
  gload(SA, 0);
  gload(SB, 1);
  sstore(SA, 0);
  __syncthreads();
  for (int ci = 0; ci < NCH; ci += 2) {
    if (ci + 2 < NCH) gload(SA, ci + 2);
    compute(ci, 0);
    sstore(SB, 1);
    __syncthreads();
    flush(ci, 0);
    if (ci + 3 < NCH) gload(SB, ci + 3);
    compute(ci + 1, 1);
    if (ci + 2 < NCH) sstore(SA, 0);
    __syncthreads();
    flush(ci + 1, 1);
  }
  __syncthreads();
}

using f32x4 = __attribute__((ext_vector_type(4))) float;
#define MFMA16(a, b, c) __builtin_amdgcn_mfma_f32_16x16x32_bf16((a), (b), (c), 0, 0, 0)
DI float ex2(float x) { return __builtin_amdgcn_exp2f(x); }
constexpr float SCL2 = 0.18033688011112042f;
constexpr float NEGB = -1e30f;

DI unsigned topk8(const float* imp, int tblk) {
  float v[32];
#pragma unroll
  for (int j = 0; j < 32; ++j) {
    float xv = imp[j];
    bool forced = (j == 0) | (j == tblk) | (j == tblk - 1);
    v[j] = (j <= tblk) ? (xv + (forced ? 1000.f : 0.f)) : -1.f;
  }
  unsigned sel = 0;
#pragma unroll
  for (int r = 0; r < 8; ++r) {
    float best = -3e38f;
    int bi = 0;
#pragma unroll
    for (int j = 0; j < 32; ++j) {
      bool ok = (((sel >> j) & 1u) == 0u) && (v[j] > best);
      best = ok ? v[j] : best;
      bi = ok ? j : bi;
    }
    sel |= 1u << bi;
  }
  return sel;
}

DI void head_step(const bf16x8& k00, const bf16x8& k01, const bf16x8& k10, const bf16x8& k11, const bf16x8& v0, const bf16x8& v1,
                  const bf16x8& v2, const bf16x8& v3, const bf16x8& q0, const bf16x8& q1, const float (&bias)[8], f32x4& O0,
                  f32x4& O1, f32x4& O2, f32x4& O3, float& m, float& l) {
  f32x4 sa = {0.f, 0.f, 0.f, 0.f}, sb = {0.f, 0.f, 0.f, 0.f};
  sa = MFMA16(k00, q0, sa);
  sb = MFMA16(k10, q0, sb);
  sa = MFMA16(k01, q1, sa);
  sb = MFMA16(k11, q1, sb);
  float sc[8];
  float cm = -3e38f;
#pragma unroll
  for (int e = 0; e < 8; ++e) {
    sc[e] = fmaf((e < 4) ? sa[e & 3] : sb[e & 3], SCL2, bias[e]);
    cm = fmaxf(cm, sc[e]);
  }
  if (__builtin_amdgcn_ballot_w64(cm > m) != 0ull) {
    cm = fmaxf(cm, __shfl_xor(cm, 16));
    cm = fmaxf(cm, __shfl_xor(cm, 32));
    const float mn = fmaxf(m, cm);
    const float alpha = ex2(m - mn);
    m = mn;
    l *= alpha;
    O0 *= alpha; O1 *= alpha; O2 *= alpha; O3 *= alpha;
  }
  float ps = 0.f;
  float pe[8];
#pragma unroll
  for (int e = 0; e < 8; ++e) {
    pe[e] = ex2(sc[e] - m);
    ps += pe[e];
  }
  l += ps;
  union { unsigned u[4]; bf16x8 v; } pk;
  pk.u[0] = pk2(pe[0], pe[1]); pk.u[1] = pk2(pe[2], pe[3]); pk.u[2] = pk2(pe[4], pe[5]); pk.u[3] = pk2(pe[6], pe[7]);
  O0 = MFMA16(v0, pk.v, O0);
  O1 = MFMA16(v1, pk.v, O1);
  O2 = MFMA16(v2, pk.v, O2);
  O3 = MFMA16(v3, pk.v, O3);
}

template <int MODE>
DI void attend(unsigned long long cmask, const bf16_t* __restrict__ Kb, const bf16_t* __restrict__ VT, const bf16x8* ql, int t,
               int t0, unsigned selmask, int n, int q4, f32x4 (&O)[4][4], float (&m)[4], float (&l)[4]) {
  const int krow = (n >> 2) * 8 + (n & 3);
  const bf16_t* Kl = Kb + (size_t)krow * 128 + q4 * 8;
  const bf16_t* Vl = VT + (size_t)n * VTS + q4 * 8;
  if (!cmask) return;
  int cur = __ffsll(cmask) - 1;
  cmask &= cmask - 1;
  bf16x8 k00, k01, k10, k11;
  {
    const bf16_t* kp_ = Kl + (size_t)cur * 32 * 128;
    k00 = *(const bf16x8*)(kp_); k01 = *(const bf16x8*)(kp_ + 32);
    k10 = *(const bf16x8*)(kp_ + 4 * 128); k11 = *(const bf16x8*)(kp_ + 4 * 128 + 32);
  }
  while (true) {
    int nxt = -1;
    if (cmask) { nxt = __ffsll(cmask) - 1; cmask &= cmask - 1; }
    bf16x8 n00, n01, n10, n11, v0, v1, v2, v3;
    {
      const bf16_t* vp_ = Vl + cur * 32;
      v0 = *(const bf16x8*)(vp_); v1 = *(const bf16x8*)(vp_ + 16 * VTS);
      v2 = *(const bf16x8*)(vp_ + 32 * VTS); v3 = *(const bf16x8*)(vp_ + 48 * VTS);
    }
    if (nxt >= 0) {
      const bf16_t* kp_ = Kl + (size_t)nxt * 32 * 128;
      n00 = *(const bf16x8*)(kp_); n01 = *(const bf16x8*)(kp_ + 32);
      n10 = *(const bf16x8*)(kp_ + 4 * 128); n11 = *(const bf16x8*)(kp_ + 4 * 128 + 32);
    }
    const int kb = cur * 32;
    const int key0 = kb + q4 * 8;
    bool blk = true;
    if (MODE == 1) blk = ((selmask >> (kb >> 6)) & 1u) != 0u;
    float bias[8];
#pragma unroll
    for (int e = 0; e < 8; ++e) {
      const int key = key0 + e;
      bool v = blk && (key <= t);
      if (MODE == 2) v = v && (key + 512 > t);
      bias[e] = v ? 0.f : NEGB;
    }
#pragma unroll
    for (int r = 0; r < 4; ++r) {
      const bf16x8 q0 = ql[(r * 2 + 0) * 64], q1 = ql[(r * 2 + 1) * 64];
      head_step(k00, k01, k10, k11, v0, v1, v2, v3, q0, q1, bias, O[r][0], O[r][1], O[r][2], O[r][3], m[r], l[r]);

    }
    if (nxt < 0) break;
    k00 = n00; k01 = n01; k10 = n10; k11 = n11;
    cur = nxt;
  }
}

constexpr int NSA_WFLOATS = 16 * 132 + 16 * 32;

__device__ void nsa_wave_item(const Params& p, int item, float* wl) {
  int tx_ = threadIdx.x;
  asm volatile("" : "+v"(tx_));
  const int lane = tx_ & 63, n = lane & 15, q4 = lane >> 4;
  const int bg = item & 15, tt = item >> 4;
  const int b = bg >> 1, g = bg & 1, t0 = tt * 16, t = t0 + n;
  const size_t tok = (size_t)b * 2048 + t;
  float* impb = wl + 2048;
  bf16x8* ql = (bf16x8*)wl + lane;
  const int krow = (n >> 2) * 8 + (n & 3);

#pragma unroll
  for (int r = 0; r < 4; ++r)
#pragma unroll
    for (int kd = 0; kd < 2; ++kd) ql[(r * 2 + kd) * 64] = *(const bf16x8*)(p.qb + tok * 512 + (g * 4 + r) * 64 + kd * 32 + q4 * 8);
  const float* gatep = p.glb + tok * 24 + g * 12;
  bf16_t* mixl = p.mix + tok * LDH + (g * 4) * 64 + q4 * 4;
  f32x4 Oc[4][4];

  {
    const bf16_t* Kc = p.kcmp + (size_t)bg * 128 * 64;
    const bf16_t* VcT = p.vcmpT + (size_t)bg * 64 * 128;
    const int nch = (t0 + 15 >= 31) ? ((min((t0 + 15 - 31) >> 4, 126) >> 5) + 1) : 0;
#pragma unroll
    for (int e = 0; e < 9; ++e) impb[lane * 9 + e] = 0.f;
    float m[4], l[4];
#pragma unroll
    for (int r = 0; r < 4; ++r) { m[r] = NEGB; l[r] = 0.f; }
#pragma unroll 1
    for (int ch = 0; ch < nch; ++ch) {
      const int kb = ch * 32;
      bf16x8 kf[2][2];
#pragma unroll
      for (int sub = 0; sub < 2; ++sub)
#pragma unroll
        for (int kd = 0; kd < 2; ++kd) kf[sub][kd] = *(const bf16x8*)(Kc + (size_t)(kb + krow + sub * 4) * 64 + kd * 32 + q4 * 8);
#pragma unroll
      for (int r = 0; r < 4; ++r) {
        f32x4 sa = {0.f, 0.f, 0.f, 0.f}, sb = {0.f, 0.f, 0.f, 0.f};
#pragma unroll
        for (int kd = 0; kd < 2; ++kd) {
          const bf16x8 qv = ql[(r * 2 + kd) * 64];
          sa = MFMA16(kf[0][kd], qv, sa);
          sb = MFMA16(kf[1][kd], qv, sb);
        }
        float sc[8];
        float cm = NEGB;
#pragma unroll
        for (int e = 0; e < 8; ++e) {
          const int c = kb + q4 * 8 + e;
          const bool v = (16 * c + 31 <= t);
          float x = ((e < 4) ? sa[e & 3] : sb[e & 3]) * SCL2;
          sc[e] = v ? x : NEGB;
          cm = fmaxf(cm, sc[e]);
        }
        cm = fmaxf(cm, __shfl_xor(cm, 16));
        cm = fmaxf(cm, __shfl_xor(cm, 32));
        const float mn = fmaxf(m[r], cm);
        float ps = 0.f;
#pragma unroll
        for (int e = 0; e < 8; ++e) ps += (sc[e] > -1e29f) ? ex2(sc[e] - mn) : 0.f;
        l[r] = l[r] * ex2(m[r] - mn) + ps;
        m[r] = mn;
        __builtin_amdgcn_sched_barrier(0);
      }
    }
    float inv[4];
#pragma unroll
    for (int r = 0; r < 4; ++r) {
      float lv = l[r];
      lv += __shfl_xor(lv, 16);
      lv += __shfl_xor(lv, 32);
      inv[r] = (lv > 0.f) ? 1.f / lv : 0.f;
    }
#pragma unroll
    for (int dt = 0; dt < 4; ++dt)
#pragma unroll
      for (int r = 0; r < 4; ++r) Oc[dt][r] = f32x4{0.f, 0.f, 0.f, 0.f};
#pragma unroll 1
    for (int ch = 0; ch < nch; ++ch) {
      const int kb = ch * 32;
      bf16x8 kf[2][2];
#pragma unroll
      for (int sub = 0; sub < 2; ++sub)
#pragma unroll
        for (int kd = 0; kd < 2; ++kd) kf[sub][kd] = *(const bf16x8*)(Kc + (size_t)(kb + krow + sub * 4) * 64 + kd * 32 + q4 * 8);
      bf16x8 vf[4];
#pragma unroll
      for (int dt = 0; dt < 4; ++dt) vf[dt] = *(const bf16x8*)(VcT + (size_t)(dt * 16 + n) * 128 + kb + q4 * 8);
      float psm[8];
#pragma unroll
      for (int e = 0; e < 8; ++e) psm[e] = 0.f;
      bf16x8 pf[4];
#pragma unroll
      for (int r = 0; r < 4; ++r) {
        f32x4 sa = {0.f, 0.f, 0.f, 0.f}, sb = {0.f, 0.f, 0.f, 0.f};
#pragma unroll
        for (int kd = 0; kd < 2; ++kd) {
          const bf16x8 qv = ql[(r * 2 + kd) * 64];
          sa = MFMA16(kf[0][kd], qv, sa);
          sb = MFMA16(kf[1][kd], qv, sb);
        }
        float pe[8];
#pragma unroll
        for (int e = 0; e < 8; ++e) {
          const int c = kb + q4 * 8 + e;
          const bool v = (16 * c + 31 <= t);
          float x = ((e < 4) ? sa[e & 3] : sb[e & 3]) * SCL2;
          pe[e] = v ? ex2(x - m[r]) * inv[r] : 0.f;
          psm[e] += pe[e];
        }
        union { unsigned u[4]; bf16x8 v; } pk;
        pk.u[0] = pk2(pe[0], pe[1]); pk.u[1] = pk2(pe[2], pe[3]); pk.u[2] = pk2(pe[4], pe[5]); pk.u[3] = pk2(pe[6], pe[7]);
        pf[r] = pk.v;
        __builtin_amdgcn_sched_barrier(0);
      }
      {
        float* ip = impb + n * 36 + (kb >> 2) + 2 * q4;
        ip[0] += psm[0] + psm[1] + psm[2] + 0.5f * psm[3];
        __builtin_amdgcn_fence(__ATOMIC_ACQ_REL, "workgroup");
        __builtin_amdgcn_wave_barrier();
        ip[1] += 0.5f * psm[3] + psm[4] + psm[5] + psm[6] + 0.5f * psm[7];
        __builtin_amdgcn_fence(__ATOMIC_ACQ_REL, "workgroup");
        __builtin_amdgcn_wave_barrier();
        ip[2] += 0.5f * psm[7];
        __builtin_amdgcn_fence(__ATOMIC_ACQ_REL, "workgroup");
        __builtin_amdgcn_wave_barrier();
      }
#pragma unroll
      for (int dt = 0; dt < 4; ++dt)
#pragma unroll
        for (int r = 0; r < 4; ++r) Oc[dt][r] = MFMA16(vf[dt], pf[r], Oc[dt][r]);
    }
  }
#pragma unroll
  for (int r = 0; r < 4; ++r) {
    const float gsc = gatep[r * 3 + 0];
#pragma unroll
    for (int dt = 0; dt < 4; ++dt) {
      uint2 o;
      o.x = pk2(Oc[dt][r][0] * gsc, Oc[dt][r][1] * gsc);
      o.y = pk2(Oc[dt][r][2] * gsc, Oc[dt][r][3] * gsc);
      *(uint2*)(mixl + r * 64 + dt * 16) = o;
    }
  }
  __builtin_amdgcn_fence(__ATOMIC_ACQ_REL, "workgroup");
  __builtin_amdgcn_wave_barrier();
  const int tblk = t0 >> 6;
  unsigned selmask = topk8(impb + n * 36, tblk);
  selmask &= (tblk >= 31) ? 0xffffffffu : ((1u << (tblk + 1)) - 1u);
  __builtin_amdgcn_wave_barrier();

#pragma unroll
  for (int r = 0; r < 4; ++r) {
    const bf16x8 q0 = ql[(r * 2 + 0) * 64];
    union { unsigned u[4]; bf16x8 v; } pk;
    float vals[8];
#pragma unroll
    for (int j = 0; j < 8; ++j) {
      float xv = bf2f((bf16_t)q0[j]);
      float ov = __shfl_xor(xv, 16);
      float2 cs = p.rope[t * 8 + j];
      vals[j] = (q4 == 0) ? (xv * cs.x - ov * cs.y) : ((q4 == 1) ? (xv * cs.x + ov * cs.y) : xv);
    }
    pk.u[0] = pk2(vals[0], vals[1]); pk.u[1] = pk2(vals[2], vals[3]); pk.u[2] = pk2(vals[4], vals[5]); pk.u[3] = pk2(vals[6], vals[7]);
    ql[(r * 2 + 0) * 64] = pk.v;
  }

#pragma unroll 1
  for (int br = 1; br <= 2; ++br) {
    unsigned long long cmask = 0ull;
    const int hic = (t0 + 15) >> 5;
    if (br == 1) {
      unsigned any = selmask;
#pragma unroll
      for (int o = 32; o >= 1; o >>= 1) any |= (unsigned)__shfl_xor((int)any, o);
      any = __builtin_amdgcn_readfirstlane(any);
      for (int j = 0; j <= tblk; ++j)
        if ((any >> j) & 1u) cmask |= 3ull << (2 * j);
      if (hic < 63) cmask &= (1ull << (hic + 1)) - 1ull;
    } else {
      const int lo = max(0, t0 - 511) >> 5;
      cmask = (hic < 63) ? ((1ull << (hic + 1)) - 1ull) : ~0ull;
      cmask &= ~((1ull << lo) - 1ull);
    }
    f32x4 O[4][4];
    float m[4], l[4];
#pragma unroll
    for (int dt = 0; dt < 4; ++dt)
#pragma unroll
      for (int r = 0; r < 4; ++r) O[r][dt] = f32x4{0.f, 0.f, 0.f, 0.f};
#pragma unroll
    for (int r = 0; r < 4; ++r) { m[r] = -1e29f; l[r] = 0.f; }
    if (br == 1)
      attend<1>(cmask, p.ksb + (size_t)b * 2048 * 128 + g * 64, p.vsT + (size_t)bg * 64 * VTS, ql, t, t0, selmask, n, q4, O, m, l);
    else
      attend<2>(cmask, p.kwb + (size_t)b * 2048 * 128 + g * 64, p.vwT + (size_t)bg * 64 * VTS, ql, t, t0, selmask, n, q4, O, m, l);
#pragma unroll
    for (int r = 0; r < 4; ++r) {
      float lv = l[r];
      lv += __shfl_xor(lv, 16);
      lv += __shfl_xor(lv, 32);
      const float gsc = gatep[r * 3 + br] * ((lv > 0.f) ? 1.f / lv : 0.f);
#pragma unroll
      for (int dt = 0; dt < 4; ++dt) {
        uint2* mp = (uint2*)(mixl + r * 64 + dt * 16);
        const uint2 u = *mp;
        float a0 = __uint_as_float(u.x << 16) + O[r][dt][0] * gsc, a1 = __uint_as_float(u.x & 0xffff0000u) + O[r][dt][1] * gsc;
        float a2 = __uint_as_float(u.y << 16) + O[r][dt][2] * gsc, a3 = __uint_as_float(u.y & 0xffff0000u) + O[r][dt][3] * gsc;
        if (br == 2) {
          const uint2 gg = *(const uint2*)(p.gns + tok * 512 + (g * 4 + r) * 64 + dt * 16 + q4 * 4);
          a0 *= __uint_as_float(gg.x << 16); a1 *= __uint_as_float(gg.x & 0xffff0000u);
          a2 *= __uint_as_float(gg.y << 16); a3 *= __uint_as_float(gg.y & 0xffff0000u);
        }
        uint2 o;
        o.x = pk2(a0, a1);
        o.y = pk2(a2, a3);
        *mp = o;
      }
    }
  }
}

DI void phase_mix_rwkv(const Params& p) {
  int tx = threadIdx.x;
  asm volatile("" : "+v"(tx));
  const int lane = tx & 63, sub = lane >> 4, c = lane & 15;
  const int gw = blockIdx.x * 4 + (tx >> 6), nw = gridDim.x * 4;
  for (int it = gw; it < T_ * 2; it += nw) {
    const int ph = it * 4 + sub;
    const int tok = ph >> 3, h = ph & 7;
    const int ch = h * 64 + c * 4;
    const size_t idx = (size_t)tok * 512 + ch;
    const float4 y = *(const float4*)(p.yraw + idx);
    const float mean = allred16(y.x + y.y + y.z + y.w) * (1.f / 64.f);
    const float d0 = y.x - mean, d1 = y.y - mean, d2 = y.z - mean, d3 = y.w - mean;
    const float var = allred16(d0 * d0 + d1 * d1 + d2 * d2 + d3 * d3) * (1.f / 64.f);
    const float rs = rsqrtf(var + 64e-5f);
    const float4 gw4 = *(const float4*)(p.gn_w + ch), gb4 = *(const float4*)(p.gn_b + ch), rk4 = *(const float4*)(p.r_k + ch);
    const uint2 ru = *(const uint2*)(p.rr + idx), ku = *(const uint2*)(p.kp + idx), vu = *(const uint2*)(p.vv + idx),
                gu = *(const uint2*)(p.grw + idx);
    const float r0 = __uint_as_float(ru.x << 16), r1 = __uint_as_float(ru.x & 0xffff0000u), r2 = __uint_as_float(ru.y << 16),
                r3 = __uint_as_float(ru.y & 0xffff0000u);
    const float k0 = __uint_as_float(ku.x << 16), k1 = __uint_as_float(ku.x & 0xffff0000u), k2 = __uint_as_float(ku.y << 16),
                k3 = __uint_as_float(ku.y & 0xffff0000u);
    const float v0 = __uint_as_float(vu.x << 16), v1 = __uint_as_float(vu.x & 0xffff0000u), v2 = __uint_as_float(vu.y << 16),
                v3 = __uint_as_float(vu.y & 0xffff0000u);
    const float g0 = __uint_as_float(gu.x << 16), g1 = __uint_as_float(gu.x & 0xffff0000u), g2 = __uint_as_float(gu.y << 16),
                g3 = __uint_as_float(gu.y & 0xffff0000u);
    const float bonus = allred16(r0 * k0 * rk4.x + r1 * k1 * rk4.y + r2 * k2 * rk4.z + r3 * k3 * rk4.w);
    uint2 o;
    o.x = pk2((d0 * rs * gw4.x + gb4.x + bonus * v0) * g0, (d1 * rs * gw4.y + gb4.y + bonus * v1) * g1);
    o.y = pk2((d2 * rs * gw4.z + gb4.z + bonus * v2) * g2, (d3 * rs * gw4.w + gb4.w + bonus * v3) * g3);
    *(uint2*)(p.mix + (size_t)tok * LDH + 512 + ch) = o;
  }
}

DI void phase_final_norm(const Params& p) {
  int tx = threadIdx.x;
  asm volatile("" : "+v"(tx));
  const int lane = tx & 63;
  const int gw = blockIdx.x * 4 + (tx >> 6), nw = gridDim.x * 4;
  const float4* fg = (const float4*)p.final_g;
  for (int row = gw; row < T_; row += nw) {
    float4* o4 = (float4*)(p.out + (size_t)row * 1024);
    float4 v[4];
    float ss = 0.f;
#pragma unroll
    for (int i = 0; i < 4; ++i) {
      v[i] = o4[i * 64 + lane];
      ss += v[i].x * v[i].x + v[i].y * v[i].y + v[i].z * v[i].z + v[i].w * v[i].w;
    }
    ss = wsum(ss);
    const float sc = rsqrtf(ss * (1.f / 1024.f) + 1e-6f);
#pragma unroll
    for (int i = 0; i < 4; ++i) {
      float4 gq = fg[i * 64 + lane];
      v[i].x *= sc * gq.x; v[i].y *= sc * gq.y; v[i].z *= sc * gq.z; v[i].w *= sc * gq.w;
      o4[i * 64 + lane] = v[i];
    }
  }
}

constexpr int NPHASE = 8;
constexpr int SMEM_BYTES = 65536;

template <int PH> DI void run_phase(const Params& p, char* smem) {
  const int bid = blockIdx.x, nb = gridDim.x;
  if (PH == 0) phase_prep(p, smem);
  if (PH == 1)
    for (int t = bid; t < 128 * 32; t += nb) gemm_tile<G_PROJ>(p, t >> 5, t & 31, 0, smem);
  if (PH == 2)
    if (nb > 128) {
      if (bid < 64) gemm_tile<G_CMP1>(p, (bid & 31) >> 1, bid & 1, bid >> 5, smem);
      else
        for (int t = bid - 64; t < 512; t += nb - 64) rwkv_prep_tile(p, t, smem);
    } else {
      for (int t = bid; t < 512 + 64; t += nb) {
        if (t < 64) gemm_tile<G_CMP1>(p, (t & 31) >> 1, t & 1, t >> 5, smem);
        else rwkv_prep_tile(p, t - 64, smem);
      }
    }
  if (PH == 3) {
    if (nb != 512)
      for (int t = bid; t < 32; t += nb) gemm_tile<G_CMP2>(p, t & 15, 0, t >> 4, smem);
  }
  if (PH == 4) {
    unsigned* flag = p.ctr + 40;
    if (nb == 512 && bid >= 256 && bid < 288) {
      const int t = bid - 256;
      gemm_tile<G_CMP2>(p, t & 15, 0, t >> 4, smem);
      asm volatile("s_waitcnt vmcnt(0)" ::: "memory");
      __syncthreads();
      if (threadIdx.x == 0) {
        __builtin_amdgcn_fence(__ATOMIC_RELEASE, "agent");
        asm volatile("s_waitcnt vmcnt(0)" ::: "memory");
        __hip_atomic_fetch_add(flag, 1u, __ATOMIC_RELAXED, __HIP_MEMORY_SCOPE_AGENT);
      }
    }
    for (int t = bid; t < 256; t += nb) scan_item(p, t, smem);
    if (nb == 512) {
      if (threadIdx.x == 0) {
        while (__hip_atomic_load(flag, __ATOMIC_RELAXED, __HIP_MEMORY_SCOPE_AGENT) < 32u) __builtin_amdgcn_s_sleep(2);
        __builtin_amdgcn_fence(__ATOMIC_ACQUIRE, "agent");
        asm volatile("s_waitcnt vmcnt(0)" ::: "memory");
      }
      __syncthreads();
    }
    float* wl = (float*)smem + (threadIdx.x >> 6) * NSA_WFLOATS;
    while (true) {
      int it = 0;
      if ((threadIdx.x & 63) == 0) it = (int)atomicAdd(p.ctr, 1u);
      it = __builtin_amdgcn_readfirstlane(it);
      if (it >= 2048) break;
      nsa_wave_item(p, (127 - (it >> 4)) * 16 + (it & 15), wl);
    }
  }
  if (PH == 5) phase_mix_rwkv(p);
  if (PH == 6)
    for (int t = bid; t < 128 * 8; t += nb) gemm_tile<G_OUT>(p, t >> 3, t & 7, 0, smem);
  if (PH == 7) phase_final_norm(p);
}

template <int PH> __global__ void __launch_bounds__(256, 2) phk(Params p) {
  __shared__ __attribute__((aligned(16))) char smem[SMEM_BYTES];
  run_phase<PH>(p, smem);
}

#ifndef PROBE_PH
#define PROBE_PH -1
#endif
#define XB_CNT(j) (256 + 64 * (j))
#define XB_SUB(j) (1280 + 64 * (j))
#define XB_GEN(j) (2304 + 64 * (j))
#define XB_TOP 3328
#define XB_TOPGEN 3392
DI unsigned xb_ld(unsigned* q) { return __hip_atomic_load(q, __ATOMIC_RELAXED, __HIP_MEMORY_SCOPE_AGENT); }
DI unsigned xb_add(unsigned* q, unsigned v) { return __hip_atomic_fetch_add(q, v, __ATOMIC_RELAXED, __HIP_MEMORY_SCOPE_AGENT); }
DI unsigned xb_xcc() { return (unsigned)__builtin_amdgcn_s_getreg((3 << 11) | 20) & 0xFu; }
DI void fast_barrier(unsigned* bar) {
  asm volatile("s_waitcnt vmcnt(0)" ::: "memory");
  __syncthreads();
  if (threadIdx.x == 0) {
    const unsigned x = xb_xcc();
    unsigned nloc, nx;
    for (;;) {
      unsigned sum = 0u;
      nloc = 1u;
      nx = 0u;
#pragma unroll
      for (unsigned j = 0; j < 16; ++j) {
        const unsigned c = xb_ld(&bar[XB_CNT(j)]);
        sum += c;
        nx += (c > 0u) ? 1u : 0u;
        nloc = (j == x) ? c : nloc;
      }
      if (sum == gridDim.x) break;
      __builtin_amdgcn_s_sleep(1);
    }
    const unsigned old = xb_add(&bar[XB_SUB(x)], 1u);
    const unsigned gen = old / nloc;
    if (old + 1u == (gen + 1u) * nloc) {
      __builtin_amdgcn_fence(__ATOMIC_RELEASE, "agent");
      asm volatile("s_waitcnt vmcnt(0)" ::: "memory");
      const unsigned og = xb_add(&bar[XB_TOP], 1u);
      const unsigned tg = og / nx;
      if (og + 1u == (tg + 1u) * nx) xb_add(&bar[XB_TOPGEN], 1u);
      else
        while (xb_ld(&bar[XB_TOPGEN]) == tg) __builtin_amdgcn_s_sleep(1);
      __builtin_amdgcn_fence(__ATOMIC_ACQUIRE, "agent");
      xb_add(&bar[XB_GEN(x)], 1u);
      asm volatile("s_waitcnt vmcnt(0)" ::: "memory");
    } else {
      while (xb_ld(&bar[XB_GEN(x)]) == gen) __builtin_amdgcn_s_sleep(1);
      __builtin_amdgcn_fence(__ATOMIC_ACQUIRE, "agent");
      asm volatile("s_waitcnt vmcnt(0)" ::: "memory");
    }
  }
  __syncthreads();
}

__global__ void __launch_bounds__(256, 2) mega(Params p) {
  __shared__ __attribute__((aligned(16))) char smem[SMEM_BYTES];
  cg::grid_group grid = cg::this_grid();
  unsigned* bar = p.xbar;
  const unsigned nblk = gridDim.x;
  if (p.ctr == nullptr) grid.sync();
  if (threadIdx.x == 0) (void)xb_add(&bar[XB_CNT(xb_xcc())], 1u);
  run_phase<0>(p, smem); fast_barrier(bar);
  run_phase<1>(p, smem); fast_barrier(bar);
  run_phase<2>(p, smem); fast_barrier(bar);
  if (nblk != 512u) { run_phase<3>(p, smem); fast_barrier(bar); }
  run_phase<4>(p, smem); fast_barrier(bar);
  run_phase<5>(p, smem); fast_barrier(bar);
  run_phase<6>(p, smem); fast_barrier(bar);
  run_phase<7>(p, smem);
}

extern "C" void kernel_launch(void* const* d_in, const int* in_sizes, int n_in, void* d_out, int out_size, void* d_ws, size_t ws_size,
                              hipStream_t stream) {
  Params p{};
  const float** pin = (const float**)&p;
  for (int i = 0; i < 21; ++i) pin[i] = (const float*)d_in[i];
  p.out = (float*)d_out;
  char* w = (char*)d_ws;
  size_t off = 0;
  auto alloc = [&](size_t bytes) { void* r = w + off; off += (bytes + 255) & ~(size_t)255; return r; };
  p.WinT = (bf16_t*)alloc((size_t)NPAD * LDW * 2);
  p.WoutT = (bf16_t*)alloc((size_t)1024 * LDW * 2);
  p.W1Tk = (bf16_t*)alloc((size_t)256 * LDW1 * 2);
  p.W1Tv = (bf16_t*)alloc((size_t)256 * LDW1 * 2);
  p.W2Tk = (bf16_t*)alloc((size_t)128 * LDW2 * 2);
  p.W2Tv = (bf16_t*)alloc((size_t)128 * LDW2 * 2);
  p.WupT = (bf16_t*)alloc((size_t)512 * 64 * 2);
  p.AupT = (bf16_t*)alloc((size_t)512 * 64 * 2);
  p.bias1k = (float*)alloc(256 * 4);
  p.bias1v = (float*)alloc(256 * 4);
  p.rope = (float2*)alloc((size_t)2048 * 8 * 8);
  p.qb = (bf16_t*)alloc((size_t)T_ * 512 * 2);
  p.kcb = (bf16_t*)alloc((size_t)(T_ + 16) * LDKC * 2);
  p.vcb = (bf16_t*)alloc((size_t)(T_ + 16) * LDKC * 2);
  p.ksb = (bf16_t*)alloc((size_t)T_ * 128 * 2);
  p.kwb = (bf16_t*)alloc((size_t)T_ * 128 * 2);
  p.vsb = nullptr;
  p.vwb = nullptr;
  p.vsT = (bf16_t*)alloc((size_t)16 * 64 * VTS * 2);
  p.vwT = (bf16_t*)alloc((size_t)16 * 64 * VTS * 2);
  p.glb = (float*)alloc((size_t)T_ * 24 * 4);
  p.gns = (bf16_t*)alloc((size_t)T_ * 512 * 2);
  p.rw = (bf16_t*)alloc((size_t)T_ * 1664 * 2);
  p.yraw = (float*)p.rw;
  p.grw = (bf16_t*)alloc((size_t)T_ * 512 * 2);
  p.hidk = (bf16_t*)alloc((size_t)2048 * LDHID * 2);
  p.hidv = (bf16_t*)alloc((size_t)2048 * LDHID * 2);
  p.kcmp = (bf16_t*)alloc((size_t)16 * 128 * 64 * 2);
  p.vcmp = (bf16_t*)alloc((size_t)16 * 128 * 64 * 2);
  p.vcmpT = (bf16_t*)alloc((size_t)16 * 128 * 64 * 2);
  p.rr = (bf16_t*)alloc((size_t)T_ * 512 * 2);
  p.kp = (bf16_t*)alloc((size_t)T_ * 512 * 2);
  p.vv = (bf16_t*)alloc((size_t)T_ * 512 * 2);
  p.mix = (bf16_t*)alloc((size_t)T_ * LDH * 2);
  p.hb = p.mix;
  p.ctr = (unsigned*)alloc(256);
  p.xbar = (unsigned*)alloc(16384);
  p.dec = (float*)d_out;
  p.kk = (bf16_t*)((char*)d_out + (size_t)T_ * 512 * 4);
  p.bb = (bf16_t*)((char*)d_out + (size_t)T_ * 512 * 6);
  if (off > ws_size) {
    fprintf(stderr, "workspace too small: need %zu have %zu\n", off, ws_size);
    return;
  }
#ifdef MULTI_LAUNCH
  hipLaunchKernelGGL(phk<0>, dim3(512), dim3(256), 0, stream, p);
  hipLaunchKernelGGL(phk<1>, dim3(512), dim3(256), 0, stream, p);
  hipLaunchKernelGGL(phk<2>, dim3(512), dim3(256), 0, stream, p);
  hipLaunchKernelGGL(phk<3>, dim3(512), dim3(256), 0, stream, p);
  hipLaunchKernelGGL(phk<4>, dim3(512), dim3(256), 0, stream, p);
  hipLaunchKernelGGL(phk<5>, dim3(512), dim3(256), 0, stream, p);
  hipLaunchKernelGGL(phk<6>, dim3(512), dim3(256), 0, stream, p);
  hipLaunchKernelGGL(phk<7>, dim3(512), dim3(256), 0, stream, p);
#else
  static int grid_blocks = 0;
  if (!grid_blocks) {
    int dev = 0, cus = 0, per_cu = 0;
    hipGetDevice(&dev);
    hipDeviceGetAttribute(&cus, hipDeviceAttributeMultiprocessorCount, dev);
    hipOccupancyMaxActiveBlocksPerMultiprocessor(&per_cu, mega, 256, 0);
    if (per_cu > 2) per_cu = 2;
    if (per_cu < 1) per_cu = 1;
    grid_blocks = cus * per_cu;
  }
  hipMemsetAsync(p.ctr, 0, 256 + 16384, stream);
  void* args[] = {&p};
  hipError_t e = hipLaunchCooperativeKernel((void*)mega, dim3(grid_blocks), dim3(256), args, 0, stream);
  if (e != hipSuccess) fprintf(stderr, "cooperative launch failed: %s (grid %d)\n", hipGetErrorString(e), grid_blocks);
#endif
}
```

```cpp
#include <hip/hip_runtime.h>
#include <hip/hip_bf16.h>
#include <hip/hip_cooperative_groups.h>
#include <cstdio>
namespace cg = cooperative_groups;


typedef unsigned short bf16_t;
using bf16x8 = __attribute__((ext_vector_type(8))) short;
using f32x16 = __attribute__((ext_vector_type(16))) float;
using f32x4 = __attribute__((ext_vector_type(4))) float;

#define DI __device__ __forceinline__

constexpr int T_ = 16384, S_ = 2048;
constexpr int NPAD = 4096;
constexpr int LDH = 1088, LDW = 1088, LDW1 = 2112, LDHID = 320, LDW2 = 320, LDKC = 136, VTS = 2112;

typedef __bf16 bf16x2_t __attribute__((ext_vector_type(2)));
typedef float f32x2_t __attribute__((ext_vector_type(2)));
DI unsigned pk2(float a, float b) {
  f32x2_t v = {a, b};
  return __builtin_bit_cast(unsigned, __builtin_convertvector(v, bf16x2_t));
}
DI bf16_t f2bf(float x) { return (bf16_t)(pk2(x, 0.f) & 0xffffu); }
DI float bf2f(bf16_t b) { return __uint_as_float(((unsigned)b) << 16); }
DI float sigmoidf_(float x) { return 1.f / (1.f + __expf(-x)); }
DI float siluf_(float x) { return x / (1.f + __expf(-x)); }
DI float wsum(float x) {
#pragma unroll
  for (int o = 32; o >= 1; o >>= 1) x += __shfl_xor(x, o);
  return x;
}
DI float wmax(float x) {
#pragma unroll
  for (int o = 32; o >= 1; o >>= 1) x = fmaxf(x, __shfl_xor(x, o));
  return x;
}
template <int CTRL> DI float dppf(float x) {
  return __int_as_float(__builtin_amdgcn_update_dpp(0, __float_as_int(x), CTRL, 0xf, 0xf, true));
}
DI float allred16(float x) {
  x += dppf<0xB1>(x);
  x += dppf<0x4E>(x);
  x += dppf<0x141>(x);
  x += dppf<0x128>(x);
  return x;
}

struct Params {
  const float *x, *norm_g, *w_in, *pos_k, *w1_k, *w2_k, *pos_v, *w1_v, *w2_v, *mu, *w0, *w_up, *a0, *a_up, *k_k, *k_a, *r_k,
      *gn_w, *gn_b, *w_out, *final_g;
  float* out;
  bf16_t *WinT, *WoutT, *W1Tk, *W1Tv, *W2Tk, *W2Tv, *WupT, *AupT;
  float *bias1k, *bias1v;
  float2* rope;
  bf16_t *qb, *kcb, *vcb, *ksb, *kwb, *vsb, *vwb, *vsT, *vwT;
  float* glb;
  bf16_t *gns, *rw, *grw, *hidk, *hidv, *kcmp, *vcmp, *vcmpT;
  bf16_t *rr, *kp, *vv, *kk, *bb;
  float *dec, *yraw;
  bf16_t* mix;
  bf16_t* hb;
  unsigned* ctr;
  unsigned* xbar;
};

DI void transpose_tile(const float* __restrict__ src, int ldsrc, bf16_t* __restrict__ dst, int ldd, int k0, int n0, const float* scale,
                       int mapmode, int nvalid, float* tile) {
  const int tid = threadIdx.x;
#pragma unroll
  for (int i = 0; i < 4; ++i) {
    const int idx = tid + 256 * i, kl = idx >> 4, ng = (idx & 15) * 4;
    const int n = n0 + ng;
    int on;
    if (mapmode == 1) on = (n < 1304) ? n : (n < 1408 ? -1 : n - 104);
    else on = (n < nvalid) ? n : -1;
    float4 v = make_float4(0.f, 0.f, 0.f, 0.f);
    if (on >= 0) {
      v = *(const float4*)(src + (size_t)(k0 + kl) * ldsrc + on);
      if (scale) {
        const float sc = scale[k0 + kl];
        v.x *= sc; v.y *= sc; v.z *= sc; v.w *= sc;
      }
    }
    float* t = tile + kl * 65 + ng;
    t[0] = v.x; t[1] = v.y; t[2] = v.z; t[3] = v.w;
  }
  __syncthreads();
#pragma unroll
  for (int i = 0; i < 2; ++i) {
    const int idx = tid + 256 * i, nl = idx >> 3, kg = (idx & 7) * 8;
    uint4 o;
    o.x = pk2(tile[(kg + 0) * 65 + nl], tile[(kg + 1) * 65 + nl]);
    o.y = pk2(tile[(kg + 2) * 65 + nl], tile[(kg + 3) * 65 + nl]);
    o.z = pk2(tile[(kg + 4) * 65 + nl], tile[(kg + 5) * 65 + nl]);
    o.w = pk2(tile[(kg + 6) * 65 + nl], tile[(kg + 7) * 65 + nl]);
    *(uint4*)(dst + (size_t)(n0 + nl) * ldd + k0 + kg) = o;
  }
  __syncthreads();
}

DI void phase_prep(const Params& p, char* smem) {
  float* tile = (float*)smem;
  const int nb = gridDim.x, bid = blockIdx.x, tid = threadIdx.x;
  {
    const int lane = tid & 63;
    for (int row = bid * 4 + (tid >> 6); row < T_; row += nb * 4) {
      const float4* x4 = (const float4*)(p.x + (size_t)row * 1024);
      float4 v[4];
      float ss = 0.f;
#pragma unroll
      for (int i = 0; i < 4; ++i) {
        {
          const f32x4 t_ = __builtin_nontemporal_load((const f32x4*)&x4[i * 64 + lane]);
          v[i] = make_float4(t_[0], t_[1], t_[2], t_[3]);
        }
        ss += v[i].x * v[i].x + v[i].y * v[i].y + v[i].z * v[i].z + v[i].w * v[i].w;
      }
      ss = wsum(ss);
      const float sc = rsqrtf(ss * (1.f / 1024.f) + 1e-6f);
      uint2* h2 = (uint2*)(p.hb + (size_t)row * LDH);
#pragma unroll
      for (int i = 0; i < 4; ++i) {
        uint2 o;
        o.x = pk2(v[i].x * sc, v[i].y * sc);
        o.y = pk2(v[i].z * sc, v[i].w * sc);
        h2[i * 64 + lane] = o;
      }
    }
  }
  const int n_win = 16 * 64, n_wout = 16 * 16, n_w1 = 32 * 4, n_w2 = 4 * 2, n_lora = 1 * 8;
  const int o1 = n_win, o2 = o1 + n_wout, o3 = o2 + n_w1, o4 = o3 + n_w1, o5 = o4 + n_w2, o6 = o5 + n_w2, o7 = o6 + n_lora,
            o8 = o7 + n_lora, o9 = o8 + 128, o10 = o9 + 16;
  for (int it = bid; it < o10; it += nb) {
    if (it < o1) {
      int kt = it & 15, nt = it >> 4;
      transpose_tile(p.w_in, 3992, p.WinT, LDW, kt * 64, nt * 64, p.norm_g, 1, 0, tile);
    } else if (it < o2) {
      int j = it - o1, kt = j & 15, nt = j >> 4;
      transpose_tile(p.w_out, 1024, p.WoutT, LDW, kt * 64, nt * 64, nullptr, 0, 1024, tile);
    } else if (it < o3) {
      int j = it - o2, kt = j & 31, nt = j >> 5;
      transpose_tile(p.w1_k, 256, p.W1Tk, LDW1, kt * 64, nt * 64, nullptr, 0, 256, tile);
    } else if (it < o4) {
      int j = it - o3, kt = j & 31, nt = j >> 5;
      transpose_tile(p.w1_v, 256, p.W1Tv, LDW1, kt * 64, nt * 64, nullptr, 0, 256, tile);
    } else if (it < o5) {
      int j = it - o4, kt = j & 3, nt = j >> 2;
      transpose_tile(p.w2_k, 64, p.W2Tk, LDW2, kt * 64, nt * 64, nullptr, 0, 64, tile);
    } else if (it < o6) {
      int j = it - o5, kt = j & 3, nt = j >> 2;
      transpose_tile(p.w2_v, 64, p.W2Tv, LDW2, kt * 64, nt * 64, nullptr, 0, 64, tile);
    } else if (it < o7) {
      int nt = it - o6;
      transpose_tile(p.w_up, 512, p.WupT, 64, 0, nt * 64, nullptr, 0, 512, tile);
    } else if (it < o8) {
      int nt = it - o7;
      transpose_tile(p.a_up, 512, p.AupT, 64, 0, nt * 64, nullptr, 0, 512, tile);
    } else if (it < o9) {
      const int j = it - o8, which = j >> 6, n0 = (j & 63) * 4;
      const float* pos = which ? p.pos_v : p.pos_k;
      const float* w1 = which ? p.w1_v : p.w1_k;
      float* bo = which ? p.bias1v : p.bias1k;
      const int kp = tid >> 2, nn = tid & 3;
      float a = 0.f;
#pragma unroll 16
      for (int k = kp * 32; k < kp * 32 + 32; ++k) a += pos[k] * w1[(size_t)k * 256 + n0 + nn];
      tile[tid] = a;
      __syncthreads();
      if (tid < 4) {
        float sum = 0.f;
        for (int q = 0; q < 64; ++q) sum += tile[q * 4 + tid];
        bo[n0 + tid] = sum;
      }
      __syncthreads();
    } else {
      int j = it - o9;
      for (int e = tid; e < 1024; e += 256) {
        int idx = j * 1024 + e;
        int pos = idx >> 3, i = idx & 7;
        float inv = powf(500000.0f, -(float)i / 8.0f);
        float ang = (float)pos * inv;
        float sn, cs;
        sincosf(ang, &sn, &cs);
        p.rope[idx] = make_float2(cs, sn);
      }
    }
  }
}

constexpr int LDT = 40;

DI int crow(int i, int h) { return (i & 3) + 8 * (i >> 2) + 4 * h; }

enum { G_PROJ = 0, G_CMP1 = 1, G_CMP2 = 2, G_OUT = 3 };

template <int MODE, bool EPI = true>
DI void gemm_tile(const Params& p, int mt, int nt, int which, char* smem) {
  constexpr int K = (MODE == G_PROJ) ? 1024 : (MODE == G_CMP1) ? 2048 : (MODE == G_CMP2) ? 256 : 1024;
  constexpr int LDA = (MODE == G_PROJ) ? LDH : (MODE == G_CMP1) ? LDKC : (MODE == G_CMP2) ? LDHID : LDH;
  constexpr int LDB = (MODE == G_PROJ) ? LDW : (MODE == G_CMP1) ? LDW1 : (MODE == G_CMP2) ? LDW2 : LDW;
  const int tid = threadIdx.x, lane = tid & 63, wave = tid >> 6;
  const int wm = wave >> 1, wn = wave & 1;
  const int m0 = mt * 128, n0 = nt * 128;

  const bf16_t* Bt;
  const bf16_t* Ab;
  if (MODE == G_PROJ) { Bt = p.WinT; Ab = p.hb; }
  else if (MODE == G_CMP1) { Bt = which ? p.W1Tv : p.W1Tk; Ab = which ? p.vcb : p.kcb; }
  else if (MODE == G_CMP2) { Bt = which ? p.W2Tv : p.W2Tk; Ab = which ? p.hidv : p.hidk; }
  else { Bt = p.WoutT; Ab = p.mix; }

  const int lrr = lane >> 2;
  const int lks = (lane & 3) ^ ((lane >> 4) & 3);
  unsigned aoA, aoB, boA;
  {
    const int r0 = m0 + (2 * wave) * 16 + lrr, r1 = r0 + 16;
    if (MODE == G_CMP1) {
      aoA = (unsigned)(r0 >> 1) * (16 * LDA) + (r0 & 1) * 64;
      aoB = (unsigned)(r1 >> 1) * (16 * LDA) + (r1 & 1) * 64;
    } else {
      aoA = (unsigned)r0 * LDA;
      aoB = (unsigned)r1 * LDA;
    }
    boA = (unsigned)(n0 + (2 * wave) * 16 + lrr) * LDB + lks * 8;
  }
  char* ldsw = smem + (2 * wave) * 1024;
  auto glds = [&](int kt) __attribute__((always_inline)) {
    char* st = ldsw + (kt & 3) * 16384;
    const int k_ = kt * 32 + lks * 8;
    const unsigned ko_ = (MODE == G_CMP1) ? ((unsigned)(k_ >> 6) * LDA + (k_ & 63)) : (unsigned)k_;
    __builtin_amdgcn_global_load_lds((const unsigned*)(Ab + (aoA + ko_)), (__attribute__((address_space(3))) unsigned*)(st), 16, 0, 0);
    __builtin_amdgcn_global_load_lds((const unsigned*)(Ab + (aoB + ko_)), (__attribute__((address_space(3))) unsigned*)(st + 1024), 16, 0, 0);
    __builtin_amdgcn_global_load_lds((const unsigned*)(Bt + (boA + kt * 32)), (__attribute__((address_space(3))) unsigned*)(st + 8192), 16, 0, 0);
    __builtin_amdgcn_global_load_lds((const unsigned*)(Bt + (boA + 16 * LDB + kt * 32)), (__attribute__((address_space(3))) unsigned*)(st + 8192 + 1024), 16, 0, 0);
  };

  f32x16 acc[2][2];
#pragma unroll
  for (int a = 0; a < 2; ++a)
#pragma unroll
    for (int b = 0; b < 2; ++b)
#pragma unroll
      for (int i = 0; i < 16; ++i) acc[a][b][i] = 0.f;

  const int frr = lane & 15, fhi = (lane >> 4) & 1, fq = lane >> 5;
  const int offA0 = ((wm * 64) >> 4) * 1024 + fhi * 1024 + frr * 64;
  const int offB0 = 8192 + ((wn * 64) >> 4) * 1024 + fhi * 1024 + frr * 64;
  const int fsw = (frr >> 2) & 3;
  bf16x8 fa0_0, fa0_1, fb0_0, fb0_1, fa1_0, fa1_1, fb1_0, fb1_1;
  bf16x8 ga0_0, ga0_1, gb0_0, gb0_1, ga1_0, ga1_1, gb1_0, gb1_1;
  const unsigned lbase = (unsigned)(size_t)(__attribute__((address_space(3))) char*)smem;
  const unsigned adA0 = lbase + offA0 + ((0 * 2 + fq) ^ fsw) * 16, adA1 = lbase + offA0 + ((1 * 2 + fq) ^ fsw) * 16;
  const unsigned adB0 = lbase + offB0 + ((0 * 2 + fq) ^ fsw) * 16, adB1 = lbase + offB0 + ((1 * 2 + fq) ^ fsw) * 16;
#define DSR(DST, AD, OFF) asm volatile("ds_read_b128 %0, %1 offset:%2" : "=v"(DST) : "v"(AD), "n"(OFF))
#define FRAG_LOAD_STG(P, SO)                \
  {                                         \
    DSR(P##a0_0, adA0, (SO));               \
    DSR(P##a0_1, adA0, (SO) + 2048);        \
    DSR(P##b0_0, adB0, (SO));               \
    DSR(P##b0_1, adB0, (SO) + 2048);        \
    DSR(P##a1_0, adA1, (SO));               \
    DSR(P##a1_1, adA1, (SO) + 2048);        \
    DSR(P##b1_0, adB1, (SO));               \
    DSR(P##b1_1, adB1, (SO) + 2048);        \
  }
#define FRAG_LOAD(P, STG)                               \
  {                                                     \
    const int stg_ = (STG);                             \
    if (stg_ == 0) FRAG_LOAD_STG(P, 0)                  \
    else if (stg_ == 1) FRAG_LOAD_STG(P, 16384)         \
    else if (stg_ == 2) FRAG_LOAD_STG(P, 32768)         \
    else FRAG_LOAD_STG(P, 49152)                        \
  }
#define FRAG_MMA(P)                                                                                     \
  {                                                                                                     \
    acc[0][0] = __builtin_amdgcn_mfma_f32_32x32x16_bf16(P##a0_0, P##b0_0, acc[0][0], 0, 0, 0);          \
    acc[0][1] = __builtin_amdgcn_mfma_f32_32x32x16_bf16(P##a0_0, P##b0_1, acc[0][1], 0, 0, 0);          \
    acc[1][0] = __builtin_amdgcn_mfma_f32_32x32x16_bf16(P##a0_1, P##b0_0, acc[1][0], 0, 0, 0);          \
    acc[1][1] = __builtin_amdgcn_mfma_f32_32x32x16_bf16(P##a0_1, P##b0_1, acc[1][1], 0, 0, 0);          \
    acc[0][0] = __builtin_amdgcn_mfma_f32_32x32x16_bf16(P##a1_0, P##b1_0, acc[0][0], 0, 0, 0);          \
    acc[0][1] = __builtin_amdgcn_mfma_f32_32x32x16_bf16(P##a1_0, P##b1_1, acc[0][1], 0, 0, 0);          \
    acc[1][0] = __builtin_amdgcn_mfma_f32_32x32x16_bf16(P##a1_1, P##b1_0, acc[1][0], 0, 0, 0);          \
    acc[1][1] = __builtin_amdgcn_mfma_f32_32x32x16_bf16(P##a1_1, P##b1_1, acc[1][1], 0, 0, 0);          \
  }
#define NEXT_TILE(P, KT1, STG)                                                     \
  {                                                                                \
    if ((KT1) + 2 <= KT - 1) asm volatile("s_waitcnt vmcnt(8)" ::: "memory");      \
    else if ((KT1) + 1 == KT - 1) asm volatile("s_waitcnt vmcnt(4)" ::: "memory"); \
    else asm volatile("s_waitcnt vmcnt(0)" ::: "memory");                          \
    asm volatile("s_waitcnt lgkmcnt(0)" ::: "memory");                             \
    __builtin_amdgcn_s_barrier();                                                  \
    if ((KT1) + 3 < KT) glds((KT1) + 3);                                           \
    FRAG_LOAD(P, STG)                                                              \
  }

  constexpr int KT = K / 32;
  static_assert(KT % 2 == 0, "k-tile count must be even");
  asm volatile("s_waitcnt vmcnt(0)" ::: "memory");
  glds(0);
  glds(1);
  glds(2);
  asm volatile("s_waitcnt vmcnt(8)" ::: "memory");
  asm volatile("s_waitcnt lgkmcnt(0)" ::: "memory");
  __builtin_amdgcn_s_barrier();
  glds(3);
  FRAG_LOAD(f, 0)
  static_assert(KT % 4 == 0, "k-tile count must be a multiple of the ring depth");
#pragma unroll 1
  for (int kt = 0; kt < KT; kt += 4) {
    NEXT_TILE(g, kt + 1, 1)
    FRAG_MMA(f)
    NEXT_TILE(f, kt + 2, 2)
    FRAG_MMA(g)
    NEXT_TILE(g, kt + 3, 3)
    FRAG_MMA(f)
    if (kt + 4 < KT) {
      NEXT_TILE(f, kt + 4, 0)
    } else {
      asm volatile("s_waitcnt lgkmcnt(0)" ::: "memory");
    }
    FRAG_MMA(g)
  }
#undef NEXT_TILE
#undef FRAG_MMA
#undef FRAG_LOAD
#undef FRAG_LOAD_STG
#undef DSR
  asm volatile("s_waitcnt lgkmcnt(0)" ::: "memory");
  __builtin_amdgcn_s_barrier();

  if (!EPI) {
    float sacc = 0.f;
#pragma unroll
    for (int a = 0; a < 2; ++a)
#pragma unroll
      for (int b = 0; b < 2; ++b)
#pragma unroll
        for (int i = 0; i < 16; ++i) sacc += acc[a][b][i];
    if (sacc == 12345.678f) p.ctr[8] = 1u;
    return;
  }
  int tide = tid;
  asm volatile("" : "+v"(tide));
  const int lane_e = tide & 63;
  const int h5 = lane_e >> 5, cl = lane_e & 31;
  auto each = [&](auto&& f) __attribute__((always_inline)) {
#pragma unroll
    for (int mi = 0; mi < 2; ++mi)
#pragma unroll
      for (int ni = 0; ni < 2; ++ni)
#pragma unroll
        for (int i = 0; i < 16; ++i) {
          const int rl = wm * 64 + mi * 32 + crow(i, h5);
          f(ni, rl, m0 + rl, n0 + wn * 64 + ni * 32 + cl, acc[mi][ni][i]);
        }
  };
  if (MODE == G_PROJ) {
    const int ct = nt;
    if (ct == 10) {
      each([&](int ni, int rl, int row, int col, float v) {
        const int c2 = col - 1280;
        if (c2 < 24) p.glb[(size_t)row * 24 + c2] = sigmoidf_(v);
      });
    } else {
      bf16_t* tl = (bf16_t*)smem;
      if (ct == 6 || ct == 8) {
        each([&](int ni, int rl, int row, int col, float v) {
          if (ni == 0) {
            float other = __shfl_xor(v, 8);
            if (cl < 16) {
              float2 cs = p.rope[(row & 2047) * 8 + (cl & 7)];
              v = (cl < 8) ? (v * cs.x - other * cs.y) : (v * cs.x + other * cs.y);
            }
          }
          tl[rl * 136 + (col - n0)] = f2bf(v);
        });
      } else if ((ct >= 11 && ct < 15) || ct >= 28) {
        each([&](int ni, int rl, int row, int col, float v) { tl[rl * 136 + (col - n0)] = f2bf(siluf_(v)); });
      } else {
        each([&](int ni, int rl, int row, int col, float v) { tl[rl * 136 + (col - n0)] = f2bf(v); });
      }
      __syncthreads();
      if (ct == 7 || ct == 9) {
        bf16_t* d2 = (ct == 7) ? p.vsT : p.vwT;
        const int b = m0 >> 11, s0 = m0 & 2047;
#pragma unroll
        for (int i = 0; i < 8; ++i) {
          const int idx = tide + 256 * i;
          const int c2 = idx & 127, rseg = idx >> 7;
          unsigned short e[8];
#pragma unroll
          for (int j = 0; j < 8; ++j) e[j] = tl[(rseg * 8 + j) * 136 + c2];
          uint4 o;
          o.x = e[0] | ((unsigned)e[1] << 16); o.y = e[2] | ((unsigned)e[3] << 16);
          o.z = e[4] | ((unsigned)e[5] << 16); o.w = e[6] | ((unsigned)e[7] << 16);
          *(uint4*)(d2 + ((size_t)((b * 2 + (c2 >> 6)) * 64 + (c2 & 63))) * VTS + s0 + rseg * 8) = o;
        }
      } else {
        bf16_t* dst;
        int ld, cb;
        if (ct < 4) { dst = p.qb; ld = 512; cb = n0; }
        else if (ct == 4) { dst = p.kcb; ld = LDKC; cb = 0; }
        else if (ct == 5) { dst = p.vcb; ld = LDKC; cb = 0; }
        else if (ct == 6) { dst = p.ksb; ld = 128; cb = 0; }
        else if (ct == 8) { dst = p.kwb; ld = 128; cb = 0; }
        else if (ct < 15) { dst = p.gns; ld = 512; cb = n0 - 1408; }
        else if (ct < 28) { dst = p.rw; ld = 1664; cb = n0 - 1920; }
        else { dst = p.grw; ld = 512; cb = n0 - 3584; }
#pragma unroll
        for (int i = 0; i < 8; ++i) {
          const int idx = tide + 256 * i;
          const int r = idx >> 4, sg = idx & 15;
          const uint4 v4 = *(const uint4*)(tl + r * 136 + sg * 8);
          *(uint4*)(dst + (size_t)(m0 + r) * ld + cb + sg * 8) = v4;
        }
      }
    }
  } else if (MODE == G_CMP1) {
    const float* bias = which ? p.bias1v : p.bias1k;
    bf16_t* hid = which ? p.hidv : p.hidk;
    each([&](int ni, int rl, int row, int col, float v) { hid[(size_t)row * LDHID + col] = f2bf(siluf_(v + bias[col])); });
  } else if (MODE == G_CMP2) {
    each([&](int ni, int rl, int row, int col, float v) {
      if (col < 64) {
        const int b = row >> 8, c = (row >> 1) & 127, g = row & 1;
        const int bg = b * 2 + g;
        bf16_t hv = (c < 127) ? f2bf(v) : (bf16_t)0;
        if (which == 0) {
          p.kcmp[((size_t)bg * 128 + c) * 64 + col] = hv;
        } else {
          p.vcmp[((size_t)bg * 128 + c) * 64 + col] = hv;
          p.vcmpT[((size_t)bg * 64 + col) * 128 + c] = hv;
        }
      }
    });
  } else {
    float xv[2][2][16];
#pragma unroll
    for (int mi = 0; mi < 2; ++mi)
#pragma unroll
      for (int ni = 0; ni < 2; ++ni)
#pragma unroll
        for (int i = 0; i < 16; ++i)
          xv[mi][ni][i] = p.x[(size_t)(m0 + wm * 64 + mi * 32 + crow(i, h5)) * 1024 + n0 + wn * 64 + ni * 32 + cl];
#pragma unroll
    for (int mi = 0; mi < 2; ++mi)
#pragma unroll
      for (int ni = 0; ni < 2; ++ni)
#pragma unroll
        for (int i = 0; i < 16; ++i)
          p.out[(size_t)(m0 + wm * 64 + mi * 32 + crow(i, h5)) * 1024 + n0 + wn * 64 + ni * 32 + cl] = xv[mi][ni][i] + acc[mi][ni][i];
  }
  __syncthreads();
}

DI float shiftv(const Params& p, int tok, int col) {
  float cur = bf2f(p.rw[(size_t)tok * 1664 + col]);
  float prev = (tok & 2047) ? bf2f(p.rw[(size_t)(tok - 1) * 1664 + col]) : 0.f;
  return cur + p.mu[col] * (prev - cur);
}

DI void unpack8(uint4 u, float (&f)[8]) {
  f[0] = __uint_as_float(u.x << 16); f[1] = __uint_as_float(u.x & 0xffff0000u);
  f[2] = __uint_as_float(u.y << 16); f[3] = __uint_as_float(u.y & 0xffff0000u);
  f[4] = __uint_as_float(u.z << 16); f[5] = __uint_as_float(u.z & 0xffff0000u);
  f[6] = __uint_as_float(u.w << 16); f[7] = __uint_as_float(u.w & 0xffff0000u);
}
DI uint4 pack8(const float (&f)[8]) {
  uint4 o;
  o.x = pk2(f[0], f[1]);
  o.y = pk2(f[2], f[3]);
  o.z = pk2(f[4], f[5]);
  o.w = pk2(f[6], f[7]);
  return o;
}
DI void ld8f(const float* ptr, float (&f)[8]) {
  const float4 a = *(const float4*)ptr, b = *(const float4*)(ptr + 4);
  f[0] = a.x; f[1] = a.y; f[2] = a.z; f[3] = a.w; f[4] = b.x; f[5] = b.y; f[6] = b.z; f[7] = b.w;
}
DI void shift8(const Params& p, int tok, int col, float (&o)[8]) {
  float c[8], pv[8], m[8];
  unpack8(*(const uint4*)(p.rw + (size_t)tok * 1664 + col), c);
  uint4 pu = make_uint4(0u, 0u, 0u, 0u);
  if (tok & 2047) pu = *(const uint4*)(p.rw + (size_t)(tok - 1) * 1664 + col);
  unpack8(pu, pv);
  ld8f(p.mu + col, m);
#pragma unroll
  for (int j = 0; j < 8; ++j) o[j] = c[j] + m[j] * (pv[j] - c[j]);
}

DI void rwkv_prep_tile(const Params& p, int tile, char* smem) {
  const int t0 = tile * 32;
  bf16_t* sW = (bf16_t*)smem;
  bf16_t* sAd = sW + 32 * 72;
  bf16_t* sA = sAd + 32 * 72;
  int tid = threadIdx.x;
  asm volatile("" : "+v"(tid));
  const int lane = tid & 63, wave = tid >> 6;
#pragma unroll
  for (int i = 0; i < 2; ++i) {
    const int idx = tid + 256 * i, m = idx >> 4, sg = idx & 15;
    float v[8];
    shift8(p, t0 + m, 1536 + sg * 8, v);
    if (sg < 8) {
#pragma unroll
      for (int j = 0; j < 8; ++j) v[j] = tanhf(v[j]);
      *(uint4*)(sW + m * 72 + sg * 8) = pack8(v);
    } else {
      *(uint4*)(sAd + m * 72 + (sg - 8) * 8) = pack8(v);
    }
  }
  __syncthreads();
  const int h5 = lane >> 5, cl = lane & 31;
#pragma unroll 1
  for (int sp = 0; sp < 8; ++sp) {
    const int pass = sp >> 2, ni = sp & 3;
    const bf16_t* As = pass ? sAd : sW;
    const bf16_t* Bt = pass ? p.AupT : p.WupT;
    const int n = wave * 128 + ni * 32 + cl;
    f32x16 acc;
#pragma unroll
    for (int i = 0; i < 16; ++i) acc[i] = 0.f;
#pragma unroll
    for (int ks = 0; ks < 4; ++ks) {
      bf16x8 af = *(const bf16x8*)(As + cl * 72 + ks * 16 + h5 * 8);
      bf16x8 bfr = *(const bf16x8*)(Bt + (size_t)n * 64 + ks * 16 + h5 * 8);
      acc = __builtin_amdgcn_mfma_f32_32x32x16_bf16(af, bfr, acc, 0, 0, 0);
    }
    if (pass == 0) {
      const float w0n = p.w0[n];
#pragma unroll
      for (int i = 0; i < 16; ++i) {
        const int tok = t0 + crow(i, h5);
        const float sg = 1.f / (1.f + __expf(-(w0n + acc[i])));
        p.dec[(size_t)tok * 512 + n] = __expf(-0.6065306597126334f * sg);
      }
    } else {
      const float a0n = p.a0[n];
#pragma unroll
      for (int i = 0; i < 16; ++i) sA[crow(i, h5) * 520 + n] = f2bf(1.f / (1.f + __expf(-(a0n + acc[i]))));
    }
  }
  __syncthreads();
#pragma unroll 1
  for (int i = 0; i < 8; ++i) {
    const int idx = tid + 256 * i, m = idx >> 6, ch0 = (idx & 63) * 8;
    const int tok = t0 + m;
    const size_t o = (size_t)tok * 512 + ch0;
    float rs[8], ks[8], vs[8], a[8], kkc[8], kac[8];
    shift8(p, tok, ch0, rs);
    shift8(p, tok, 512 + ch0, ks);
    shift8(p, tok, 1024 + ch0, vs);
    unpack8(*(const uint4*)(sA + m * 520 + ch0), a);
    ld8f(p.k_k + ch0, kkc);
    ld8f(p.k_a + ch0, kac);
    float kkr[8], ssq = 0.f;
#pragma unroll
    for (int j = 0; j < 8; ++j) { kkr[j] = ks[j] * kkc[j]; ssq += kkr[j] * kkr[j]; }
    ssq += __shfl_xor(ssq, 1);
    ssq += __shfl_xor(ssq, 2);
    ssq += __shfl_xor(ssq, 4);
    const float inv = 1.0f / fmaxf(sqrtf(ssq), 1e-12f);
    float kp[8], bb[8];
#pragma unroll
    for (int j = 0; j < 8; ++j) {
      kkr[j] *= inv;
      kp[j] = ks[j] * (1.f + (a[j] - 1.f) * kac[j]);
      bb[j] = kkr[j] * a[j];
    }
    *(uint4*)(p.rr + o) = pack8(rs);
    *(uint4*)(p.kp + o) = pack8(kp);
    *(uint4*)(p.vv + o) = pack8(vs);
    *(uint4*)(p.kk + o) = pack8(kkr);
    *(uint4*)(p.bb + o) = pack8(bb);
  }
  __syncthreads();
}

constexpr int SCH = 16;
constexpr int SSTR = 336;

DI void scan_item(const Params& p, int item, char* smem) {
  const int xcd = item & 7, slot = item >> 3;
  const int bh = xcd * 8 + (slot >> 2), rg = slot & 3;
  const int b = bh >> 3, h = bh & 7, row0 = rg * 16;
  float* buf = (float*)smem;
  float* ybuf = buf + 2 * SCH * SSTR;
  int tid = threadIdx.x;
  asm volatile("" : "+v"(tid));
  const int lane = tid & 63, wave = tid >> 6;
  const int q = lane >> 4, c = lane & 15, lr = wave * 4 + q;
  const size_t tokb = (size_t)b * 2048;

  const bf16_t* ap[2];
  int ast[2], aseg[2], aslot[2];
#pragma unroll
  for (int i = 0; i < 2; ++i) {
    int e = tid + 256 * i;
    int arr = e >> 7;
    ast[i] = (e >> 3) & 15;
    aseg[i] = e & 7;
    ap[i] = arr == 0 ? p.rr : arr == 1 ? p.kp : arr == 2 ? p.kk : p.bb;
    aslot[i] = arr == 0 ? 4 : arr;
  }
  const int dst_ = tid >> 4, dseg = tid & 15;
  const int vst = (tid >> 1) & 15, vseg = tid & 1;
  struct Stage { uint4 g0, g1, gv; float4 gd; };
  auto gload = [&](Stage& S, int ci) {
    const size_t s0 = tokb + (size_t)ci * SCH;
    S.g0 = *(const uint4*)(ap[0] + (s0 + ast[0]) * 512 + h * 64 + aseg[0] * 8);
    S.g1 = *(const uint4*)(ap[1] + (s0 + ast[1]) * 512 + h * 64 + aseg[1] * 8);
    S.gd = *(const float4*)(p.dec + (s0 + dst_) * 512 + h * 64 + dseg * 4);
    if (tid < 32) S.gv = *(const uint4*)(p.vv + (s0 + vst) * 512 + h * 64 + row0 + vseg * 8);
  };
  auto cvt8 = [&](uint4 u, float* d) {
    float4 a, b2;
    a.x = __uint_as_float(u.x << 16); a.y = __uint_as_float(u.x & 0xffff0000u);
    a.z = __uint_as_float(u.y << 16); a.w = __uint_as_float(u.y & 0xffff0000u);
    b2.x = __uint_as_float(u.z << 16); b2.y = __uint_as_float(u.z & 0xffff0000u);
    b2.z = __uint_as_float(u.w << 16); b2.w = __uint_as_float(u.w & 0xffff0000u);
    *(float4*)d = a;
    *(float4*)(d + 4) = b2;
  };
  auto sstore = [&](const Stage& S, int nbuf) {
    float* B = buf + nbuf * SCH * SSTR;
    cvt8(S.g0, B + ast[0] * SSTR + aslot[0] * 64 + aseg[0] * 8);
    cvt8(S.g1, B + ast[1] * SSTR + aslot[1] * 64 + aseg[1] * 8);
    *(float4*)(B + dst_ * SSTR + dseg * 4) = S.gd;
    if (tid < 32) cvt8(S.gv, B + vst * SSTR + 320 + vseg * 8);
  };

  f32x2_t sA = {0.f, 0.f}, sB = {0.f, 0.f};
  auto compute = [&](int ci, int cb) {
    const float* B = buf + cb * SCH * SSTR;
    float* Y = ybuf + cb * 256;
    const float* Lc = B + 4 * c;
    const float* Lv = B + 320 + lr;
    float4 w0_ = *(const float4*)(Lc), k0_ = *(const float4*)(Lc + 64), q0_ = *(const float4*)(Lc + 128),
           b0_ = *(const float4*)(Lc + 192), r0_ = *(const float4*)(Lc + 256);
    float v0_ = Lv[0];
    float4 w1_, k1_, q1_, b1_, r1_;
    float v1_;
    float pp;
    {
      const f32x2_t k0 = {q0_.x, q0_.y}, k1 = {q0_.z, q0_.w};
      f32x2_t pq = sA * k0;
      pq = sB * k1 + pq;
      pp = allred16(pq.x + pq.y);
    }
    float ysel = 0.f;
#define SCAN_STEP(W, K, BV, R, V, NW, NK, NQ, NB, NR, NV, ST)                                          \
  {                                                                                                    \
    if ((ST) + 1 < SCH) {                                                                              \
      NW = *(const float4*)(Lc + ((ST) + 1) * SSTR);                                                   \
      NK = *(const float4*)(Lc + ((ST) + 1) * SSTR + 64);                                              \
      NQ = *(const float4*)(Lc + ((ST) + 1) * SSTR + 128);                                             \
      NB = *(const float4*)(Lc + ((ST) + 1) * SSTR + 192);                                             \
      NR = *(const float4*)(Lc + ((ST) + 1) * SSTR + 256);                                             \
      NV = Lv[((ST) + 1) * SSTR];                                                                      \
    }                                                                                                  \
    const f32x2_t wa = {W.x, W.y}, wb = {W.z, W.w}, ka = {K.x, K.y}, kb = {K.z, K.w}, ba = {BV.x, BV.y}, \
                  bb2 = {BV.z, BV.w}, ra = {R.x, R.y}, rb = {R.z, R.w}, qa = {NQ.x, NQ.y}, qb = {NQ.z, NQ.w}; \
    const f32x2_t msa = {-pp, -pp}, vv2 = {V, V};                                                      \
    const f32x2_t t0 = ba * msa + ka * vv2, t1 = bb2 * msa + kb * vv2;                                 \
    sA = sA * wa + t0;                                                                                 \
    sB = sB * wb + t1;                                                                                 \
    f32x2_t yq = sA * ra;                                                                              \
    yq = sB * rb + yq;                                                                                 \
    f32x2_t pq = sA * qa;                                                                              \
    pq = sB * qb + pq;                                                                                 \
    float ys = yq.x + yq.y, ps = pq.x + pq.y;                                                          \
    ys += dppf<0xB1>(ys);  ps += dppf<0xB1>(ps);                                                       \
    ys += dppf<0x4E>(ys);  ps += dppf<0x4E>(ps);                                                       \
    ys += dppf<0x141>(ys); ps += dppf<0x141>(ps);                                                      \
    ys += dppf<0x128>(ys); ps += dppf<0x128>(ps);                                                      \
    pp = ps;                                                                                           \
    ysel = (c == (ST)) ? ys : ysel;                                                                    \
  }
#pragma unroll 2
    for (int st = 0; st < SCH; st += 2) {
      SCAN_STEP(w0_, k0_, b0_, r0_, v0_, w1_, k1_, q1_, b1_, r1_, v1_, st)
      SCAN_STEP(w1_, k1_, b1_, r1_, v1_, w0_, k0_, q0_, b0_, r0_, v0_, st + 1)
    }
#undef SCAN_STEP
    Y[c * 16 + lr] = ysel;
  };
  auto flush = [&](int ci, int cb) {
    const int st = tid >> 4, rr_ = tid & 15;
    p.yraw[(tokb + (size_t)ci * SCH + st) * 512 + h * 64 + row0 + rr_] = (ybuf + cb * 256)[tid];
  };

  constexpr int NCH = S_ / SCH;
  Stage SA, SB;
  gload(SA, 0);
  gload(SB, 1);
  sstore(SA, 0);
  __syncthreads();
  for (int ci = 0; ci < NCH; ci += 2) {
    if (ci + 2 < NCH) gload(SA, ci + 2);
    compute(ci, 0);
    sstore(SB, 1);
    __syncthreads();
    flush(ci, 0);
    if (ci + 3 < NCH) gload(SB, ci + 3);
    compute(ci + 1, 1);
    if (ci + 2 < NCH) sstore(SA, 0);
    __syncthreads();
    flush(ci + 1, 1);
  }
  __syncthreads();
}

#define MFMA16(a, b, c) __builtin_amdgcn_mfma_f32_16x16x32_bf16((a), (b), (c), 0, 0, 0)
DI float ex2(float x) { return __builtin_amdgcn_exp2f(x); }
constexpr float SCL2 = 0.18033688011112042f;
constexpr float NEGB = -1e30f;

DI unsigned topk8(const float* imp, int tblk) {
  float v[32];
#pragma unroll
  for (int j = 0; j < 32; ++j) {
    float xv = imp[j];
    bool forced = (j == 0) | (j == tblk) | (j == tblk - 1);
    v[j] = (j <= tblk) ? (xv + (forced ? 1000.f : 0.f)) : -1.f;
  }
  unsigned sel = 0;
#pragma unroll
  for (int r = 0; r < 8; ++r) {
    float best = -3e38f;
    int bi = 0;
#pragma unroll
    for (int j = 0; j < 32; ++j) {
      bool ok = (((sel >> j) & 1u) == 0u) && (v[j] > best);
      best = ok ? v[j] : best;
      bi = ok ? j : bi;
    }
    sel |= 1u << bi;
  }
  return sel;
}

DI void head_step(const bf16x8& k00, const bf16x8& k01, const bf16x8& k10, const bf16x8& k11, const bf16x8& v0, const bf16x8& v1,
                  const bf16x8& v2, const bf16x8& v3, const bf16x8& q0, const bf16x8& q1, const float (&bias)[8], f32x4& O0,
                  f32x4& O1, f32x4& O2, f32x4& O3, float& m, float& l) {
  f32x4 sa = {0.f, 0.f, 0.f, 0.f}, sb = {0.f, 0.f, 0.f, 0.f};
  sa = MFMA16(k00, q0, sa);
  sb = MFMA16(k10, q0, sb);
  sa = MFMA16(k01, q1, sa);
  sb = MFMA16(k11, q1, sb);
  float sc[8];
  float cm = -3e38f;
#pragma unroll
  for (int e = 0; e < 8; ++e) {
    sc[e] = fmaf((e < 4) ? sa[e & 3] : sb[e & 3], SCL2, bias[e]);
    cm = fmaxf(cm, sc[e]);
  }
  if (__builtin_amdgcn_ballot_w64(cm > m) != 0ull) {
    cm = fmaxf(cm, __shfl_xor(cm, 16));
    cm = fmaxf(cm, __shfl_xor(cm, 32));
    const float mn = fmaxf(m, cm);
    const float alpha = ex2(m - mn);
    m = mn;
    l *= alpha;
    O0 *= alpha; O1 *= alpha; O2 *= alpha; O3 *= alpha;
  }
  float ps = 0.f;
  float pe[8];
#pragma unroll
  for (int e = 0; e < 8; ++e) {
    pe[e] = ex2(sc[e] - m);
    ps += pe[e];
  }
  l += ps;
  union { unsigned u[4]; bf16x8 v; } pk;
  pk.u[0] = pk2(pe[0], pe[1]); pk.u[1] = pk2(pe[2], pe[3]); pk.u[2] = pk2(pe[4], pe[5]); pk.u[3] = pk2(pe[6], pe[7]);
  O0 = MFMA16(v0, pk.v, O0);
  O1 = MFMA16(v1, pk.v, O1);
  O2 = MFMA16(v2, pk.v, O2);
  O3 = MFMA16(v3, pk.v, O3);
}

template <int MODE>
DI void attend(unsigned long long cmask, const bf16_t* __restrict__ Kb, const bf16_t* __restrict__ VT, const bf16x8* ql, int t,
               int t0, unsigned selmask, int n, int q4, f32x4 (&O)[4][4], float (&m)[4], float (&l)[4]) {
  const int krow = (n >> 2) * 8 + (n & 3);
  const bf16_t* Kl = Kb + (size_t)krow * 128 + q4 * 8;
  const bf16_t* Vl = VT + (size_t)n * VTS + q4 * 8;
  if (!cmask) return;
  int cur = __ffsll(cmask) - 1;
  cmask &= cmask - 1;
  bf16x8 k00, k01, k10, k11;
  {
    const bf16_t* kp_ = Kl + (size_t)cur * 32 * 128;
    k00 = *(const bf16x8*)(kp_); k01 = *(const bf16x8*)(kp_ + 32);
    k10 = *(const bf16x8*)(kp_ + 4 * 128); k11 = *(const bf16x8*)(kp_ + 4 * 128 + 32);
  }
  while (true) {
    int nxt = -1;
    if (cmask) { nxt = __ffsll(cmask) - 1; cmask &= cmask - 1; }
    bf16x8 n00, n01, n10, n11, v0, v1, v2, v3;
    {
      const bf16_t* vp_ = Vl + cur * 32;
      v0 = *(const bf16x8*)(vp_); v1 = *(const bf16x8*)(vp_ + 16 * VTS);
      v2 = *(const bf16x8*)(vp_ + 32 * VTS); v3 = *(const bf16x8*)(vp_ + 48 * VTS);
    }
    if (nxt >= 0) {
      const bf16_t* kp_ = Kl + (size_t)nxt * 32 * 128;
      n00 = *(const bf16x8*)(kp_); n01 = *(const bf16x8*)(kp_ + 32);
      n10 = *(const bf16x8*)(kp_ + 4 * 128); n11 = *(const bf16x8*)(kp_ + 4 * 128 + 32);
    }
    const int kb = cur * 32;
    const int key0 = kb + q4 * 8;
    bool blk = true;
    if (MODE == 1) blk = ((selmask >> (kb >> 6)) & 1u) != 0u;
    float bias[8];
#pragma unroll
    for (int e = 0; e < 8; ++e) {
      const int key = key0 + e;
      bool v = blk && (key <= t);
      if (MODE == 2) v = v && (key + 512 > t);
      bias[e] = v ? 0.f : NEGB;
    }
#pragma unroll
    for (int r = 0; r < 4; ++r) {
      const bf16x8 q0 = ql[(r * 2 + 0) * 64], q1 = ql[(r * 2 + 1) * 64];
      head_step(k00, k01, k10, k11, v0, v1, v2, v3, q0, q1, bias, O[r][0], O[r][1], O[r][2], O[r][3], m[r], l[r]);

    }
    if (nxt < 0) break;
    k00 = n00; k01 = n01; k10 = n10; k11 = n11;
    cur = nxt;
  }
}

constexpr int NSA_WFLOATS = 16 * 132 + 16 * 32;

__device__ void nsa_wave_item(const Params& p, int item, float* wl) {
  int tx_ = threadIdx.x;
  asm volatile("" : "+v"(tx_));
  const int lane = tx_ & 63, n = lane & 15, q4 = lane >> 4;
  const int bg = item & 15, tt = item >> 4;
  const int b = bg >> 1, g = bg & 1, t0 = tt * 16, t = t0 + n;
  const size_t tok = (size_t)b * 2048 + t;
  float* impb = wl + 2048;
  bf16x8* ql = (bf16x8*)wl + lane;
  const int krow = (n >> 2) * 8 + (n & 3);

#pragma unroll
  for (int r = 0; r < 4; ++r)
#pragma unroll
    for (int kd = 0; kd < 2; ++kd) ql[(r * 2 + kd) * 64] = *(const bf16x8*)(p.qb + tok * 512 + (g * 4 + r) * 64 + kd * 32 + q4 * 8);
  const float* gatep = p.glb + tok * 24 + g * 12;
  bf16_t* mixl = p.mix + tok * LDH + (g * 4) * 64 + q4 * 4;
  f32x4 Oc[4][4];

  {
    const bf16_t* Kc = p.kcmp + (size_t)bg * 128 * 64;
    const bf16_t* VcT = p.vcmpT + (size_t)bg * 64 * 128;
    const int nch = (t0 + 15 >= 31) ? ((min((t0 + 15 - 31) >> 4, 126) >> 5) + 1) : 0;
#pragma unroll
    for (int e = 0; e < 9; ++e) impb[lane * 9 + e] = 0.f;
    float m[4], l[4];
#pragma unroll
    for (int r = 0; r < 4; ++r) { m[r] = NEGB; l[r] = 0.f; }
#pragma unroll 1
    for (int ch = 0; ch < nch; ++ch) {
      const int kb = ch * 32;
      bf16x8 kf[2][2];
#pragma unroll
      for (int sub = 0; sub < 2; ++sub)
#pragma unroll
        for (int kd = 0; kd < 2; ++kd) kf[sub][kd] = *(const bf16x8*)(Kc + (size_t)(kb + krow + sub * 4) * 64 + kd * 32 + q4 * 8);
#pragma unroll
      for (int r = 0; r < 4; ++r) {
        f32x4 sa = {0.f, 0.f, 0.f, 0.f}, sb = {0.f, 0.f, 0.f, 0.f};
#pragma unroll
        for (int kd = 0; kd < 2; ++kd) {
          const bf16x8 qv = ql[(r * 2 + kd) * 64];
          sa = MFMA16(kf[0][kd], qv, sa);
          sb = MFMA16(kf[1][kd], qv, sb);
        }
        float sc[8];
        float cm = NEGB;
#pragma unroll
        for (int e = 0; e < 8; ++e) {
          const int c = kb + q4 * 8 + e;
          const bool v = (16 * c + 31 <= t);
          float x = ((e < 4) ? sa[e & 3] : sb[e & 3]) * SCL2;
          sc[e] = v ? x : NEGB;
          cm = fmaxf(cm, sc[e]);
        }
        cm = fmaxf(cm, __shfl_xor(cm, 16));
        cm = fmaxf(cm, __shfl_xor(cm, 32));
        const float mn = fmaxf(m[r], cm);
        float ps = 0.f;
#pragma unroll
        for (int e = 0; e < 8; ++e) ps += (sc[e] > -1e29f) ? ex2(sc[e] - mn) : 0.f;
        l[r] = l[r] * ex2(m[r] - mn) + ps;
        m[r] = mn;
        __builtin_amdgcn_sched_barrier(0);
      }
    }
    float inv[4];
#pragma unroll
    for (int r = 0; r < 4; ++r) {
      float lv = l[r];
      lv += __shfl_xor(lv, 16);
      lv += __shfl_xor(lv, 32);
      inv[r] = (lv > 0.f) ? 1.f / lv : 0.f;
    }
#pragma unroll
    for (int dt = 0; dt < 4; ++dt)
#pragma unroll
      for (int r = 0; r < 4; ++r) Oc[dt][r] = f32x4{0.f, 0.f, 0.f, 0.f};
#pragma unroll 1
    for (int ch = 0; ch < nch; ++ch) {
      const int kb = ch * 32;
      bf16x8 kf[2][2];
#pragma unroll
      for (int sub = 0; sub < 2; ++sub)
#pragma unroll
        for (int kd = 0; kd < 2; ++kd) kf[sub][kd] = *(const bf16x8*)(Kc + (size_t)(kb + krow + sub * 4) * 64 + kd * 32 + q4 * 8);
      bf16x8 vf[4];
#pragma unroll
      for (int dt = 0; dt < 4; ++dt) vf[dt] = *(const bf16x8*)(VcT + (size_t)(dt * 16 + n) * 128 + kb + q4 * 8);
      float psm[8];
#pragma unroll
      for (int e = 0; e < 8; ++e) psm[e] = 0.f;
      bf16x8 pf[4];
#pragma unroll
      for (int r = 0; r < 4; ++r) {
        f32x4 sa = {0.f, 0.f, 0.f, 0.f}, sb = {0.f, 0.f, 0.f, 0.f};
#pragma unroll
        for (int kd = 0; kd < 2; ++kd) {
          const bf16x8 qv = ql[(r * 2 + kd) * 64];
          sa = MFMA16(kf[0][kd], qv, sa);
          sb = MFMA16(kf[1][kd], qv, sb);
        }
        float pe[8];
#pragma unroll
        for (int e = 0; e < 8; ++e) {
          const int c = kb + q4 * 8 + e;
          const bool v = (16 * c + 31 <= t);
          float x = ((e < 4) ? sa[e & 3] : sb[e & 3]) * SCL2;
          pe[e] = v ? ex2(x - m[r]) * inv[r] : 0.f;
          psm[e] += pe[e];
        }
        union { unsigned u[4]; bf16x8 v; } pk;
        pk.u[0] = pk2(pe[0], pe[1]); pk.u[1] = pk2(pe[2], pe[3]); pk.u[2] = pk2(pe[4], pe[5]); pk.u[3] = pk2(pe[6], pe[7]);
        pf[r] = pk.v;
        __builtin_amdgcn_sched_barrier(0);
      }
      {
        float* ip = impb + n * 36 + (kb >> 2) + 2 * q4;
        ip[0] += psm[0] + psm[1] + psm[2] + 0.5f * psm[3];
        __builtin_amdgcn_fence(__ATOMIC_ACQ_REL, "workgroup");
        __builtin_amdgcn_wave_barrier();
        ip[1] += 0.5f * psm[3] + psm[4] + psm[5] + psm[6] + 0.5f * psm[7];
        __builtin_amdgcn_fence(__ATOMIC_ACQ_REL, "workgroup");
        __builtin_amdgcn_wave_barrier();
        ip[2] += 0.5f * psm[7];
        __builtin_amdgcn_fence(__ATOMIC_ACQ_REL, "workgroup");
        __builtin_amdgcn_wave_barrier();
      }
#pragma unroll
      for (int dt = 0; dt < 4; ++dt)
#pragma unroll
        for (int r = 0; r < 4; ++r) Oc[dt][r] = MFMA16(vf[dt], pf[r], Oc[dt][r]);
    }
  }
#pragma unroll
  for (int r = 0; r < 4; ++r) {
    const float gsc = gatep[r * 3 + 0];
#pragma unroll
    for (int dt = 0; dt < 4; ++dt) {
      uint2 o;
      o.x = pk2(Oc[dt][r][0] * gsc, Oc[dt][r][1] * gsc);
      o.y = pk2(Oc[dt][r][2] * gsc, Oc[dt][r][3] * gsc);
      *(uint2*)(mixl + r * 64 + dt * 16) = o;
    }
  }
  __builtin_amdgcn_fence(__ATOMIC_ACQ_REL, "workgroup");
  __builtin_amdgcn_wave_barrier();
  const int tblk = t0 >> 6;
  unsigned selmask = topk8(impb + n * 36, tblk);
  selmask &= (tblk >= 31) ? 0xffffffffu : ((1u << (tblk + 1)) - 1u);
  __builtin_amdgcn_wave_barrier();

#pragma unroll
  for (int r = 0; r < 4; ++r) {
    const bf16x8 q0 = ql[(r * 2 + 0) * 64];
    union { unsigned u[4]; bf16x8 v; } pk;
    float vals[8];
#pragma unroll
    for (int j = 0; j < 8; ++j) {
      float xv = bf2f((bf16_t)q0[j]);
      float ov = __shfl_xor(xv, 16);
      float2 cs = p.rope[t * 8 + j];
      vals[j] = (q4 == 0) ? (xv * cs.x - ov * cs.y) : ((q4 == 1) ? (xv * cs.x + ov * cs.y) : xv);
    }
    pk.u[0] = pk2(vals[0], vals[1]); pk.u[1] = pk2(vals[2], vals[3]); pk.u[2] = pk2(vals[4], vals[5]); pk.u[3] = pk2(vals[6], vals[7]);
    ql[(r * 2 + 0) * 64] = pk.v;
  }

#pragma unroll 1
  for (int br = 1; br <= 2; ++br) {
    unsigned long long cmask = 0ull;
    const int hic = (t0 + 15) >> 5;
    if (br == 1) {
      unsigned any = selmask;
#pragma unroll
      for (int o = 32; o >= 1; o >>= 1) any |= (unsigned)__shfl_xor((int)any, o);
      any = __builtin_amdgcn_readfirstlane(any);
      for (int j = 0; j <= tblk; ++j)
        if ((any >> j) & 1u) cmask |= 3ull << (2 * j);
      if (hic < 63) cmask &= (1ull << (hic + 1)) - 1ull;
    } else {
      const int lo = max(0, t0 - 511) >> 5;
      cmask = (hic < 63) ? ((1ull << (hic + 1)) - 1ull) : ~0ull;
      cmask &= ~((1ull << lo) - 1ull);
    }
    f32x4 O[4][4];
    float m[4], l[4];
#pragma unroll
    for (int dt = 0; dt < 4; ++dt)
#pragma unroll
      for (int r = 0; r < 4; ++r) O[r][dt] = f32x4{0.f, 0.f, 0.f, 0.f};
#pragma unroll
    for (int r = 0; r < 4; ++r) { m[r] = -1e29f; l[r] = 0.f; }
    if (br == 1)
      attend<1>(cmask, p.ksb + (size_t)b * 2048 * 128 + g * 64, p.vsT + (size_t)bg * 64 * VTS, ql, t, t0, selmask, n, q4, O, m, l);
    else
      attend<2>(cmask, p.kwb + (size_t)b * 2048 * 128 + g * 64, p.vwT + (size_t)bg * 64 * VTS, ql, t, t0, selmask, n, q4, O, m, l);
#pragma unroll
    for (int r = 0; r < 4; ++r) {
      float lv = l[r];
      lv += __shfl_xor(lv, 16);
      lv += __shfl_xor(lv, 32);
      const float gsc = gatep[r * 3 + br] * ((lv > 0.f) ? 1.f / lv : 0.f);
#pragma unroll
      for (int dt = 0; dt < 4; ++dt) {
        uint2* mp = (uint2*)(mixl + r * 64 + dt * 16);
        const uint2 u = *mp;
        float a0 = __uint_as_float(u.x << 16) + O[r][dt][0] * gsc, a1 = __uint_as_float(u.x & 0xffff0000u) + O[r][dt][1] * gsc;
        float a2 = __uint_as_float(u.y << 16) + O[r][dt][2] * gsc, a3 = __uint_as_float(u.y & 0xffff0000u) + O[r][dt][3] * gsc;
        if (br == 2) {
          const uint2 gg = *(const uint2*)(p.gns + tok * 512 + (g * 4 + r) * 64 + dt * 16 + q4 * 4);
          a0 *= __uint_as_float(gg.x << 16); a1 *= __uint_as_float(gg.x & 0xffff0000u);
          a2 *= __uint_as_float(gg.y << 16); a3 *= __uint_as_float(gg.y & 0xffff0000u);
        }
        uint2 o;
        o.x = pk2(a0, a1);
        o.y = pk2(a2, a3);
        *mp = o;
      }
    }
  }
}

DI void phase_mix_rwkv(const Params& p) {
  int tx = threadIdx.x;
  asm volatile("" : "+v"(tx));
  const int lane = tx & 63, sub = lane >> 4, c = lane & 15;
  const int gw = blockIdx.x * 4 + (tx >> 6), nw = gridDim.x * 4;
  for (int it = gw; it < T_ * 2; it += nw) {
    const int ph = it * 4 + sub;
    const int tok = ph >> 3, h = ph & 7;
    const int ch = h * 64 + c * 4;
    const size_t idx = (size_t)tok * 512 + ch;
    const float4 y = *(const float4*)(p.yraw + idx);
    const float mean = allred16(y.x + y.y + y.z + y.w) * (1.f / 64.f);
    const float d0 = y.x - mean, d1 = y.y - mean, d2 = y.z - mean, d3 = y.w - mean;
    const float var = allred16(d0 * d0 + d1 * d1 + d2 * d2 + d3 * d3) * (1.f / 64.f);
    const float rs = rsqrtf(var + 64e-5f);
    const float4 gw4 = *(const float4*)(p.gn_w + ch), gb4 = *(const float4*)(p.gn_b + ch), rk4 = *(const float4*)(p.r_k + ch);
    const uint2 ru = *(const uint2*)(p.rr + idx), ku = *(const uint2*)(p.kp + idx), vu = *(const uint2*)(p.vv + idx),
                gu = *(const uint2*)(p.grw + idx);
    const float r0 = __uint_as_float(ru.x << 16), r1 = __uint_as_float(ru.x & 0xffff0000u), r2 = __uint_as_float(ru.y << 16),
                r3 = __uint_as_float(ru.y & 0xffff0000u);
    const float k0 = __uint_as_float(ku.x << 16), k1 = __uint_as_float(ku.x & 0xffff0000u), k2 = __uint_as_float(ku.y << 16),
                k3 = __uint_as_float(ku.y & 0xffff0000u);
    const float v0 = __uint_as_float(vu.x << 16), v1 = __uint_as_float(vu.x & 0xffff0000u), v2 = __uint_as_float(vu.y << 16),
                v3 = __uint_as_float(vu.y & 0xffff0000u);
    const float g0 = __uint_as_float(gu.x << 16), g1 = __uint_as_float(gu.x & 0xffff0000u), g2 = __uint_as_float(gu.y << 16),
                g3 = __uint_as_float(gu.y & 0xffff0000u);
    const float bonus = allred16(r0 * k0 * rk4.x + r1 * k1 * rk4.y + r2 * k2 * rk4.z + r3 * k3 * rk4.w);
    uint2 o;
    o.x = pk2((d0 * rs * gw4.x + gb4.x + bonus * v0) * g0, (d1 * rs * gw4.y + gb4.y + bonus * v1) * g1);
    o.y = pk2((d2 * rs * gw4.z + gb4.z + bonus * v2) * g2, (d3 * rs * gw4.w + gb4.w + bonus * v3) * g3);
    *(uint2*)(p.mix + (size_t)tok * LDH + 512 + ch) = o;
  }
}

DI void phase_final_norm(const Params& p) {
  int tx = threadIdx.x;
  asm volatile("" : "+v"(tx));
  const int lane = tx & 63;
  const int gw = blockIdx.x * 4 + (tx >> 6), nw = gridDim.x * 4;
  const float4* fg = (const float4*)p.final_g;
  for (int row = gw; row < T_; row += nw) {
    float4* o4 = (float4*)(p.out + (size_t)row * 1024);
    float4 v[4];
    float ss = 0.f;
#pragma unroll
    for (int i = 0; i < 4; ++i) {
      v[i] = o4[i * 64 + lane];
      ss += v[i].x * v[i].x + v[i].y * v[i].y + v[i].z * v[i].z + v[i].w * v[i].w;
    }
    ss = wsum(ss);
    const float sc = rsqrtf(ss * (1.f / 1024.f) + 1e-6f);
#pragma unroll
    for (int i = 0; i < 4; ++i) {
      float4 gq = fg[i * 64 + lane];
      v[i].x *= sc * gq.x; v[i].y *= sc * gq.y; v[i].z *= sc * gq.z; v[i].w *= sc * gq.w;
      {
        const f32x4 t_ = {v[i].x, v[i].y, v[i].z, v[i].w};
        __builtin_nontemporal_store(t_, (f32x4*)&o4[i * 64 + lane]);
      }
    }
  }
}

constexpr int NPHASE = 8;
constexpr int SMEM_BYTES = 65536;

template <int PH> DI void run_phase(const Params& p, char* smem) {
  const int bid = blockIdx.x, nb = gridDim.x;
  if (PH == 0) phase_prep(p, smem);
  if (PH == 1)
    for (int t = bid; t < 128 * 32; t += nb) gemm_tile<G_PROJ>(p, t >> 5, t & 31, 0, smem);
  if (PH == 2)
    if (nb > 128) {
      if (bid < 64) gemm_tile<G_CMP1>(p, (bid & 31) >> 1, bid & 1, bid >> 5, smem);
      else
        for (int t = bid - 64; t < 512; t += nb - 64) rwkv_prep_tile(p, t, smem);
    } else {
      for (int t = bid; t < 512 + 64; t += nb) {
        if (t < 64) gemm_tile<G_CMP1>(p, (t & 31) >> 1, t & 1, t >> 5, smem);
        else rwkv_prep_tile(p, t - 64, smem);
      }
    }
  if (PH == 3) {
    if (nb != 512)
      for (int t = bid; t < 32; t += nb) gemm_tile<G_CMP2>(p, t & 15, 0, t >> 4, smem);
  }
  if (PH == 4) {
    unsigned* flag = p.ctr + 40;
    if (nb == 512 && bid >= 256 && bid < 288) {
      const int t = bid - 256;
      gemm_tile<G_CMP2>(p, t & 15, 0, t >> 4, smem);
      asm volatile("s_waitcnt vmcnt(0)" ::: "memory");
      __syncthreads();
      if (threadIdx.x == 0) {
        __builtin_amdgcn_fence(__ATOMIC_RELEASE, "agent");
        asm volatile("s_waitcnt vmcnt(0)" ::: "memory");
        __hip_atomic_fetch_add(flag, 1u, __ATOMIC_RELAXED, __HIP_MEMORY_SCOPE_AGENT);
      }
    }
    for (int t = bid; t < 256; t += nb) scan_item(p, t, smem);
    if (nb == 512) {
      if (threadIdx.x == 0) {
        while (__hip_atomic_load(flag, __ATOMIC_RELAXED, __HIP_MEMORY_SCOPE_AGENT) < 32u) __builtin_amdgcn_s_sleep(2);
        __builtin_amdgcn_fence(__ATOMIC_ACQUIRE, "agent");
        asm volatile("s_waitcnt vmcnt(0)" ::: "memory");
      }
      __syncthreads();
    }
    float* wl = (float*)smem + (threadIdx.x >> 6) * NSA_WFLOATS;
    while (true) {
      int it = 0;
      if ((threadIdx.x & 63) == 0) it = (int)atomicAdd(p.ctr, 1u);
      it = __builtin_amdgcn_readfirstlane(it);
      if (it >= 2048) break;
      nsa_wave_item(p, (127 - (it >> 4)) * 16 + (it & 15), wl);
    }
  }
  if (PH == 5) phase_mix_rwkv(p);
  if (PH == 6)
    for (int t = bid; t < 128 * 8; t += nb) gemm_tile<G_OUT>(p, t >> 3, t & 7, 0, smem);
  if (PH == 7) phase_final_norm(p);
}

template <int PH> __global__ void __launch_bounds__(256, 2) phk(Params p) {
  __shared__ __attribute__((aligned(16))) char smem[SMEM_BYTES];
  run_phase<PH>(p, smem);
}

#ifndef PROBE_PH
#define PROBE_PH -1
#endif
#define XB_CNT(j) (256 + 64 * (j))
#define XB_SUB(j) (1280 + 64 * (j))
#define XB_GEN(j) (2304 + 64 * (j))
#define XB_TOP 3328
#define XB_TOPGEN 3392
DI unsigned xb_ld(unsigned* q) { return __hip_atomic_load(q, __ATOMIC_RELAXED, __HIP_MEMORY_SCOPE_AGENT); }
DI unsigned xb_add(unsigned* q, unsigned v) { return __hip_atomic_fetch_add(q, v, __ATOMIC_RELAXED, __HIP_MEMORY_SCOPE_AGENT); }
DI unsigned xb_xcc() { return (unsigned)__builtin_amdgcn_s_getreg((3 << 11) | 20) & 0xFu; }
DI void fast_barrier(unsigned* bar) {
  asm volatile("s_waitcnt vmcnt(0)" ::: "memory");
  __syncthreads();
  if (threadIdx.x == 0) {
    const unsigned x = xb_xcc();
    unsigned nloc, nx;
    for (;;) {
      unsigned sum = 0u;
      nloc = 1u;
      nx = 0u;
#pragma unroll
      for (unsigned j = 0; j < 16; ++j) {
        const unsigned c = xb_ld(&bar[XB_CNT(j)]);
        sum += c;
        nx += (c > 0u) ? 1u : 0u;
        nloc = (j == x) ? c : nloc;
      }
      if (sum == gridDim.x) break;
      __builtin_amdgcn_s_sleep(1);
    }
    const unsigned old = xb_add(&bar[XB_SUB(x)], 1u);
    const unsigned gen = old / nloc;
    if (old + 1u == (gen + 1u) * nloc) {
      __builtin_amdgcn_fence(__ATOMIC_RELEASE, "agent");
      asm volatile("s_waitcnt vmcnt(0)" ::: "memory");
      const unsigned og = xb_add(&bar[XB_TOP], 1u);
      const unsigned tg = og / nx;
      if (og + 1u == (tg + 1u) * nx) xb_add(&bar[XB_TOPGEN], 1u);
      else
        while (xb_ld(&bar[XB_TOPGEN]) == tg) __builtin_amdgcn_s_sleep(1);
      __builtin_amdgcn_fence(__ATOMIC_ACQUIRE, "agent");
      xb_add(&bar[XB_GEN(x)], 1u);
      asm volatile("s_waitcnt vmcnt(0)" ::: "memory");
    } else {
      while (xb_ld(&bar[XB_GEN(x)]) == gen) __builtin_amdgcn_s_sleep(1);
      __builtin_amdgcn_fence(__ATOMIC_ACQUIRE, "agent");
      asm volatile("s_waitcnt vmcnt(0)" ::: "memory");
    }
  }
  __syncthreads();
}

__global__ void __launch_bounds__(256, 2) mega(Params p) {
  __shared__ __attribute__((aligned(16))) char smem[SMEM_BYTES];
  cg::grid_group grid = cg::this_grid();
  unsigned* bar = p.xbar;
  const unsigned nblk = gridDim.x;
  if (p.ctr == nullptr) grid.sync();
  if (threadIdx.x == 0) (void)xb_add(&bar[XB_CNT(xb_xcc())], 1u);
  run_phase<0>(p, smem); fast_barrier(bar);
  run_phase<1>(p, smem); fast_barrier(bar);
  run_phase<2>(p, smem); fast_barrier(bar);
  if (nblk != 512u) { run_phase<3>(p, smem); fast_barrier(bar); }
  run_phase<4>(p, smem); fast_barrier(bar);
  run_phase<5>(p, smem); fast_barrier(bar);
  run_phase<6>(p, smem); fast_barrier(bar);
  run_phase<7>(p, smem);
}

extern "C" void kernel_launch(void* const* d_in, const int* in_sizes, int n_in, void* d_out, int out_size, void* d_ws, size_t ws_size,
                              hipStream_t stream) {
  Params p{};
  const float** pin = (const float**)&p;
  for (int i = 0; i < 21; ++i) pin[i] = (const float*)d_in[i];
  p.out = (float*)d_out;
  char* w = (char*)d_ws;
  size_t off = 0;
  auto alloc = [&](size_t bytes) { void* r = w + off; off += (bytes + 255) & ~(size_t)255; return r; };
  p.WinT = (bf16_t*)alloc((size_t)NPAD * LDW * 2);
  p.WoutT = (bf16_t*)alloc((size_t)1024 * LDW * 2);
  p.W1Tk = (bf16_t*)alloc((size_t)256 * LDW1 * 2);
  p.W1Tv = (bf16_t*)alloc((size_t)256 * LDW1 * 2);
  p.W2Tk = (bf16_t*)alloc((size_t)128 * LDW2 * 2);
  p.W2Tv = (bf16_t*)alloc((size_t)128 * LDW2 * 2);
  p.WupT = (bf16_t*)alloc((size_t)512 * 64 * 2);
  p.AupT = (bf16_t*)alloc((size_t)512 * 64 * 2);
  p.bias1k = (float*)alloc(256 * 4);
  p.bias1v = (float*)alloc(256 * 4);
  p.rope = (float2*)alloc((size_t)2048 * 8 * 8);
  p.qb = (bf16_t*)alloc((size_t)T_ * 512 * 2);
  p.kcb = (bf16_t*)alloc((size_t)(T_ + 16) * LDKC * 2);
  p.vcb = (bf16_t*)alloc((size_t)(T_ + 16) * LDKC * 2);
  p.ksb = (bf16_t*)alloc((size_t)T_ * 128 * 2);
  p.kwb = (bf16_t*)alloc((size_t)T_ * 128 * 2);
  p.vsb = nullptr;
  p.vwb = nullptr;
  p.vsT = (bf16_t*)alloc((size_t)16 * 64 * VTS * 2);
  p.vwT = (bf16_t*)alloc((size_t)16 * 64 * VTS * 2);
  p.glb = (float*)alloc((size_t)T_ * 24 * 4);
  p.gns = (bf16_t*)alloc((size_t)T_ * 512 * 2);
  p.rw = (bf16_t*)alloc((size_t)T_ * 1664 * 2);
  p.yraw = (float*)p.rw;
  p.grw = (bf16_t*)alloc((size_t)T_ * 512 * 2);
  p.hidk = (bf16_t*)alloc((size_t)2048 * LDHID * 2);
  p.hidv = (bf16_t*)alloc((size_t)2048 * LDHID * 2);
  p.kcmp = (bf16_t*)alloc((size_t)16 * 128 * 64 * 2);
  p.vcmp = (bf16_t*)alloc((size_t)16 * 128 * 64 * 2);
  p.vcmpT = (bf16_t*)alloc((size_t)16 * 128 * 64 * 2);
  p.rr = (bf16_t*)alloc((size_t)T_ * 512 * 2);
  p.kp = (bf16_t*)alloc((size_t)T_ * 512 * 2);
  p.vv = (bf16_t*)alloc((size_t)T_ * 512 * 2);
  p.mix = (bf16_t*)alloc((size_t)T_ * LDH * 2);
  p.hb = p.mix;
  p.ctr = (unsigned*)alloc(256);
  p.xbar = (unsigned*)alloc(16384);
  p.dec = (float*)d_out;
  p.kk = (bf16_t*)((char*)d_out + (size_t)T_ * 512 * 4);
  p.bb = (bf16_t*)((char*)d_out + (size_t)T_ * 512 * 6);
  if (off > ws_size) {
    fprintf(stderr, "workspace too small: need %zu have %zu\n", off, ws_size);
    return;
  }
#ifdef MULTI_LAUNCH
  hipLaunchKernelGGL(phk<0>, dim3(512), dim3(256), 0, stream, p);
  hipLaunchKernelGGL(phk<1>, dim3(512), dim3(256), 0, stream, p);
  hipLaunchKernelGGL(phk<2>, dim3(512), dim3(256), 0, stream, p);
  hipLaunchKernelGGL(phk<3>, dim3(512), dim3(256), 0, stream, p);
  hipLaunchKernelGGL(phk<4>, dim3(512), dim3(256), 0, stream, p);
  hipLaunchKernelGGL(phk<5>, dim3(512), dim3(256), 0, stream, p);
  hipLaunchKernelGGL(phk<6>, dim3(512), dim3(256), 0, stream, p);
  hipLaunchKernelGGL(phk<7>, dim3(512), dim3(256), 0, stream, p);
#else
  static int grid_blocks = 0;
  if (!grid_blocks) {
    int dev = 0, cus = 0, per_cu = 0;
    hipGetDevice(&dev);
    hipDeviceGetAttribute(&cus, hipDeviceAttributeMultiprocessorCount, dev);
    hipOccupancyMaxActiveBlocksPerMultiprocessor(&per_cu, mega, 256, 0);
    if (per_cu > 2) per_cu = 2;
    if (per_cu < 1) per_cu = 1;
    grid_blocks = cus * per_cu;
  }
  hipMemsetAsync(p.ctr, 0, 256 + 16384, stream);
  void* args[] = {&p};
  hipError_t e = hipLaunchCooperativeKernel((void*)mega, dim3(grid_blocks), dim3(256), args, 0, stream);
  if (e != hipSuccess) fprintf(stderr, "cooperative launch failed: %s (grid %d)\n", hipGetErrorString(e), grid_blocks);
#endif
}
```

```cpp
#include <hip/hip_runtime.h>
#include <hip/hip_bf16.h>
#include <hip/hip_cooperative_groups.h>
#include <cstdio>
namespace cg = cooperative_groups;


typedef unsigned short bf16_t;
using bf16x8 = __attribute__((ext_vector_type(8))) short;
using f32x16 = __attribute__((ext_vector_type(16))) float;
using f32x4 = __attribute__((ext_vector_type(4))) float;

#define DI __device__ __forceinline__

constexpr int T_ = 16384, S_ = 2048;
constexpr int NPAD = 4096;
constexpr int LDH = 1088, LDW = 1088, LDW1 = 2112, LDHID = 320, LDW2 = 320, LDKC = 136, VTS = 2112;

typedef __bf16 bf16x2_t __attribute__((ext_vector_type(2)));
typedef float f32x2_t __attribute__((ext_vector_type(2)));
DI unsigned pk2(float a, float b) {
  f32x2_t v = {a, b};
  return __builtin_bit_cast(unsigned, __builtin_convertvector(v, bf16x2_t));
}
DI bf16_t f2bf(float x) { return (bf16_t)(pk2(x, 0.f) & 0xffffu); }
DI float bf2f(bf16_t b) { return __uint_as_float(((unsigned)b) << 16); }
typedef unsigned u32x4_t __attribute__((ext_vector_type(4)));
DI void stnt16(void* q, uint4 v) {
  const u32x4_t t_ = {v.x, v.y, v.z, v.w};
  __builtin_nontemporal_store(t_, (u32x4_t*)q);
}
DI float sigmoidf_(float x) { return 1.f / (1.f + __expf(-x)); }
DI float siluf_(float x) { return x / (1.f + __expf(-x)); }
DI float wsum(float x) {
#pragma unroll
  for (int o = 32; o >= 1; o >>= 1) x += __shfl_xor(x, o);
  return x;
}
DI float wmax(float x) {
#pragma unroll
  for (int o = 32; o >= 1; o >>= 1) x = fmaxf(x, __shfl_xor(x, o));
  return x;
}
template <int CTRL> DI float dppf(float x) {
  return __int_as_float(__builtin_amdgcn_update_dpp(0, __float_as_int(x), CTRL, 0xf, 0xf, true));
}
DI float allred16(float x) {
  x += dppf<0xB1>(x);
  x += dppf<0x4E>(x);
  x += dppf<0x141>(x);
  x += dppf<0x128>(x);
  return x;
}

struct Params {
  const float *x, *norm_g, *w_in, *pos_k, *w1_k, *w2_k, *pos_v, *w1_v, *w2_v, *mu, *w0, *w_up, *a0, *a_up, *k_k, *k_a, *r_k,
      *gn_w, *gn_b, *w_out, *final_g;
  float* out;
  bf16_t *WinT, *WoutT, *W1Tk, *W1Tv, *W2Tk, *W2Tv, *WupT, *AupT;
  float *bias1k, *bias1v;
  float2* rope;
  bf16_t *qb, *kcb, *vcb, *ksb, *kwb, *vsb, *vwb, *vsT, *vwT;
  float* glb;
  bf16_t *gns, *rw, *grw, *hidk, *hidv, *kcmp, *vcmp, *vcmpT;
  bf16_t *rr, *kp, *vv, *kk, *bb;
  float *dec, *yraw;
  bf16_t* mix;
  bf16_t* hb;
  unsigned* ctr;
  unsigned* xbar;
};

DI void transpose_tile(const float* __restrict__ src, int ldsrc, bf16_t* __restrict__ dst, int ldd, int k0, int n0, const float* scale,
                       int mapmode, int nvalid, float* tile) {
  const int tid = threadIdx.x;
#pragma unroll
  for (int i = 0; i < 4; ++i) {
    const int idx = tid + 256 * i, kl = idx >> 4, ng = (idx & 15) * 4;
    const int n = n0 + ng;
    int on;
    if (mapmode == 1) on = (n < 1304) ? n : (n < 1408 ? -1 : n - 104);
    else on = (n < nvalid) ? n : -1;
    float4 v = make_float4(0.f, 0.f, 0.f, 0.f);
    if (on >= 0) {
      v = *(const float4*)(src + (size_t)(k0 + kl) * ldsrc + on);
      if (scale) {
        const float sc = scale[k0 + kl];
        v.x *= sc; v.y *= sc; v.z *= sc; v.w *= sc;
      }
    }
    float* t = tile + kl * 65 + ng;
    t[0] = v.x; t[1] = v.y; t[2] = v.z; t[3] = v.w;
  }
  __syncthreads();
#pragma unroll
  for (int i = 0; i < 2; ++i) {
    const int idx = tid + 256 * i, nl = idx >> 3, kg = (idx & 7) * 8;
    uint4 o;
    o.x = pk2(tile[(kg + 0) * 65 + nl], tile[(kg + 1) * 65 + nl]);
    o.y = pk2(tile[(kg + 2) * 65 + nl], tile[(kg + 3) * 65 + nl]);
    o.z = pk2(tile[(kg + 4) * 65 + nl], tile[(kg + 5) * 65 + nl]);
    o.w = pk2(tile[(kg + 6) * 65 + nl], tile[(kg + 7) * 65 + nl]);
    *(uint4*)(dst + (size_t)(n0 + nl) * ldd + k0 + kg) = o;
  }
  __syncthreads();
}

DI void phase_prep(const Params& p, char* smem) {
  float* tile = (float*)smem;
  const int nb = gridDim.x, bid = blockIdx.x, tid = threadIdx.x;
  {
    const int lane = tid & 63;
    for (int row = bid * 4 + (tid >> 6); row < T_; row += nb * 4) {
      const float4* x4 = (const float4*)(p.x + (size_t)row * 1024);
      float4 v[4];
      float ss = 0.f;
#pragma unroll
      for (int i = 0; i < 4; ++i) {
        {
          const f32x4 t_ = __builtin_nontemporal_load((const f32x4*)&x4[i * 64 + lane]);
          v[i] = make_float4(t_[0], t_[1], t_[2], t_[3]);
        }
        ss += v[i].x * v[i].x + v[i].y * v[i].y + v[i].z * v[i].z + v[i].w * v[i].w;
      }
      ss = wsum(ss);
      const float sc = rsqrtf(ss * (1.f / 1024.f) + 1e-6f);
      uint2* h2 = (uint2*)(p.hb + (size_t)row * LDH);
#pragma unroll
      for (int i = 0; i < 4; ++i) {
        uint2 o;
        o.x = pk2(v[i].x * sc, v[i].y * sc);
        o.y = pk2(v[i].z * sc, v[i].w * sc);
        h2[i * 64 + lane] = o;
      }
    }
  }
  const int n_win = 16 * 64, n_wout = 16 * 16, n_w1 = 32 * 4, n_w2 = 4 * 2, n_lora = 1 * 8;
  const int o1 = n_win, o2 = o1 + n_wout, o3 = o2 + n_w1, o4 = o3 + n_w1, o5 = o4 + n_w2, o6 = o5 + n_w2, o7 = o6 + n_lora,
            o8 = o7 + n_lora, o9 = o8 + 128, o10 = o9 + 16;
  for (int it = bid; it < o10; it += nb) {
    if (it < o1) {
      int kt = it & 15, nt = it >> 4;
      transpose_tile(p.w_in, 3992, p.WinT, LDW, kt * 64, nt * 64, p.norm_g, 1, 0, tile);
    } else if (it < o2) {
      int j = it - o1, kt = j & 15, nt = j >> 4;
      transpose_tile(p.w_out, 1024, p.WoutT, LDW, kt * 64, nt * 64, nullptr, 0, 1024, tile);
    } else if (it < o3) {
      int j = it - o2, kt = j & 31, nt = j >> 5;
      transpose_tile(p.w1_k, 256, p.W1Tk, LDW1, kt * 64, nt * 64, nullptr, 0, 256, tile);
    } else if (it < o4) {
      int j = it - o3, kt = j & 31, nt = j >> 5;
      transpose_tile(p.w1_v, 256, p.W1Tv, LDW1, kt * 64, nt * 64, nullptr, 0, 256, tile);
    } else if (it < o5) {
      int j = it - o4, kt = j & 3, nt = j >> 2;
      transpose_tile(p.w2_k, 64, p.W2Tk, LDW2, kt * 64, nt * 64, nullptr, 0, 64, tile);
    } else if (it < o6) {
      int j = it - o5, kt = j & 3, nt = j >> 2;
      transpose_tile(p.w2_v, 64, p.W2Tv, LDW2, kt * 64, nt * 64, nullptr, 0, 64, tile);
    } else if (it < o7) {
      int nt = it - o6;
      transpose_tile(p.w_up, 512, p.WupT, 64, 0, nt * 64, nullptr, 0, 512, tile);
    } else if (it < o8) {
      int nt = it - o7;
      transpose_tile(p.a_up, 512, p.AupT, 64, 0, nt * 64, nullptr, 0, 512, tile);
    } else if (it < o9) {
      const int j = it - o8, which = j >> 6, n0 = (j & 63) * 4;
      const float* pos = which ? p.pos_v : p.pos_k;
      const float* w1 = which ? p.w1_v : p.w1_k;
      float* bo = which ? p.bias1v : p.bias1k;
      const int kp = tid >> 2, nn = tid & 3;
      float a = 0.f;
#pragma unroll 16
      for (int k = kp * 32; k < kp * 32 + 32; ++k) a += pos[k] * w1[(size_t)k * 256 + n0 + nn];
      tile[tid] = a;
      __syncthreads();
      if (tid < 4) {
        float sum = 0.f;
        for (int q = 0; q < 64; ++q) sum += tile[q * 4 + tid];
        bo[n0 + tid] = sum;
      }
      __syncthreads();
    } else {
      int j = it - o9;
      for (int e = tid; e < 1024; e += 256) {
        int idx = j * 1024 + e;
        int pos = idx >> 3, i = idx & 7;
        float inv = powf(500000.0f, -(float)i / 8.0f);
        float ang = (float)pos * inv;
        float sn, cs;
        sincosf(ang, &sn, &cs);
        p.rope[idx] = make_float2(cs, sn);
      }
    }
  }
}

constexpr int LDT = 40;

DI int crow(int i, int h) { return (i & 3) + 8 * (i >> 2) + 4 * h; }

enum { G_PROJ = 0, G_CMP1 = 1, G_CMP2 = 2, G_OUT = 3 };

template <int MODE, bool EPI = true>
DI void gemm_tile(const Params& p, int mt, int nt, int which, char* smem) {
  constexpr int K = (MODE == G_PROJ) ? 1024 : (MODE == G_CMP1) ? 2048 : (MODE == G_CMP2) ? 256 : 1024;
  constexpr int LDA = (MODE == G_PROJ) ? LDH : (MODE == G_CMP1) ? LDKC : (MODE == G_CMP2) ? LDHID : LDH;
  constexpr int LDB = (MODE == G_PROJ) ? LDW : (MODE == G_CMP1) ? LDW1 : (MODE == G_CMP2) ? LDW2 : LDW;
  const int tid = threadIdx.x, lane = tid & 63, wave = tid >> 6;
  const int wm = wave >> 1, wn = wave & 1;
  const int m0 = mt * 128, n0 = nt * 128;

  const bf16_t* Bt;
  const bf16_t* Ab;
  if (MODE == G_PROJ) { Bt = p.WinT; Ab = p.hb; }
  else if (MODE == G_CMP1) { Bt = which ? p.W1Tv : p.W1Tk; Ab = which ? p.vcb : p.kcb; }
  else if (MODE == G_CMP2) { Bt = which ? p.W2Tv : p.W2Tk; Ab = which ? p.hidv : p.hidk; }
  else { Bt = p.WoutT; Ab = p.mix; }

  const int lrr = lane >> 2;
  const int lks = (lane & 3) ^ ((lane >> 4) & 3);
  unsigned aoA, aoB, boA;
  {
    const int r0 = m0 + (2 * wave) * 16 + lrr, r1 = r0 + 16;
    if (MODE == G_CMP1) {
      aoA = (unsigned)(r0 >> 1) * (16 * LDA) + (r0 & 1) * 64;
      aoB = (unsigned)(r1 >> 1) * (16 * LDA) + (r1 & 1) * 64;
    } else {
      aoA = (unsigned)r0 * LDA;
      aoB = (unsigned)r1 * LDA;
    }
    boA = (unsigned)(n0 + (2 * wave) * 16 + lrr) * LDB + lks * 8;
  }
  char* ldsw = smem + (2 * wave) * 1024;
  auto glds = [&](int kt) __attribute__((always_inline)) {
    char* st = ldsw + (kt & 3) * 16384;
    const int k_ = kt * 32 + lks * 8;
    const unsigned ko_ = (MODE == G_CMP1) ? ((unsigned)(k_ >> 6) * LDA + (k_ & 63)) : (unsigned)k_;
    __builtin_amdgcn_global_load_lds((const unsigned*)(Ab + (aoA + ko_)), (__attribute__((address_space(3))) unsigned*)(st), 16, 0, 0);
    __builtin_amdgcn_global_load_lds((const unsigned*)(Ab + (aoB + ko_)), (__attribute__((address_space(3))) unsigned*)(st + 1024), 16, 0, 0);
    __builtin_amdgcn_global_load_lds((const unsigned*)(Bt + (boA + kt * 32)), (__attribute__((address_space(3))) unsigned*)(st + 8192), 16, 0, 0);
    __builtin_amdgcn_global_load_lds((const unsigned*)(Bt + (boA + 16 * LDB + kt * 32)), (__attribute__((address_space(3))) unsigned*)(st + 8192 + 1024), 16, 0, 0);
  };

  f32x16 acc[2][2];
#pragma unroll
  for (int a = 0; a < 2; ++a)
#pragma unroll
    for (int b = 0; b < 2; ++b)
#pragma unroll
      for (int i = 0; i < 16; ++i) acc[a][b][i] = 0.f;

  const int frr = lane & 15, fhi = (lane >> 4) & 1, fq = lane >> 5;
  const int offA0 = ((wm * 64) >> 4) * 1024 + fhi * 1024 + frr * 64;
  const int offB0 = 8192 + ((wn * 64) >> 4) * 1024 + fhi * 1024 + frr * 64;
  const int fsw = (frr >> 2) & 3;
  bf16x8 fa0_0, fa0_1, fb0_0, fb0_1, fa1_0, fa1_1, fb1_0, fb1_1;
  bf16x8 ga0_0, ga0_1, gb0_0, gb0_1, ga1_0, ga1_1, gb1_0, gb1_1;
  const unsigned lbase = (unsigned)(size_t)(__attribute__((address_space(3))) char*)smem;
  const unsigned adA0 = lbase + offA0 + ((0 * 2 + fq) ^ fsw) * 16, adA1 = lbase + offA0 + ((1 * 2 + fq) ^ fsw) * 16;
  const unsigned adB0 = lbase + offB0 + ((0 * 2 + fq) ^ fsw) * 16, adB1 = lbase + offB0 + ((1 * 2 + fq) ^ fsw) * 16;
#define DSR(DST, AD, OFF) asm volatile("ds_read_b128 %0, %1 offset:%2" : "=v"(DST) : "v"(AD), "n"(OFF))
#define FRAG_LOAD_STG(P, SO)                \
  {                                         \
    DSR(P##a0_0, adA0, (SO));               \
    DSR(P##a0_1, adA0, (SO) + 2048);        \
    DSR(P##b0_0, adB0, (SO));               \
    DSR(P##b0_1, adB0, (SO) + 2048);        \
    DSR(P##a1_0, adA1, (SO));               \
    DSR(P##a1_1, adA1, (SO) + 2048);        \
    DSR(P##b1_0, adB1, (SO));               \
    DSR(P##b1_1, adB1, (SO) + 2048);        \
  }
#define FRAG_LOAD(P, STG)                               \
  {                                                     \
    const int stg_ = (STG);                             \
    if (stg_ == 0) FRAG_LOAD_STG(P, 0)                  \
    else if (stg_ == 1) FRAG_LOAD_STG(P, 16384)         \
    else if (stg_ == 2) FRAG_LOAD_STG(P, 32768)         \
    else FRAG_LOAD_STG(P, 49152)                        \
  }
#define FRAG_MMA(P)                                                                                     \
  {                                                                                                     \
    acc[0][0] = __builtin_amdgcn_mfma_f32_32x32x16_bf16(P##a0_0, P##b0_0, acc[0][0], 0, 0, 0);          \
    acc[0][1] = __builtin_amdgcn_mfma_f32_32x32x16_bf16(P##a0_0, P##b0_1, acc[0][1], 0, 0, 0);          \
    acc[1][0] = __builtin_amdgcn_mfma_f32_32x32x16_bf16(P##a0_1, P##b0_0, acc[1][0], 0, 0, 0);          \
    acc[1][1] = __builtin_amdgcn_mfma_f32_32x32x16_bf16(P##a0_1, P##b0_1, acc[1][1], 0, 0, 0);          \
    acc[0][0] = __builtin_amdgcn_mfma_f32_32x32x16_bf16(P##a1_0, P##b1_0, acc[0][0], 0, 0, 0);          \
    acc[0][1] = __builtin_amdgcn_mfma_f32_32x32x16_bf16(P##a1_0, P##b1_1, acc[0][1], 0, 0, 0);          \
    acc[1][0] = __builtin_amdgcn_mfma_f32_32x32x16_bf16(P##a1_1, P##b1_0, acc[1][0], 0, 0, 0);          \
    acc[1][1] = __builtin_amdgcn_mfma_f32_32x32x16_bf16(P##a1_1, P##b1_1, acc[1][1], 0, 0, 0);          \
  }
#define NEXT_TILE(P, KT1, STG)                                                     \
  {                                                                                \
    if ((KT1) + 2 <= KT - 1) asm volatile("s_waitcnt vmcnt(8)" ::: "memory");      \
    else if ((KT1) + 1 == KT - 1) asm volatile("s_waitcnt vmcnt(4)" ::: "memory"); \
    else asm volatile("s_waitcnt vmcnt(0)" ::: "memory");                          \
    asm volatile("s_waitcnt lgkmcnt(0)" ::: "memory");                             \
    __builtin_amdgcn_s_barrier();                                                  \
    if ((KT1) + 3 < KT) glds((KT1) + 3);                                           \
    FRAG_LOAD(P, STG)                                                              \
  }

  constexpr int KT = K / 32;
  static_assert(KT % 2 == 0, "k-tile count must be even");
  asm volatile("s_waitcnt vmcnt(0)" ::: "memory");
  glds(0);
  glds(1);
  glds(2);
  asm volatile("s_waitcnt vmcnt(8)" ::: "memory");
  asm volatile("s_waitcnt lgkmcnt(0)" ::: "memory");
  __builtin_amdgcn_s_barrier();
  glds(3);
  FRAG_LOAD(f, 0)
  static_assert(KT % 4 == 0, "k-tile count must be a multiple of the ring depth");
#pragma unroll 1
  for (int kt = 0; kt < KT; kt += 4) {
    NEXT_TILE(g, kt + 1, 1)
    FRAG_MMA(f)
    NEXT_TILE(f, kt + 2, 2)
    FRAG_MMA(g)
    NEXT_TILE(g, kt + 3, 3)
    FRAG_MMA(f)
    if (kt + 4 < KT) {
      NEXT_TILE(f, kt + 4, 0)
    } else {
      asm volatile("s_waitcnt lgkmcnt(0)" ::: "memory");
    }
    FRAG_MMA(g)
  }
#undef NEXT_TILE
#undef FRAG_MMA
#undef FRAG_LOAD
#undef FRAG_LOAD_STG
#undef DSR
  asm volatile("s_waitcnt lgkmcnt(0)" ::: "memory");
  __builtin_amdgcn_s_barrier();

  if (!EPI) {
    float sacc = 0.f;
#pragma unroll
    for (int a = 0; a < 2; ++a)
#pragma unroll
      for (int b = 0; b < 2; ++b)
#pragma unroll
        for (int i = 0; i < 16; ++i) sacc += acc[a][b][i];
    if (sacc == 12345.678f) p.ctr[8] = 1u;
    return;
  }
  int tide = tid;
  asm volatile("" : "+v"(tide));
  const int lane_e = tide & 63;
  const int h5 = lane_e >> 5, cl = lane_e & 31;
  auto each = [&](auto&& f) __attribute__((always_inline)) {
#pragma unroll
    for (int mi = 0; mi < 2; ++mi)
#pragma unroll
      for (int ni = 0; ni < 2; ++ni)
#pragma unroll
        for (int i = 0; i < 16; ++i) {
          const int rl = wm * 64 + mi * 32 + crow(i, h5);
          f(ni, rl, m0 + rl, n0 + wn * 64 + ni * 32 + cl, acc[mi][ni][i]);
        }
  };
  if (MODE == G_PROJ) {
    const int ct = nt;
    if (ct == 10) {
      each([&](int ni, int rl, int row, int col, float v) {
        const int c2 = col - 1280;
        if (c2 < 24) p.glb[(size_t)row * 24 + c2] = sigmoidf_(v);
      });
    } else {
      bf16_t* tl = (bf16_t*)smem;
      if (ct == 6 || ct == 8) {
        each([&](int ni, int rl, int row, int col, float v) {
          if (ni == 0) {
            float other = __shfl_xor(v, 8);
            if (cl < 16) {
              float2 cs = p.rope[(row & 2047) * 8 + (cl & 7)];
              v = (cl < 8) ? (v * cs.x - other * cs.y) : (v * cs.x + other * cs.y);
            }
          }
          tl[rl * 136 + (col - n0)] = f2bf(v);
        });
      } else if ((ct >= 11 && ct < 15) || ct >= 28) {
        each([&](int ni, int rl, int row, int col, float v) { tl[rl * 136 + (col - n0)] = f2bf(siluf_(v)); });
      } else {
        each([&](int ni, int rl, int row, int col, float v) { tl[rl * 136 + (col - n0)] = f2bf(v); });
      }
      __syncthreads();
      if (ct == 7 || ct == 9) {
        bf16_t* d2 = (ct == 7) ? p.vsT : p.vwT;
        const int b = m0 >> 11, s0 = m0 & 2047;
#pragma unroll
        for (int i = 0; i < 8; ++i) {
          const int idx = tide + 256 * i;
          const int c2 = idx & 127, rseg = idx >> 7;
          unsigned short e[8];
#pragma unroll
          for (int j = 0; j < 8; ++j) e[j] = tl[(rseg * 8 + j) * 136 + c2];
          uint4 o;
          o.x = e[0] | ((unsigned)e[1] << 16); o.y = e[2] | ((unsigned)e[3] << 16);
          o.z = e[4] | ((unsigned)e[5] << 16); o.w = e[6] | ((unsigned)e[7] << 16);
          *(uint4*)(d2 + ((size_t)((b * 2 + (c2 >> 6)) * 64 + (c2 & 63))) * VTS + s0 + rseg * 8) = o;
        }
      } else {
        bf16_t* dst;
        int ld, cb;
        if (ct < 4) { dst = p.qb; ld = 512; cb = n0; }
        else if (ct == 4) { dst = p.kcb; ld = LDKC; cb = 0; }
        else if (ct == 5) { dst = p.vcb; ld = LDKC; cb = 0; }
        else if (ct == 6) { dst = p.ksb; ld = 128; cb = 0; }
        else if (ct == 8) { dst = p.kwb; ld = 128; cb = 0; }
        else if (ct < 15) { dst = p.gns; ld = 512; cb = n0 - 1408; }
        else if (ct < 28) { dst = p.rw; ld = 1664; cb = n0 - 1920; }
        else { dst = p.grw; ld = 512; cb = n0 - 3584; }
#pragma unroll
        for (int i = 0; i < 8; ++i) {
          const int idx = tide + 256 * i;
          const int r = idx >> 4, sg = idx & 15;
          const uint4 v4 = *(const uint4*)(tl + r * 136 + sg * 8);
          *(uint4*)(dst + (size_t)(m0 + r) * ld + cb + sg * 8) = v4;
        }
      }
    }
  } else if (MODE == G_CMP1) {
    const float* bias = which ? p.bias1v : p.bias1k;
    bf16_t* hid = which ? p.hidv : p.hidk;
    each([&](int ni, int rl, int row, int col, float v) { hid[(size_t)row * LDHID + col] = f2bf(siluf_(v + bias[col])); });
  } else if (MODE == G_CMP2) {
    each([&](int ni, int rl, int row, int col, float v) {
      if (col < 64) {
        const int b = row >> 8, c = (row >> 1) & 127, g = row & 1;
        const int bg = b * 2 + g;
        bf16_t hv = (c < 127) ? f2bf(v) : (bf16_t)0;
        if (which == 0) {
          p.kcmp[((size_t)bg * 128 + c) * 64 + col] = hv;
        } else {
          p.vcmp[((size_t)bg * 128 + c) * 64 + col] = hv;
          p.vcmpT[((size_t)bg * 64 + col) * 128 + c] = hv;
        }
      }
    });
  } else {
    float xv[2][2][16];
#pragma unroll
    for (int mi = 0; mi < 2; ++mi)
#pragma unroll
      for (int ni = 0; ni < 2; ++ni)
#pragma unroll
        for (int i = 0; i < 16; ++i)
          xv[mi][ni][i] = p.x[(size_t)(m0 + wm * 64 + mi * 32 + crow(i, h5)) * 1024 + n0 + wn * 64 + ni * 32 + cl];
#pragma unroll
    for (int mi = 0; mi < 2; ++mi)
#pragma unroll
      for (int ni = 0; ni < 2; ++ni)
#pragma unroll
        for (int i = 0; i < 16; ++i)
          p.out[(size_t)(m0 + wm * 64 + mi * 32 + crow(i, h5)) * 1024 + n0 + wn * 64 + ni * 32 + cl] = xv[mi][ni][i] + acc[mi][ni][i];
  }
  __syncthreads();
}

DI float shiftv(const Params& p, int tok, int col) {
  float cur = bf2f(p.rw[(size_t)tok * 1664 + col]);
  float prev = (tok & 2047) ? bf2f(p.rw[(size_t)(tok - 1) * 1664 + col]) : 0.f;
  return cur + p.mu[col] * (prev - cur);
}

DI void unpack8(uint4 u, float (&f)[8]) {
  f[0] = __uint_as_float(u.x << 16); f[1] = __uint_as_float(u.x & 0xffff0000u);
  f[2] = __uint_as_float(u.y << 16); f[3] = __uint_as_float(u.y & 0xffff0000u);
  f[4] = __uint_as_float(u.z << 16); f[5] = __uint_as_float(u.z & 0xffff0000u);
  f[6] = __uint_as_float(u.w << 16); f[7] = __uint_as_float(u.w & 0xffff0000u);
}
DI uint4 pack8(const float (&f)[8]) {
  uint4 o;
  o.x = pk2(f[0], f[1]);
  o.y = pk2(f[2], f[3]);
  o.z = pk2(f[4], f[5]);
  o.w = pk2(f[6], f[7]);
  return o;
}
DI void ld8f(const float* ptr, float (&f)[8]) {
  const float4 a = *(const float4*)ptr, b = *(const float4*)(ptr + 4);
  f[0] = a.x; f[1] = a.y; f[2] = a.z; f[3] = a.w; f[4] = b.x; f[5] = b.y; f[6] = b.z; f[7] = b.w;
}
DI void shift8(const Params& p, int tok, int col, float (&o)[8]) {
  float c[8], pv[8], m[8];
  unpack8(*(const uint4*)(p.rw + (size_t)tok * 1664 + col), c);
  uint4 pu = make_uint4(0u, 0u, 0u, 0u);
  if (tok & 2047) pu = *(const uint4*)(p.rw + (size_t)(tok - 1) * 1664 + col);
  unpack8(pu, pv);
  ld8f(p.mu + col, m);
#pragma unroll
  for (int j = 0; j < 8; ++j) o[j] = c[j] + m[j] * (pv[j] - c[j]);
}

DI void rwkv_prep_tile(const Params& p, int tile, char* smem) {
  const int t0 = tile * 32;
  bf16_t* sW = (bf16_t*)smem;
  bf16_t* sAd = sW + 32 * 72;
  bf16_t* sA = sAd + 32 * 72;
  int tid = threadIdx.x;
  asm volatile("" : "+v"(tid));
  const int lane = tid & 63, wave = tid >> 6;
#pragma unroll
  for (int i = 0; i < 2; ++i) {
    const int idx = tid + 256 * i, m = idx >> 4, sg = idx & 15;
    float v[8];
    shift8(p, t0 + m, 1536 + sg * 8, v);
    if (sg < 8) {
#pragma unroll
      for (int j = 0; j < 8; ++j) v[j] = tanhf(v[j]);
      *(uint4*)(sW + m * 72 + sg * 8) = pack8(v);
    } else {
      *(uint4*)(sAd + m * 72 + (sg - 8) * 8) = pack8(v);
    }
  }
  __syncthreads();
  const int h5 = lane >> 5, cl = lane & 31;
#pragma unroll 1
  for (int sp = 0; sp < 8; ++sp) {
    const int pass = sp >> 2, ni = sp & 3;
    const bf16_t* As = pass ? sAd : sW;
    const bf16_t* Bt = pass ? p.AupT : p.WupT;
    const int n = wave * 128 + ni * 32 + cl;
    f32x16 acc;
#pragma unroll
    for (int i = 0; i < 16; ++i) acc[i] = 0.f;
#pragma unroll
    for (int ks = 0; ks < 4; ++ks) {
      bf16x8 af = *(const bf16x8*)(As + cl * 72 + ks * 16 + h5 * 8);
      bf16x8 bfr = *(const bf16x8*)(Bt + (size_t)n * 64 + ks * 16 + h5 * 8);
      acc = __builtin_amdgcn_mfma_f32_32x32x16_bf16(af, bfr, acc, 0, 0, 0);
    }
    if (pass == 0) {
      const float w0n = p.w0[n];
#pragma unroll
      for (int i = 0; i < 16; ++i) {
        const int tok = t0 + crow(i, h5);
        const float sg = 1.f / (1.f + __expf(-(w0n + acc[i])));
        __builtin_nontemporal_store(__expf(-0.6065306597126334f * sg), p.dec + (size_t)tok * 512 + n);
      }
    } else {
      const float a0n = p.a0[n];
#pragma unroll
      for (int i = 0; i < 16; ++i) sA[crow(i, h5) * 520 + n] = f2bf(1.f / (1.f + __expf(-(a0n + acc[i]))));
    }
  }
  __syncthreads();
#pragma unroll 1
  for (int i = 0; i < 8; ++i) {
    const int idx = tid + 256 * i, m = idx >> 6, ch0 = (idx & 63) * 8;
    const int tok = t0 + m;
    const size_t o = (size_t)tok * 512 + ch0;
    float rs[8], ks[8], vs[8], a[8], kkc[8], kac[8];
    shift8(p, tok, ch0, rs);
    shift8(p, tok, 512 + ch0, ks);
    shift8(p, tok, 1024 + ch0, vs);
    unpack8(*(const uint4*)(sA + m * 520 + ch0), a);
    ld8f(p.k_k + ch0, kkc);
    ld8f(p.k_a + ch0, kac);
    float kkr[8], ssq = 0.f;
#pragma unroll
    for (int j = 0; j < 8; ++j) { kkr[j] = ks[j] * kkc[j]; ssq += kkr[j] * kkr[j]; }
    ssq += __shfl_xor(ssq, 1);
    ssq += __shfl_xor(ssq, 2);
    ssq += __shfl_xor(ssq, 4);
    const float inv = 1.0f / fmaxf(sqrtf(ssq), 1e-12f);
    float kp[8], bb[8];
#pragma unroll
    for (int j = 0; j < 8; ++j) {
      kkr[j] *= inv;
      kp[j] = ks[j] * (1.f + (a[j] - 1.f) * kac[j]);
      bb[j] = kkr[j] * a[j];
    }
    stnt16(p.rr + o, pack8(rs));
    stnt16(p.kp + o, pack8(kp));
    stnt16(p.vv + o, pack8(vs));
    stnt16(p.kk + o, pack8(kkr));
    stnt16(p.bb + o, pack8(bb));
  }
  __syncthreads();
}

constexpr int SCH = 16;
constexpr int SSTR = 336;

DI void scan_item(const Params& p, int item, char* smem) {
  const int xcd = item & 7, slot = item >> 3;
  const int bh = xcd * 8 + (slot >> 2), rg = slot & 3;
  const int b = bh >> 3, h = bh & 7, row0 = rg * 16;
  float* buf = (float*)smem;
  float* ybuf = buf + 2 * SCH * SSTR;
  int tid = threadIdx.x;
  asm volatile("" : "+v"(tid));
  const int lane = tid & 63, wave = tid >> 6;
  const int q = lane >> 4, c = lane & 15, lr = wave * 4 + q;
  const size_t tokb = (size_t)b * 2048;

  const bf16_t* ap[2];
  int ast[2], aseg[2], aslot[2];
#pragma unroll
  for (int i = 0; i < 2; ++i) {
    int e = tid + 256 * i;
    int arr = e >> 7;
    ast[i] = (e >> 3) & 15;
    aseg[i] = e & 7;
    ap[i] = arr == 0 ? p.rr : arr == 1 ? p.kp : arr == 2 ? p.kk : p.bb;
    aslot[i] = arr == 0 ? 4 : arr;
  }
  const int dst_ = tid >> 4, dseg = tid & 15;
  const int vst = (tid >> 1) & 15, vseg = tid & 1;
  struct Stage { uint4 g0, g1, gv; float4 gd; };
  auto gload = [&](Stage& S, int ci) {
    const size_t s0 = tokb + (size_t)ci * SCH;
    S.g0 = *(const uint4*)(ap[0] + (s0 + ast[0]) * 512 + h * 64 + aseg[0] * 8);
    S.g1 = *(const uint4*)(ap[1] + (s0 + ast[1]) * 512 + h * 64 + aseg[1] * 8);
    S.gd = *(const float4*)(p.dec + (s0 + dst_) * 512 + h * 64 + dseg * 4);
    if (tid < 32) S.gv = *(const uint4*)(p.vv + (s0 + vst) * 512 + h * 64 + row0 + vseg * 8);
  };
  auto cvt8 = [&](uint4 u, float* d) {
    float4 a, b2;
    a.x = __uint_as_float(u.x << 16); a.y = __uint_as_float(u.x & 0xffff0000u);
    a.z = __uint_as_float(u.y << 16); a.w = __uint_as_float(u.y & 0xffff0000u);
    b2.x = __uint_as_float(u.z << 16); b2.y = __uint_as_float(u.z & 0xffff0000u);
    b2.z = __uint_as_float(u.w << 16); b2.w = __uint_as_float(u.w & 0xffff0000u);
    *(float4*)d = a;
    *(float4*)(d + 4) = b2;
  };
  auto sstore = [&](const Stage& S, int nbuf) {
    float* B = buf + nbuf * SCH * SSTR;
    cvt8(S.g0, B + ast[0] * SSTR + aslot[0] * 64 + aseg[0] * 8);
    cvt8(S.g1, B + ast[1] * SSTR + aslot[1] * 64 + aseg[1] * 8);
    *(float4*)(B + dst_ * SSTR + dseg * 4) = S.gd;
    if (tid < 32) cvt8(S.gv, B + vst * SSTR + 320 + vseg * 8);
  };

  f32x2_t sA = {0.f, 0.f}, sB = {0.f, 0.f};
  auto compute = [&](int ci, int cb) {
    const float* B = buf + cb * SCH * SSTR;
    float* Y = ybuf + cb * 256;
    const float* Lc = B + 4 * c;
    const float* Lv = B + 320 + lr;
    float4 w0_ = *(const float4*)(Lc), k0_ = *(const float4*)(Lc + 64), q0_ = *(const float4*)(Lc + 128),
           b0_ = *(const float4*)(Lc + 192), r0_ = *(const float4*)(Lc + 256);
    float v0_ = Lv[0];
    float4 w1_, k1_, q1_, b1_, r1_;
    float v1_;
    float pp;
    {
      const f32x2_t k0 = {q0_.x, q0_.y}, k1 = {q0_.z, q0_.w};
      f32x2_t pq = sA * k0;
      pq = sB * k1 + pq;
      pp = allred16(pq.x + pq.y);
    }
    float ysel = 0.f;
#define SCAN_STEP(W, K, BV, R, V, NW, NK, NQ, NB, NR, NV, ST)                                          \
  {                                                                                                    \
    if ((ST) + 1 < SCH) {                                                                              \
      NW = *(const float4*)(Lc + ((ST) + 1) * SSTR);                                                   \
      NK = *(const float4*)(Lc + ((ST) + 1) * SSTR + 64);                                              \
      NQ = *(const float4*)(Lc + ((ST) + 1) * SSTR + 128);                                             \
      NB = *(const float4*)(Lc + ((ST) + 1) * SSTR + 192);                                             \
      NR = *(const float4*)(Lc + ((ST) + 1) * SSTR + 256);                                             \
      NV = Lv[((ST) + 1) * SSTR];                                                                      \
    }                                                                                                  \
    const f32x2_t wa = {W.x, W.y}, wb = {W.z, W.w}, ka = {K.x, K.y}, kb = {K.z, K.w}, ba = {BV.x, BV.y}, \
                  bb2 = {BV.z, BV.w}, ra = {R.x, R.y}, rb = {R.z, R.w}, qa = {NQ.x, NQ.y}, qb = {NQ.z, NQ.w}; \
    const f32x2_t msa = {-pp, -pp}, vv2 = {V, V};                                                      \
    const f32x2_t t0 = ba * msa + ka * vv2, t1 = bb2 * msa + kb * vv2;                                 \
    sA = sA * wa + t0;                                                                                 \
    sB = sB * wb + t1;                                                                                 \
    f32x2_t yq = sA * ra;                                                                              \
    yq = sB * rb + yq;                                                                                 \
    f32x2_t pq = sA * qa;                                                                              \
    pq = sB * qb + pq;                                                                                 \
    float ys = yq.x + yq.y, ps = pq.x + pq.y;                                                          \
    ys += dppf<0xB1>(ys);  ps += dppf<0xB1>(ps);                                                       \
    ys += dppf<0x4E>(ys);  ps += dppf<0x4E>(ps);                                                       \
    ys += dppf<0x141>(ys); ps += dppf<0x141>(ps);                                                      \
    ys += dppf<0x128>(ys); ps += dppf<0x128>(ps);                                                      \
    pp = ps;                                                                                           \
    ysel = (c == (ST)) ? ys : ysel;                                                                    \
  }
#pragma unroll 2
    for (int st = 0; st < SCH; st += 2) {
      SCAN_STEP(w0_, k0_, b0_, r0_, v0_, w1_, k1_, q1_, b1_, r1_, v1_, st)
      SCAN_STEP(w1_, k1_, b1_, r1_, v1_, w0_, k0_, q0_, b0_, r0_, v0_, st + 1)
    }
#undef SCAN_STEP
    Y[c * 16 + lr] = ysel;
  };
  auto flush = [&](int ci, int cb) {
    const int st = tid >> 4, rr_ = tid & 15;
    p.yraw[(tokb + (size_t)ci * SCH + st) * 512 + h * 64 + row0 + rr_] = (ybuf + cb * 256)[tid];
  };

  constexpr int NCH = S_ / SCH;
  Stage SA, SB;
  gload(SA, 0);
  gload(SB, 1);
  sstore(SA, 0);
  __syncthreads();
  for (int ci = 0; ci < NCH; ci += 2) {
    if (ci + 2 < NCH) gload(SA, ci + 2);
    compute(ci, 0);
    sstore(SB, 1);
    __syncthreads();
    flush(ci, 0);
    if (ci + 3 < NCH) gload(SB, ci + 3);
    compute(ci + 1, 1);
    if (ci + 2 < NCH) sstore(SA, 0);
    __syncthreads();
    flush(ci + 1, 1);
  }
  __syncthreads();
}

#define MFMA16(a, b, c) __builtin_amdgcn_mfma_f32_16x16x32_bf16((a), (b), (c), 0, 0, 0)
DI float ex2(float x) { return __builtin_amdgcn_exp2f(x); }
constexpr float SCL2 = 0.18033688011112042f;
constexpr float NEGB = -1e30f;

DI unsigned topk8(const float* imp, int tblk) {
  float v[32];
#pragma unroll
  for (int j = 0; j < 32; ++j) {
    float xv = imp[j];
    bool forced = (j == 0) | (j == tblk) | (j == tblk - 1);
    v[j] = (j <= tblk) ? (xv + (forced ? 1000.f : 0.f)) : -1.f;
  }
  unsigned sel = 0;
#pragma unroll
  for (int r = 0; r < 8; ++r) {
    float best = -3e38f;
    int bi = 0;
#pragma unroll
    for (int j = 0; j < 32; ++j) {
      bool ok = (((sel >> j) & 1u) == 0u) && (v[j] > best);
      best = ok ? v[j] : best;
      bi = ok ? j : bi;
    }
    sel |= 1u << bi;
  }
  return sel;
}

DI void head_step(const bf16x8& k00, const bf16x8& k01, const bf16x8& k10, const bf16x8& k11, const bf16x8& v0, const bf16x8& v1,
                  const bf16x8& v2, const bf16x8& v3, const bf16x8& q0, const bf16x8& q1, const float (&bias)[8], f32x4& O0,
                  f32x4& O1, f32x4& O2, f32x4& O3, float& m, float& l) {
  f32x4 sa = {0.f, 0.f, 0.f, 0.f}, sb = {0.f, 0.f, 0.f, 0.f};
  sa = MFMA16(k00, q0, sa);
  sb = MFMA16(k10, q0, sb);
  sa = MFMA16(k01, q1, sa);
  sb = MFMA16(k11, q1, sb);
  float sc[8];
  float cm = -3e38f;
#pragma unroll
  for (int e = 0; e < 8; ++e) {
    sc[e] = fmaf((e < 4) ? sa[e & 3] : sb[e & 3], SCL2, bias[e]);
    cm = fmaxf(cm, sc[e]);
  }
  if (__builtin_amdgcn_ballot_w64(cm > m) != 0ull) {
    cm = fmaxf(cm, __shfl_xor(cm, 16));
    cm = fmaxf(cm, __shfl_xor(cm, 32));
    const float mn = fmaxf(m, cm);
    const float alpha = ex2(m - mn);
    m = mn;
    l *= alpha;
    O0 *= alpha; O1 *= alpha; O2 *= alpha; O3 *= alpha;
  }
  float ps = 0.f;
  float pe[8];
#pragma unroll
  for (int e = 0; e < 8; ++e) {
    pe[e] = ex2(sc[e] - m);
    ps += pe[e];
  }
  l += ps;
  union { unsigned u[4]; bf16x8 v; } pk;
  pk.u[0] = pk2(pe[0], pe[1]); pk.u[1] = pk2(pe[2], pe[3]); pk.u[2] = pk2(pe[4], pe[5]); pk.u[3] = pk2(pe[6], pe[7]);
  O0 = MFMA16(v0, pk.v, O0);
  O1 = MFMA16(v1, pk.v, O1);
  O2 = MFMA16(v2, pk.v, O2);
  O3 = MFMA16(v3, pk.v, O3);
}

template <int MODE>
DI void attend(unsigned long long cmask, const bf16_t* __restrict__ Kb, const bf16_t* __restrict__ VT, const bf16x8* ql, int t,
               int t0, unsigned selmask, int n, int q4, f32x4 (&O)[4][4], float (&m)[4], float (&l)[4]) {
  const int krow = (n >> 2) * 8 + (n & 3);
  const bf16_t* Kl = Kb + (size_t)krow * 128 + q4 * 8;
  const bf16_t* Vl = VT + (size_t)n * VTS + q4 * 8;
  if (!cmask) return;
  int cur = __ffsll(cmask) - 1;
  cmask &= cmask - 1;
  bf16x8 k00, k01, k10, k11;
  {
    const bf16_t* kp_ = Kl + (size_t)cur * 32 * 128;
    k00 = *(const bf16x8*)(kp_); k01 = *(const bf16x8*)(kp_ + 32);
    k10 = *(const bf16x8*)(kp_ + 4 * 128); k11 = *(const bf16x8*)(kp_ + 4 * 128 + 32);
  }
  while (true) {
    int nxt = -1;
    if (cmask) { nxt = __ffsll(cmask) - 1; cmask &= cmask - 1; }
    bf16x8 n00, n01, n10, n11, v0, v1, v2, v3;
    {
      const bf16_t* vp_ = Vl + cur * 32;
      v0 = *(const bf16x8*)(vp_); v1 = *(const bf16x8*)(vp_ + 16 * VTS);
      v2 = *(const bf16x8*)(vp_ + 32 * VTS); v3 = *(const bf16x8*)(vp_ + 48 * VTS);
    }
    if (nxt >= 0) {
      const bf16_t* kp_ = Kl + (size_t)nxt * 32 * 128;
      n00 = *(const bf16x8*)(kp_); n01 = *(const bf16x8*)(kp_ + 32);
      n10 = *(const bf16x8*)(kp_ + 4 * 128); n11 = *(const bf16x8*)(kp_ + 4 * 128 + 32);
    }
    const int kb = cur * 32;
    const int key0 = kb + q4 * 8;
    bool blk = true;
    if (MODE == 1) blk = ((selmask >> (kb >> 6)) & 1u) != 0u;
    float bias[8];
#pragma unroll
    for (int e = 0; e < 8; ++e) {
      const int key = key0 + e;
      bool v = blk && (key <= t);
      if (MODE == 2) v = v && (key + 512 > t);
      bias[e] = v ? 0.f : NEGB;
    }
#pragma unroll
    for (int r = 0; r < 4; ++r) {
      const bf16x8 q0 = ql[(r * 2 + 0) * 64], q1 = ql[(r * 2 + 1) * 64];
      head_step(k00, k01, k10, k11, v0, v1, v2, v3, q0, q1, bias, O[r][0], O[r][1], O[r][2], O[r][3], m[r], l[r]);

    }
    if (nxt < 0) break;
    k00 = n00; k01 = n01; k10 = n10; k11 = n11;
    cur = nxt;
  }
}

constexpr int NSA_WFLOATS = 16 * 132 + 16 * 32;

__device__ void nsa_wave_item(const Params& p, int item, float* wl) {
  int tx_ = threadIdx.x;
  asm volatile("" : "+v"(tx_));
  const int lane = tx_ & 63, n = lane & 15, q4 = lane >> 4;
  const int bg = item & 15, tt = item >> 4;
  const int b = bg >> 1, g = bg & 1, t0 = tt * 16, t = t0 + n;
  const size_t tok = (size_t)b * 2048 + t;
  float* impb = wl + 2048;
  bf16x8* ql = (bf16x8*)wl + lane;
  const int krow = (n >> 2) * 8 + (n & 3);

#pragma unroll
  for (int r = 0; r < 4; ++r)
#pragma unroll
    for (int kd = 0; kd < 2; ++kd) ql[(r * 2 + kd) * 64] = *(const bf16x8*)(p.qb + tok * 512 + (g * 4 + r) * 64 + kd * 32 + q4 * 8);
  const float* gatep = p.glb + tok * 24 + g * 12;
  bf16_t* mixl = p.mix + tok * LDH + (g * 4) * 64 + q4 * 4;
  f32x4 Oc[4][4];

  {
    const bf16_t* Kc = p.kcmp + (size_t)bg * 128 * 64;
    const bf16_t* VcT = p.vcmpT + (size_t)bg * 64 * 128;
    const int nch = (t0 + 15 >= 31) ? ((min((t0 + 15 - 31) >> 4, 126) >> 5) + 1) : 0;
#pragma unroll
    for (int e = 0; e < 9; ++e) impb[lane * 9 + e] = 0.f;
    float m[4], l[4];
#pragma unroll
    for (int r = 0; r < 4; ++r) { m[r] = NEGB; l[r] = 0.f; }
#pragma unroll 1
    for (int ch = 0; ch < nch; ++ch) {
      const int kb = ch * 32;
      bf16x8 kf[2][2];
#pragma unroll
      for (int sub = 0; sub < 2; ++sub)
#pragma unroll
        for (int kd = 0; kd < 2; ++kd) kf[sub][kd] = *(const bf16x8*)(Kc + (size_t)(kb + krow + sub * 4) * 64 + kd * 32 + q4 * 8);
#pragma unroll
      for (int r = 0; r < 4; ++r) {
        f32x4 sa = {0.f, 0.f, 0.f, 0.f}, sb = {0.f, 0.f, 0.f, 0.f};
#pragma unroll
        for (int kd = 0; kd < 2; ++kd) {
          const bf16x8 qv = ql[(r * 2 + kd) * 64];
          sa = MFMA16(kf[0][kd], qv, sa);
          sb = MFMA16(kf[1][kd], qv, sb);
        }
        float sc[8];
        float cm = NEGB;
#pragma unroll
        for (int e = 0; e < 8; ++e) {
          const int c = kb + q4 * 8 + e;
          const bool v = (16 * c + 31 <= t);
          float x = ((e < 4) ? sa[e & 3] : sb[e & 3]) * SCL2;
          sc[e] = v ? x : NEGB;
          cm = fmaxf(cm, sc[e]);
        }
        cm = fmaxf(cm, __shfl_xor(cm, 16));
        cm = fmaxf(cm, __shfl_xor(cm, 32));
        const float mn = fmaxf(m[r], cm);
        float ps = 0.f;
#pragma unroll
        for (int e = 0; e < 8; ++e) ps += (sc[e] > -1e29f) ? ex2(sc[e] - mn) : 0.f;
        l[r] = l[r] * ex2(m[r] - mn) + ps;
        m[r] = mn;
        __builtin_amdgcn_sched_barrier(0);
      }
    }
    float inv[4];
#pragma unroll
    for (int r = 0; r < 4; ++r) {
      float lv = l[r];
      lv += __shfl_xor(lv, 16);
      lv += __shfl_xor(lv, 32);
      inv[r] = (lv > 0.f) ? 1.f / lv : 0.f;
    }
#pragma unroll
    for (int dt = 0; dt < 4; ++dt)
#pragma unroll
      for (int r = 0; r < 4; ++r) Oc[dt][r] = f32x4{0.f, 0.f, 0.f, 0.f};
#pragma unroll 1
    for (int ch = 0; ch < nch; ++ch) {
      const int kb = ch * 32;
      bf16x8 kf[2][2];
#pragma unroll
      for (int sub = 0; sub < 2; ++sub)
#pragma unroll
        for (int kd = 0; kd < 2; ++kd) kf[sub][kd] = *(const bf16x8*)(Kc + (size_t)(kb + krow + sub * 4) * 64 + kd * 32 + q4 * 8);
      bf16x8 vf[4];
#pragma unroll
      for (int dt = 0; dt < 4; ++dt) vf[dt] = *(const bf16x8*)(VcT + (size_t)(dt * 16 + n) * 128 + kb + q4 * 8);
      float psm[8];
#pragma unroll
      for (int e = 0; e < 8; ++e) psm[e] = 0.f;
      bf16x8 pf[4];
#pragma unroll
      for (int r = 0; r < 4; ++r) {
        f32x4 sa = {0.f, 0.f, 0.f, 0.f}, sb = {0.f, 0.f, 0.f, 0.f};
#pragma unroll
        for (int kd = 0; kd < 2; ++kd) {
          const bf16x8 qv = ql[(r * 2 + kd) * 64];
          sa = MFMA16(kf[0][kd], qv, sa);
          sb = MFMA16(kf[1][kd], qv, sb);
        }
        float pe[8];
#pragma unroll
        for (int e = 0; e < 8; ++e) {
          const int c = kb + q4 * 8 + e;
          const bool v = (16 * c + 31 <= t);
          float x = ((e < 4) ? sa[e & 3] : sb[e & 3]) * SCL2;
          pe[e] = v ? ex2(x - m[r]) * inv[r] : 0.f;
          psm[e] += pe[e];
        }
        union { unsigned u[4]; bf16x8 v; } pk;
        pk.u[0] = pk2(pe[0], pe[1]); pk.u[1] = pk2(pe[2], pe[3]); pk.u[2] = pk2(pe[4], pe[5]); pk.u[3] = pk2(pe[6], pe[7]);
        pf[r] = pk.v;
        __builtin_amdgcn_sched_barrier(0);
      }
      {
        float* ip = impb + n * 36 + (kb >> 2) + 2 * q4;
        ip[0] += psm[0] + psm[1] + psm[2] + 0.5f * psm[3];
        __builtin_amdgcn_fence(__ATOMIC_ACQ_REL, "workgroup");
        __builtin_amdgcn_wave_barrier();
        ip[1] += 0.5f * psm[3] + psm[4] + psm[5] + psm[6] + 0.5f * psm[7];
        __builtin_amdgcn_fence(__ATOMIC_ACQ_REL, "workgroup");
        __builtin_amdgcn_wave_barrier();
        ip[2] += 0.5f * psm[7];
        __builtin_amdgcn_fence(__ATOMIC_ACQ_REL, "workgroup");
        __builtin_amdgcn_wave_barrier();
      }
#pragma unroll
      for (int dt = 0; dt < 4; ++dt)
#pragma unroll
        for (int r = 0; r < 4; ++r) Oc[dt][r] = MFMA16(vf[dt], pf[r], Oc[dt][r]);
    }
  }
#pragma unroll
  for (int r = 0; r < 4; ++r) {
    const float gsc = gatep[r * 3 + 0];
#pragma unroll
    for (int dt = 0; dt < 4; ++dt) {
      uint2 o;
      o.x = pk2(Oc[dt][r][0] * gsc, Oc[dt][r][1] * gsc);
      o.y = pk2(Oc[dt][r][2] * gsc, Oc[dt][r][3] * gsc);
      *(uint2*)(mixl + r * 64 + dt * 16) = o;
    }
  }
  __builtin_amdgcn_fence(__ATOMIC_ACQ_REL, "workgroup");
  __builtin_amdgcn_wave_barrier();
  const int tblk = t0 >> 6;
  unsigned selmask = topk8(impb + n * 36, tblk);
  selmask &= (tblk >= 31) ? 0xffffffffu : ((1u << (tblk + 1)) - 1u);
  __builtin_amdgcn_wave_barrier();

#pragma unroll
  for (int r = 0; r < 4; ++r) {
    const bf16x8 q0 = ql[(r * 2 + 0) * 64];
    union { unsigned u[4]; bf16x8 v; } pk;
    float vals[8];
#pragma unroll
    for (int j = 0; j < 8; ++j) {
      float xv = bf2f((bf16_t)q0[j]);
      float ov = __shfl_xor(xv, 16);
      float2 cs = p.rope[t * 8 + j];
      vals[j] = (q4 == 0) ? (xv * cs.x - ov * cs.y) : ((q4 == 1) ? (xv * cs.x + ov * cs.y) : xv);
    }
    pk.u[0] = pk2(vals[0], vals[1]); pk.u[1] = pk2(vals[2], vals[3]); pk.u[2] = pk2(vals[4], vals[5]); pk.u[3] = pk2(vals[6], vals[7]);
    ql[(r * 2 + 0) * 64] = pk.v;
  }

#pragma unroll 1
  for (int br = 1; br <= 2; ++br) {
    unsigned long long cmask = 0ull;
    const int hic = (t0 + 15) >> 5;
    if (br == 1) {
      unsigned any = selmask;
#pragma unroll
      for (int o = 32; o >= 1; o >>= 1) any |= (unsigned)__shfl_xor((int)any, o);
      any = __builtin_amdgcn_readfirstlane(any);
      for (int j = 0; j <= tblk; ++j)
        if ((any >> j) & 1u) cmask |= 3ull << (2 * j);
      if (hic < 63) cmask &= (1ull << (hic + 1)) - 1ull;
    } else {
      const int lo = max(0, t0 - 511) >> 5;
      cmask = (hic < 63) ? ((1ull << (hic + 1)) - 1ull) : ~0ull;
      cmask &= ~((1ull << lo) - 1ull);
    }
    f32x4 O[4][4];
    float m[4], l[4];
#pragma unroll
    for (int dt = 0; dt < 4; ++dt)
#pragma unroll
      for (int r = 0; r < 4; ++r) O[r][dt] = f32x4{0.f, 0.f, 0.f, 0.f};
#pragma unroll
    for (int r = 0; r < 4; ++r) { m[r] = -1e29f; l[r] = 0.f; }
    if (br == 1)
      attend<1>(cmask, p.ksb + (size_t)b * 2048 * 128 + g * 64, p.vsT + (size_t)bg * 64 * VTS, ql, t, t0, selmask, n, q4, O, m, l);
    else
      attend<2>(cmask, p.kwb + (size_t)b * 2048 * 128 + g * 64, p.vwT + (size_t)bg * 64 * VTS, ql, t, t0, selmask, n, q4, O, m, l);
#pragma unroll
    for (int r = 0; r < 4; ++r) {
      float lv = l[r];
      lv += __shfl_xor(lv, 16);
      lv += __shfl_xor(lv, 32);
      const float gsc = gatep[r * 3 + br] * ((lv > 0.f) ? 1.f / lv : 0.f);
#pragma unroll
      for (int dt = 0; dt < 4; ++dt) {
        uint2* mp = (uint2*)(mixl + r * 64 + dt * 16);
        const uint2 u = *mp;
        float a0 = __uint_as_float(u.x << 16) + O[r][dt][0] * gsc, a1 = __uint_as_float(u.x & 0xffff0000u) + O[r][dt][1] * gsc;
        float a2 = __uint_as_float(u.y << 16) + O[r][dt][2] * gsc, a3 = __uint_as_float(u.y & 0xffff0000u) + O[r][dt][3] * gsc;
        if (br == 2) {
          const uint2 gg = *(const uint2*)(p.gns + tok * 512 + (g * 4 + r) * 64 + dt * 16 + q4 * 4);
          a0 *= __uint_as_float(gg.x << 16); a1 *= __uint_as_float(gg.x & 0xffff0000u);
          a2 *= __uint_as_float(gg.y << 16); a3 *= __uint_as_float(gg.y & 0xffff0000u);
        }
        uint2 o;
        o.x = pk2(a0, a1);
        o.y = pk2(a2, a3);
        *mp = o;
      }
    }
  }
}

DI void phase_mix_rwkv(const Params& p) {
  int tx = threadIdx.x;
  asm volatile("" : "+v"(tx));
  const int lane = tx & 63, sub = lane >> 4, c = lane & 15;
  const int gw = blockIdx.x * 4 + (tx >> 6), nw = gridDim.x * 4;
  for (int it = gw; it < T_ * 2; it += nw) {
    const int ph = it * 4 + sub;
    const int tok = ph >> 3, h = ph & 7;
    const int ch = h * 64 + c * 4;
    const size_t idx = (size_t)tok * 512 + ch;
    const float4 y = *(const float4*)(p.yraw + idx);
    const float mean = allred16(y.x + y.y + y.z + y.w) * (1.f / 64.f);
    const float d0 = y.x - mean, d1 = y.y - mean, d2 = y.z - mean, d3 = y.w - mean;
    const float var = allred16(d0 * d0 + d1 * d1 + d2 * d2 + d3 * d3) * (1.f / 64.f);
    const float rs = rsqrtf(var + 64e-5f);
    const float4 gw4 = *(const float4*)(p.gn_w + ch), gb4 = *(const float4*)(p.gn_b + ch), rk4 = *(const float4*)(p.r_k + ch);
    const uint2 ru = *(const uint2*)(p.rr + idx), ku = *(const uint2*)(p.kp + idx), vu = *(const uint2*)(p.vv + idx),
                gu = *(const uint2*)(p.grw + idx);
    const float r0 = __uint_as_float(ru.x << 16), r1 = __uint_as_float(ru.x & 0xffff0000u), r2 = __uint_as_float(ru.y << 16),
                r3 = __uint_as_float(ru.y & 0xffff0000u);
    const float k0 = __uint_as_float(ku.x << 16), k1 = __uint_as_float(ku.x & 0xffff0000u), k2 = __uint_as_float(ku.y << 16),
                k3 = __uint_as_float(ku.y & 0xffff0000u);
    const float v0 = __uint_as_float(vu.x << 16), v1 = __uint_as_float(vu.x & 0xffff0000u), v2 = __uint_as_float(vu.y << 16),
                v3 = __uint_as_float(vu.y & 0xffff0000u);
    const float g0 = __uint_as_float(gu.x << 16), g1 = __uint_as_float(gu.x & 0xffff0000u), g2 = __uint_as_float(gu.y << 16),
                g3 = __uint_as_float(gu.y & 0xffff0000u);
    const float bonus = allred16(r0 * k0 * rk4.x + r1 * k1 * rk4.y + r2 * k2 * rk4.z + r3 * k3 * rk4.w);
    uint2 o;
    o.x = pk2((d0 * rs * gw4.x + gb4.x + bonus * v0) * g0, (d1 * rs * gw4.y + gb4.y + bonus * v1) * g1);
    o.y = pk2((d2 * rs * gw4.z + gb4.z + bonus * v2) * g2, (d3 * rs * gw4.w + gb4.w + bonus * v3) * g3);
    *(uint2*)(p.mix + (size_t)tok * LDH + 512 + ch) = o;
  }
}

DI void phase_final_norm(const Params& p) {
  int tx = threadIdx.x;
  asm volatile("" : "+v"(tx));
  const int lane = tx & 63;
  const int gw = blockIdx.x * 4 + (tx >> 6), nw = gridDim.x * 4;
  const float4* fg = (const float4*)p.final_g;
  for (int row = gw; row < T_; row += nw) {
    float4* o4 = (float4*)(p.out + (size_t)row * 1024);
    float4 v[4];
    float ss = 0.f;
#pragma unroll
    for (int i = 0; i < 4; ++i) {
      v[i] = o4[i * 64 + lane];
      ss += v[i].x * v[i].x + v[i].y * v[i].y + v[i].z * v[i].z + v[i].w * v[i].w;
    }
    ss = wsum(ss);
    const float sc = rsqrtf(ss * (1.f / 1024.f) + 1e-6f);
#pragma unroll
    for (int i = 0; i < 4; ++i) {
      float4 gq = fg[i * 64 + lane];
      v[i].x *= sc * gq.x; v[i].y *= sc * gq.y; v[i].z *= sc * gq.z; v[i].w *= sc * gq.w;
      {
        const f32x4 t_ = {v[i].x, v[i].y, v[i].z, v[i].w};
        __builtin_nontemporal_store(t_, (f32x4*)&o4[i * 64 + lane]);
      }
    }
  }
}

constexpr int NPHASE = 8;
constexpr int SMEM_BYTES = 65536;

template <int PH> DI void run_phase(const Params& p, char* smem) {
  const int bid = blockIdx.x, nb = gridDim.x;
  if (PH == 0) phase_prep(p, smem);
  if (PH == 1)
    for (int t = bid; t < 128 * 32; t += nb) gemm_tile<G_PROJ>(p, t >> 5, t & 31, 0, smem);
  if (PH == 2)
    if (nb > 128) {
      if (bid < 64) gemm_tile<G_CMP1>(p, (bid & 31) >> 1, bid & 1, bid >> 5, smem);
      else
        for (int t = bid - 64; t < 512; t += nb - 64) rwkv_prep_tile(p, t, smem);
    } else {
      for (int t = bid; t < 512 + 64; t += nb) {
        if (t < 64) gemm_tile<G_CMP1>(p, (t & 31) >> 1, t & 1, t >> 5, smem);
        else rwkv_prep_tile(p, t - 64, smem);
      }
    }
  if (PH == 3) {
    if (nb != 512)
      for (int t = bid; t < 32; t += nb) gemm_tile<G_CMP2>(p, t & 15, 0, t >> 4, smem);
  }
  if (PH == 4) {
    unsigned* flag = p.ctr + 40;
    if (nb == 512 && bid >= 256 && bid < 288) {
      const int t = bid - 256;
      gemm_tile<G_CMP2>(p, t & 15, 0, t >> 4, smem);
      asm volatile("s_waitcnt vmcnt(0)" ::: "memory");
      __syncthreads();
      if (threadIdx.x == 0) {
        __builtin_amdgcn_fence(__ATOMIC_RELEASE, "agent");
        asm volatile("s_waitcnt vmcnt(0)" ::: "memory");
        __hip_atomic_fetch_add(flag, 1u, __ATOMIC_RELAXED, __HIP_MEMORY_SCOPE_AGENT);
      }
    }
    for (int t = bid; t < 256; t += nb) scan_item(p, t, smem);
    if (nb == 512) {
      if (threadIdx.x == 0) {
        while (__hip_atomic_load(flag, __ATOMIC_RELAXED, __HIP_MEMORY_SCOPE_AGENT) < 32u) __builtin_amdgcn_s_sleep(2);
        __builtin_amdgcn_fence(__ATOMIC_ACQUIRE, "agent");
        asm volatile("s_waitcnt vmcnt(0)" ::: "memory");
      }
      __syncthreads();
    }
    float* wl = (float*)smem + (threadIdx.x >> 6) * NSA_WFLOATS;
    while (true) {
      int it = 0;
      if ((threadIdx.x & 63) == 0) it = (int)atomicAdd(p.ctr, 1u);
      it = __builtin_amdgcn_readfirstlane(it);
      if (it >= 2048) break;
      nsa_wave_item(p, (127 - (it >> 4)) * 16 + (it & 15), wl);
    }
  }
  if (PH == 5) phase_mix_rwkv(p);
  if (PH == 6)
    for (int t = bid; t < 128 * 8; t += nb) gemm_tile<G_OUT>(p, t >> 3, t & 7, 0, smem);
  if (PH == 7) phase_final_norm(p);
}

template <int PH> __global__ void __launch_bounds__(256, 2) phk(Params p) {
  __shared__ __attribute__((aligned(16))) char smem[SMEM_BYTES];
  run_phase<PH>(p, smem);
}

#ifndef PROBE_PH
#define PROBE_PH -1
#endif
#define XB_CNT(j) (256 + 64 * (j))
#define XB_SUB(j) (1280 + 64 * (j))
#define XB_GEN(j) (2304 + 64 * (j))
#define XB_TOP 3328
#define XB_TOPGEN 3392
DI unsigned xb_ld(unsigned* q) { return __hip_atomic_load(q, __ATOMIC_RELAXED, __HIP_MEMORY_SCOPE_AGENT); }
DI unsigned xb_add(unsigned* q, unsigned v) { return __hip_atomic_fetch_add(q, v, __ATOMIC_RELAXED, __HIP_MEMORY_SCOPE_AGENT); }
DI unsigned xb_xcc() { return (unsigned)__builtin_amdgcn_s_getreg((3 << 11) | 20) & 0xFu; }
DI void fast_barrier(unsigned* bar) {
  asm volatile("s_waitcnt vmcnt(0)" ::: "memory");
  __syncthreads();
  if (threadIdx.x == 0) {
    const unsigned x = xb_xcc();
    unsigned nloc, nx;
    for (;;) {
      unsigned sum = 0u;
      nloc = 1u;
      nx = 0u;
#pragma unroll
      for (unsigned j = 0; j < 16; ++j) {
        const unsigned c = xb_ld(&bar[XB_CNT(j)]);
        sum += c;
        nx += (c > 0u) ? 1u : 0u;
        nloc = (j == x) ? c : nloc;
      }
      if (sum == gridDim.x) break;
      __builtin_amdgcn_s_sleep(1);
    }
    const unsigned old = xb_add(&bar[XB_SUB(x)], 1u);
    const unsigned gen = old / nloc;
    if (old + 1u == (gen + 1u) * nloc) {
      __builtin_amdgcn_fence(__ATOMIC_RELEASE, "agent");
      asm volatile("s_waitcnt vmcnt(0)" ::: "memory");
      const unsigned og = xb_add(&bar[XB_TOP], 1u);
      const unsigned tg = og / nx;
      if (og + 1u == (tg + 1u) * nx) xb_add(&bar[XB_TOPGEN], 1u);
      else
        while (xb_ld(&bar[XB_TOPGEN]) == tg) __builtin_amdgcn_s_sleep(1);
      __builtin_amdgcn_fence(__ATOMIC_ACQUIRE, "agent");
      xb_add(&bar[XB_GEN(x)], 1u);
      asm volatile("s_waitcnt vmcnt(0)" ::: "memory");
    } else {
      while (xb_ld(&bar[XB_GEN(x)]) == gen) __builtin_amdgcn_s_sleep(1);
      __builtin_amdgcn_fence(__ATOMIC_ACQUIRE, "agent");
      asm volatile("s_waitcnt vmcnt(0)" ::: "memory");
    }
  }
  __syncthreads();
}

__global__ void __launch_bounds__(256, 2) mega(Params p) {
  __shared__ __attribute__((aligned(16))) char smem[SMEM_BYTES];
  cg::grid_group grid = cg::this_grid();
  unsigned* bar = p.xbar;
  const unsigned nblk = gridDim.x;
  if (p.ctr == nullptr) grid.sync();
  if (threadIdx.x == 0) (void)xb_add(&bar[XB_CNT(xb_xcc())], 1u);
  run_phase<0>(p, smem); fast_barrier(bar);
  run_phase<1>(p, smem); fast_barrier(bar);
  run_phase<2>(p, smem); fast_barrier(bar);
  if (nblk != 512u) { run_phase<3>(p, smem); fast_barrier(bar); }
  run_phase<4>(p, smem); fast_barrier(bar);
  run_phase<5>(p, smem); fast_barrier(bar);
  run_phase<6>(p, smem); fast_barrier(bar);
  run_phase<7>(p, smem);
}

extern "C" void kernel_launch(void* const* d_in, const int* in_sizes, int n_in, void* d_out, int out_size, void* d_ws, size_t ws_size,
                              hipStream_t stream) {
  Params p{};
  const float** pin = (const float**)&p;
  for (int i = 0; i < 21; ++i) pin[i] = (const float*)d_in[i];
  p.out = (float*)d_out;
  char* w = (char*)d_ws;
  size_t off = 0;
  auto alloc = [&](size_t bytes) { void* r = w + off; off += (bytes + 255) & ~(size_t)255; return r; };
  p.WinT = (bf16_t*)alloc((size_t)NPAD * LDW * 2);
  p.WoutT = (bf16_t*)alloc((size_t)1024 * LDW * 2);
  p.W1Tk = (bf16_t*)alloc((size_t)256 * LDW1 * 2);
  p.W1Tv = (bf16_t*)alloc((size_t)256 * LDW1 * 2);
  p.W2Tk = (bf16_t*)alloc((size_t)128 * LDW2 * 2);
  p.W2Tv = (bf16_t*)alloc((size_t)128 * LDW2 * 2);
  p.WupT = (bf16_t*)alloc((size_t)512 * 64 * 2);
  p.AupT = (bf16_t*)alloc((size_t)512 * 64 * 2);
  p.bias1k = (float*)alloc(256 * 4);
  p.bias1v = (float*)alloc(256 * 4);
  p.rope = (float2*)alloc((size_t)2048 * 8 * 8);
  p.qb = (bf16_t*)alloc((size_t)T_ * 512 * 2);
  p.kcb = (bf16_t*)alloc((size_t)(T_ + 16) * LDKC * 2);
  p.vcb = (bf16_t*)alloc((size_t)(T_ + 16) * LDKC * 2);
  p.ksb = (bf16_t*)alloc((size_t)T_ * 128 * 2);
  p.kwb = (bf16_t*)alloc((size_t)T_ * 128 * 2);
  p.vsb = nullptr;
  p.vwb = nullptr;
  p.vsT = (bf16_t*)alloc((size_t)16 * 64 * VTS * 2);
  p.vwT = (bf16_t*)alloc((size_t)16 * 64 * VTS * 2);
  p.glb = (float*)alloc((size_t)T_ * 24 * 4);
  p.gns = (bf16_t*)alloc((size_t)T_ * 512 * 2);
  p.rw = (bf16_t*)alloc((size_t)T_ * 1664 * 2);
  p.yraw = (float*)p.rw;
  p.grw = (bf16_t*)alloc((size_t)T_ * 512 * 2);
  p.hidk = (bf16_t*)alloc((size_t)2048 * LDHID * 2);
  p.hidv = (bf16_t*)alloc((size_t)2048 * LDHID * 2);
  p.kcmp = (bf16_t*)alloc((size_t)16 * 128 * 64 * 2);
  p.vcmp = (bf16_t*)alloc((size_t)16 * 128 * 64 * 2);
  p.vcmpT = (bf16_t*)alloc((size_t)16 * 128 * 64 * 2);
  p.rr = (bf16_t*)alloc((size_t)T_ * 512 * 2);
  p.kp = (bf16_t*)alloc((size_t)T_ * 512 * 2);
  p.vv = (bf16_t*)alloc((size_t)T_ * 512 * 2);
  p.mix = (bf16_t*)alloc((size_t)T_ * LDH * 2);
  p.hb = p.mix;
  p.ctr = (unsigned*)alloc(256);
  p.xbar = (unsigned*)alloc(16384);
  p.dec = (float*)d_out;
  p.kk = (bf16_t*)((char*)d_out + (size_t)T_ * 512 * 4);
  p.bb = (bf16_t*)((char*)d_out + (size_t)T_ * 512 * 6);
  if (off > ws_size) {
    fprintf(stderr, "workspace too small: need %zu have %zu\n", off, ws_size);
    return;
  }
#ifdef MULTI_LAUNCH
  hipLaunchKernelGGL(phk<0>, dim3(512), dim3(256), 0, stream, p);
  hipLaunchKernelGGL(phk<1>, dim3(512), dim3(256), 0, stream, p);
  hipLaunchKernelGGL(phk<2>, dim3(512), dim3(256), 0, stream, p);
  hipLaunchKernelGGL(phk<3>, dim3(512), dim3(256), 0, stream, p);
  hipLaunchKernelGGL(phk<4>, dim3(512), dim3(256), 0, stream, p);
  hipLaunchKernelGGL(phk<5>, dim3(512), dim3(256), 0, stream, p);
  hipLaunchKernelGGL(phk<6>, dim3(512), dim3(256), 0, stream, p);
  hipLaunchKernelGGL(phk<7>, dim3(512), dim3(256), 0, stream, p);
#else
  static int grid_blocks = 0;
  if (!grid_blocks) {
    int dev = 0, cus = 0, per_cu = 0;
    hipGetDevice(&dev);
    hipDeviceGetAttribute(&cus, hipDeviceAttributeMultiprocessorCount, dev);
    hipOccupancyMaxActiveBlocksPerMultiprocessor(&per_cu, mega, 256, 0);
    if (per_cu > 2) per_cu = 2;
    if (per_cu < 1) per_cu = 1;
    grid_blocks = cus * per_cu;
  }
  hipMemsetAsync(p.ctr, 0, 256 + 16384, stream);
  void* args[] = {&p};
  hipError_t e = hipLaunchCooperativeKernel((void*)mega, dim3(grid_blocks), dim3(256), args, 0, stream);
  if (e != hipSuccess) fprintf(stderr, "cooperative launch failed: %s (grid %d)\n", hipGetErrorString(e), grid_blocks);
#endif
}
```

```cpp
#include <hip/hip_runtime.h>
#include <hip/hip_bf16.h>
#include <hip/hip_cooperative_groups.h>
#include <cstdio>
namespace cg = cooperative_groups;


typedef unsigned short bf16_t;
using bf16x8 = __attribute__((ext_vector_type(8))) short;
using f32x16 = __attribute__((ext_vector_type(16))) float;
using f32x4 = __attribute__((ext_vector_type(4))) float;

#define DI __device__ __forceinline__

constexpr int T_ = 16384, S_ = 2048;
constexpr int NPAD = 4096;
constexpr int LDH = 1088, LDW = 1088, LDW1 = 2112, LDHID = 320, LDW2 = 320, LDKC = 136, VTS = 2112;

typedef __bf16 bf16x2_t __attribute__((ext_vector_type(2)));
typedef float f32x2_t __attribute__((ext_vector_type(2)));
DI unsigned pk2(float a, float b) {
  f32x2_t v = {a, b};
  return __builtin_bit_cast(unsigned, __builtin_convertvector(v, bf16x2_t));
}
DI bf16_t f2bf(float x) { return (bf16_t)(pk2(x, 0.f) & 0xffffu); }
DI float bf2f(bf16_t b) { return __uint_as_float(((unsigned)b) << 16); }
typedef unsigned u32x4_t __attribute__((ext_vector_type(4)));
DI void stnt16(void* q, uint4 v) {
  const u32x4_t t_ = {v.x, v.y, v.z, v.w};
  __builtin_nontemporal_store(t_, (u32x4_t*)q);
}
DI float sigmoidf_(float x) { return 1.f / (1.f + __expf(-x)); }
DI float siluf_(float x) { return x / (1.f + __expf(-x)); }
DI float wsum(float x) {
#pragma unroll
  for (int o = 32; o >= 1; o >>= 1) x += __shfl_xor(x, o);
  return x;
}
DI float wmax(float x) {
#pragma unroll
  for (int o = 32; o >= 1; o >>= 1) x = fmaxf(x, __shfl_xor(x, o));
  return x;
}
template <int CTRL> DI float dppf(float x) {
  return __int_as_float(__builtin_amdgcn_update_dpp(0, __float_as_int(x), CTRL, 0xf, 0xf, true));
}
DI float allred16(float x) {
  x += dppf<0xB1>(x);
  x += dppf<0x4E>(x);
  x += dppf<0x141>(x);
  x += dppf<0x128>(x);
  return x;
}

struct Params {
  const float *x, *norm_g, *w_in, *pos_k, *w1_k, *w2_k, *pos_v, *w1_v, *w2_v, *mu, *w0, *w_up, *a0, *a_up, *k_k, *k_a, *r_k,
      *gn_w, *gn_b, *w_out, *final_g;
  float* out;
  bf16_t *WinT, *WoutT, *W1Tk, *W1Tv, *W2Tk, *W2Tv, *WupT, *AupT;
  float *bias1k, *bias1v;
  float2* rope;
  bf16_t *qb, *kcb, *vcb, *ksb, *kwb, *vsb, *vwb, *vsT, *vwT;
  float* glb;
  bf16_t *gns, *rw, *grw, *hidk, *hidv, *kcmp, *vcmp, *vcmpT;
  bf16_t *rr, *kp, *vv, *kk, *bb;
  float *dec, *yraw;
  bf16_t* mix;
  bf16_t* hb;
  unsigned* ctr;
  unsigned* xbar;
};

DI void transpose_tile(const float* __restrict__ src, int ldsrc, bf16_t* __restrict__ dst, int ldd, int k0, int n0, const float* scale,
                       int mapmode, int nvalid, float* tile) {
  const int tid = threadIdx.x;
#pragma unroll
  for (int i = 0; i < 4; ++i) {
    const int idx = tid + 256 * i, kl = idx >> 4, ng = (idx & 15) * 4;
    const int n = n0 + ng;
    int on;
    if (mapmode == 1) on = (n < 1304) ? n : (n < 1408 ? -1 : n - 104);
    else on = (n < nvalid) ? n : -1;
    float4 v = make_float4(0.f, 0.f, 0.f, 0.f);
    if (on >= 0) {
      v = *(const float4*)(src + (size_t)(k0 + kl) * ldsrc + on);
      if (scale) {
        const float sc = scale[k0 + kl];
        v.x *= sc; v.y *= sc; v.z *= sc; v.w *= sc;
      }
    }
    float* t = tile + kl * 65 + ng;
    t[0] = v.x; t[1] = v.y; t[2] = v.z; t[3] = v.w;
  }
  __syncthreads();
#pragma unroll
  for (int i = 0; i < 2; ++i) {
    const int idx = tid + 256 * i, nl = idx >> 3, kg = (idx & 7) * 8;
    uint4 o;
    o.x = pk2(tile[(kg + 0) * 65 + nl], tile[(kg + 1) * 65 + nl]);
    o.y = pk2(tile[(kg + 2) * 65 + nl], tile[(kg + 3) * 65 + nl]);
    o.z = pk2(tile[(kg + 4) * 65 + nl], tile[(kg + 5) * 65 + nl]);
    o.w = pk2(tile[(kg + 6) * 65 + nl], tile[(kg + 7) * 65 + nl]);
    *(uint4*)(dst + (size_t)(n0 + nl) * ldd + k0 + kg) = o;
  }
  __syncthreads();
}

DI void phase_prep(const Params& p, char* smem) {
  float* tile = (float*)smem;
  const int nb = gridDim.x, bid = blockIdx.x, tid = threadIdx.x;
  {
    const int lane = tid & 63;
    for (int row = bid * 4 + (tid >> 6); row < T_; row += nb * 4) {
      const float4* x4 = (const float4*)(p.x + (size_t)row * 1024);
      float4 v[4];
      float ss = 0.f;
#pragma unroll
      for (int i = 0; i < 4; ++i) {
        {
          const f32x4 t_ = __builtin_nontemporal_load((const f32x4*)&x4[i * 64 + lane]);
          v[i] = make_float4(t_[0], t_[1], t_[2], t_[3]);
        }
        ss += v[i].x * v[i].x + v[i].y * v[i].y + v[i].z * v[i].z + v[i].w * v[i].w;
      }
      ss = wsum(ss);
      const float sc = rsqrtf(ss * (1.f / 1024.f) + 1e-6f);
      uint2* h2 = (uint2*)(p.hb + (size_t)row * LDH);
#pragma unroll
      for (int i = 0; i < 4; ++i) {
        uint2 o;
        o.x = pk2(v[i].x * sc, v[i].y * sc);
        o.y = pk2(v[i].z * sc, v[i].w * sc);
        h2[i * 64 + lane] = o;
      }
    }
  }
  const int n_win = 16 * 64, n_wout = 16 * 16, n_w1 = 32 * 4, n_w2 = 4 * 2, n_lora = 1 * 8;
  const int o1 = n_win, o2 = o1 + n_wout, o3 = o2 + n_w1, o4 = o3 + n_w1, o5 = o4 + n_w2, o6 = o5 + n_w2, o7 = o6 + n_lora,
            o8 = o7 + n_lora, o9 = o8 + 128, o10 = o9 + 16;
  for (int it = bid; it < o10; it += nb) {
    if (it < o1) {
      int kt = it & 15, nt = it >> 4;
      transpose_tile(p.w_in, 3992, p.WinT, LDW, kt * 64, nt * 64, p.norm_g, 1, 0, tile);
    } else if (it < o2) {
      int j = it - o1, kt = j & 15, nt = j >> 4;
      transpose_tile(p.w_out, 1024, p.WoutT, LDW, kt * 64, nt * 64, nullptr, 0, 1024, tile);
    } else if (it < o3) {
      int j = it - o2, kt = j & 31, nt = j >> 5;
      transpose_tile(p.w1_k, 256, p.W1Tk, LDW1, kt * 64, nt * 64, nullptr, 0, 256, tile);
    } else if (it < o4) {
      int j = it - o3, kt = j & 31, nt = j >> 5;
      transpose_tile(p.w1_v, 256, p.W1Tv, LDW1, kt * 64, nt * 64, nullptr, 0, 256, tile);
    } else if (it < o5) {
      int j = it - o4, kt = j & 3, nt = j >> 2;
      transpose_tile(p.w2_k, 64, p.W2Tk, LDW2, kt * 64, nt * 64, nullptr, 0, 64, tile);
    } else if (it < o6) {
      int j = it - o5, kt = j & 3, nt = j >> 2;
      transpose_tile(p.w2_v, 64, p.W2Tv, LDW2, kt * 64, nt * 64, nullptr, 0, 64, tile);
    } else if (it < o7) {
      int nt = it - o6;
      transpose_tile(p.w_up, 512, p.WupT, 64, 0, nt * 64, nullptr, 0, 512, tile);
    } else if (it < o8) {
      int nt = it - o7;
      transpose_tile(p.a_up, 512, p.AupT, 64, 0, nt * 64, nullptr, 0, 512, tile);
    } else if (it < o9) {
      const int j = it - o8, which = j >> 6, n0 = (j & 63) * 4;
      const float* pos = which ? p.pos_v : p.pos_k;
      const float* w1 = which ? p.w1_v : p.w1_k;
      float* bo = which ? p.bias1v : p.bias1k;
      const int kp = tid >> 2, nn = tid & 3;
      float a = 0.f;
#pragma unroll 16
      for (int k = kp * 32; k < kp * 32 + 32; ++k) a += pos[k] * w1[(size_t)k * 256 + n0 + nn];
      tile[tid] = a;
      __syncthreads();
      if (tid < 4) {
        float sum = 0.f;
        for (int q = 0; q < 64; ++q) sum += tile[q * 4 + tid];
        bo[n0 + tid] = sum;
      }
      __syncthreads();
    } else {
      int j = it - o9;
      for (int e = tid; e < 1024; e += 256) {
        int idx = j * 1024 + e;
        int pos = idx >> 3, i = idx & 7;
        float inv = powf(500000.0f, -(float)i / 8.0f);
        float ang = (float)pos * inv;
        float sn, cs;
        sincosf(ang, &sn, &cs);
        p.rope[idx] = make_float2(cs, sn);
      }
    }
  }
}

constexpr int LDT = 40;

DI int crow(int i, int h) { return (i & 3) + 8 * (i >> 2) + 4 * h; }

enum { G_PROJ = 0, G_CMP1 = 1, G_CMP2 = 2, G_OUT = 3 };

template <int MODE, bool EPI = true>
DI void gemm_tile(const Params& p, int mt, int nt, int which, char* smem) {
  constexpr int K = (MODE == G_PROJ) ? 1024 : (MODE == G_CMP1) ? 2048 : (MODE == G_CMP2) ? 256 : 1024;
  constexpr int LDA = (MODE == G_PROJ) ? LDH : (MODE == G_CMP1) ? LDKC : (MODE == G_CMP2) ? LDHID : LDH;
  constexpr int LDB = (MODE == G_PROJ) ? LDW : (MODE == G_CMP1) ? LDW1 : (MODE == G_CMP2) ? LDW2 : LDW;
  const int tid = threadIdx.x, lane = tid & 63, wave = tid >> 6;
  const int wm = wave >> 1, wn = wave & 1;
  const int m0 = mt * 128, n0 = nt * 128;

  const bf16_t* Bt;
  const bf16_t* Ab;
  if (MODE == G_PROJ) { Bt = p.WinT; Ab = p.hb; }
  else if (MODE == G_CMP1) { Bt = which ? p.W1Tv : p.W1Tk; Ab = which ? p.vcb : p.kcb; }
  else if (MODE == G_CMP2) { Bt = which ? p.W2Tv : p.W2Tk; Ab = which ? p.hidv : p.hidk; }
  else { Bt = p.WoutT; Ab = p.mix; }

  const int lrr = lane >> 2;
  const int lks = (lane & 3) ^ ((lane >> 4) & 3);
  unsigned aoA, aoB, boA;
  {
    const int r0 = m0 + (2 * wave) * 16 + lrr, r1 = r0 + 16;
    if (MODE == G_CMP1) {
      aoA = (unsigned)(r0 >> 1) * (16 * LDA) + (r0 & 1) * 64;
      aoB = (unsigned)(r1 >> 1) * (16 * LDA) + (r1 & 1) * 64;
    } else {
      aoA = (unsigned)r0 * LDA;
      aoB = (unsigned)r1 * LDA;
    }
    boA = (unsigned)(n0 + (2 * wave) * 16 + lrr) * LDB + lks * 8;
  }
  char* ldsw = smem + (2 * wave) * 1024;
  auto glds = [&](int kt) __attribute__((always_inline)) {
    char* st = ldsw + (kt & 3) * 16384;
    const int k_ = kt * 32 + lks * 8;
    const unsigned ko_ = (MODE == G_CMP1) ? ((unsigned)(k_ >> 6) * LDA + (k_ & 63)) : (unsigned)k_;
    __builtin_amdgcn_global_load_lds((const unsigned*)(Ab + (aoA + ko_)), (__attribute__((address_space(3))) unsigned*)(st), 16, 0, 0);
    __builtin_amdgcn_global_load_lds((const unsigned*)(Ab + (aoB + ko_)), (__attribute__((address_space(3))) unsigned*)(st + 1024), 16, 0, 0);
    __builtin_amdgcn_global_load_lds((const unsigned*)(Bt + (boA + kt * 32)), (__attribute__((address_space(3))) unsigned*)(st + 8192), 16, 0, 0);
    __builtin_amdgcn_global_load_lds((const unsigned*)(Bt + (boA + 16 * LDB + kt * 32)), (__attribute__((address_space(3))) unsigned*)(st + 8192 + 1024), 16, 0, 0);
  };

  f32x16 acc[2][2];
#pragma unroll
  for (int a = 0; a < 2; ++a)
#pragma unroll
    for (int b = 0; b < 2; ++b)
#pragma unroll
      for (int i = 0; i < 16; ++i) acc[a][b][i] = 0.f;

  const int frr = lane & 15, fhi = (lane >> 4) & 1, fq = lane >> 5;
  const int offA0 = ((wm * 64) >> 4) * 1024 + fhi * 1024 + frr * 64;
  const int offB0 = 8192 + ((wn * 64) >> 4) * 1024 + fhi * 1024 + frr * 64;
  const int fsw = (frr >> 2) & 3;
  bf16x8 fa0_0, fa0_1, fb0_0, fb0_1, fa1_0, fa1_1, fb1_0, fb1_1;
  bf16x8 ga0_0, ga0_1, gb0_0, gb0_1, ga1_0, ga1_1, gb1_0, gb1_1;
  const unsigned lbase = (unsigned)(size_t)(__attribute__((address_space(3))) char*)smem;
  const unsigned adA0 = lbase + offA0 + ((0 * 2 + fq) ^ fsw) * 16, adA1 = lbase + offA0 + ((1 * 2 + fq) ^ fsw) * 16;
  const unsigned adB0 = lbase + offB0 + ((0 * 2 + fq) ^ fsw) * 16, adB1 = lbase + offB0 + ((1 * 2 + fq) ^ fsw) * 16;
#define DSR(DST, AD, OFF) asm volatile("ds_read_b128 %0, %1 offset:%2" : "=v"(DST) : "v"(AD), "n"(OFF))
#define FRAG_LOAD_STG(P, SO)                \
  {                                         \
    DSR(P##a0_0, adA0, (SO));               \
    DSR(P##a0_1, adA0, (SO) + 2048);        \
    DSR(P##b0_0, adB0, (SO));               \
    DSR(P##b0_1, adB0, (SO) + 2048);        \
    DSR(P##a1_0, adA1, (SO));               \
    DSR(P##a1_1, adA1, (SO) + 2048);        \
    DSR(P##b1_0, adB1, (SO));               \
    DSR(P##b1_1, adB1, (SO) + 2048);        \
  }
#define FRAG_LOAD(P, STG)                               \
  {                                                     \
    const int stg_ = (STG);                             \
    if (stg_ == 0) FRAG_LOAD_STG(P, 0)                  \
    else if (stg_ == 1) FRAG_LOAD_STG(P, 16384)         \
    else if (stg_ == 2) FRAG_LOAD_STG(P, 32768)         \
    else FRAG_LOAD_STG(P, 49152)                        \
  }
#define FRAG_MMA(P)                                                                                     \
  {                                                                                                     \
    acc[0][0] = __builtin_amdgcn_mfma_f32_32x32x16_bf16(P##a0_0, P##b0_0, acc[0][0], 0, 0, 0);          \
    acc[0][1] = __builtin_amdgcn_mfma_f32_32x32x16_bf16(P##a0_0, P##b0_1, acc[0][1], 0, 0, 0);          \
    acc[1][0] = __builtin_amdgcn_mfma_f32_32x32x16_bf16(P##a0_1, P##b0_0, acc[1][0], 0, 0, 0);          \
    acc[1][1] = __builtin_amdgcn_mfma_f32_32x32x16_bf16(P##a0_1, P##b0_1, acc[1][1], 0, 0, 0);          \
    acc[0][0] = __builtin_amdgcn_mfma_f32_32x32x16_bf16(P##a1_0, P##b1_0, acc[0][0], 0, 0, 0);          \
    acc[0][1] = __builtin_amdgcn_mfma_f32_32x32x16_bf16(P##a1_0, P##b1_1, acc[0][1], 0, 0, 0);          \
    acc[1][0] = __builtin_amdgcn_mfma_f32_32x32x16_bf16(P##a1_1, P##b1_0, acc[1][0], 0, 0, 0);          \
    acc[1][1] = __builtin_amdgcn_mfma_f32_32x32x16_bf16(P##a1_1, P##b1_1, acc[1][1], 0, 0, 0);          \
  }
#define NEXT_TILE(P, KT1, STG)                                                     \
  {                                                                                \
    if ((KT1) + 2 <= KT - 1) asm volatile("s_waitcnt vmcnt(8)" ::: "memory");      \
    else if ((KT1) + 1 == KT - 1) asm volatile("s_waitcnt vmcnt(4)" ::: "memory"); \
    else asm volatile("s_waitcnt vmcnt(0)" ::: "memory");                          \
    asm volatile("s_waitcnt lgkmcnt(0)" ::: "memory");                             \
    __builtin_amdgcn_s_barrier();                                                  \
    if ((KT1) + 3 < KT) glds((KT1) + 3);                                           \
    FRAG_LOAD(P, STG)                                                              \
  }

  constexpr int KT = K / 32;
  static_assert(KT % 2 == 0, "k-tile count must be even");
  asm volatile("s_waitcnt vmcnt(0)" ::: "memory");
  glds(0);
  glds(1);
  glds(2);
  asm volatile("s_waitcnt vmcnt(8)" ::: "memory");
  asm volatile("s_waitcnt lgkmcnt(0)" ::: "memory");
  __builtin_amdgcn_s_barrier();
  glds(3);
  FRAG_LOAD(f, 0)
  static_assert(KT % 4 == 0, "k-tile count must be a multiple of the ring depth");
#pragma unroll 1
  for (int kt = 0; kt < KT; kt += 4) {
    NEXT_TILE(g, kt + 1, 1)
    FRAG_MMA(f)
    NEXT_TILE(f, kt + 2, 2)
    FRAG_MMA(g)
    NEXT_TILE(g, kt + 3, 3)
    FRAG_MMA(f)
    if (kt + 4 < KT) {
      NEXT_TILE(f, kt + 4, 0)
    } else {
      asm volatile("s_waitcnt lgkmcnt(0)" ::: "memory");
    }
    FRAG_MMA(g)
  }
#undef NEXT_TILE
#undef FRAG_MMA
#undef FRAG_LOAD
#undef FRAG_LOAD_STG
#undef DSR
  asm volatile("s_waitcnt lgkmcnt(0)" ::: "memory");
  __builtin_amdgcn_s_barrier();

  if (!EPI) {
    float sacc = 0.f;
#pragma unroll
    for (int a = 0; a < 2; ++a)
#pragma unroll
      for (int b = 0; b < 2; ++b)
#pragma unroll
        for (int i = 0; i < 16; ++i) sacc += acc[a][b][i];
    if (sacc == 12345.678f) p.ctr[8] = 1u;
    return;
  }
  int tide = tid;
  asm volatile("" : "+v"(tide));
  const int lane_e = tide & 63;
  const int h5 = lane_e >> 5, cl = lane_e & 31;
  auto each = [&](auto&& f) __attribute__((always_inline)) {
#pragma unroll
    for (int mi = 0; mi < 2; ++mi)
#pragma unroll
      for (int ni = 0; ni < 2; ++ni)
#pragma unroll
        for (int i = 0; i < 16; ++i) {
          const int rl = wm * 64 + mi * 32 + crow(i, h5);
          f(ni, rl, m0 + rl, n0 + wn * 64 + ni * 32 + cl, acc[mi][ni][i]);
        }
  };
  if (MODE == G_PROJ) {
    const int ct = nt;
    if (ct == 10) {
      each([&](int ni, int rl, int row, int col, float v) {
        const int c2 = col - 1280;
        if (c2 < 24) p.glb[(size_t)row * 24 + c2] = sigmoidf_(v);
      });
    } else {
      bf16_t* tl = (bf16_t*)smem;
      if (ct == 6 || ct == 8) {
        each([&](int ni, int rl, int row, int col, float v) {
          if (ni == 0) {
            float other = __shfl_xor(v, 8);
            if (cl < 16) {
              float2 cs = p.rope[(row & 2047) * 8 + (cl & 7)];
              v = (cl < 8) ? (v * cs.x - other * cs.y) : (v * cs.x + other * cs.y);
            }
          }
          tl[rl * 136 + (col - n0)] = f2bf(v);
        });
      } else if ((ct >= 11 && ct < 15) || ct >= 28) {
        each([&](int ni, int rl, int row, int col, float v) { tl[rl * 136 + (col - n0)] = f2bf(siluf_(v)); });
      } else {
        each([&](int ni, int rl, int row, int col, float v) { tl[rl * 136 + (col - n0)] = f2bf(v); });
      }
      __syncthreads();
      if (ct == 7 || ct == 9) {
        bf16_t* d2 = (ct == 7) ? p.vsT : p.vwT;
        const int b = m0 >> 11, s0 = m0 & 2047;
#pragma unroll
        for (int i = 0; i < 8; ++i) {
          const int idx = tide + 256 * i;
          const int c2 = idx & 127, rseg = idx >> 7;
          unsigned short e[8];
#pragma unroll
          for (int j = 0; j < 8; ++j) e[j] = tl[(rseg * 8 + j) * 136 + c2];
          uint4 o;
          o.x = e[0] | ((unsigned)e[1] << 16); o.y = e[2] | ((unsigned)e[3] << 16);
          o.z = e[4] | ((unsigned)e[5] << 16); o.w = e[6] | ((unsigned)e[7] << 16);
          *(uint4*)(d2 + ((size_t)((b * 2 + (c2 >> 6)) * 64 + (c2 & 63))) * VTS + s0 + rseg * 8) = o;
        }
      } else {
        bf16_t* dst;
        int ld, cb;
        if (ct < 4) { dst = p.qb; ld = 512; cb = n0; }
        else if (ct == 4) { dst = p.kcb; ld = LDKC; cb = 0; }
        else if (ct == 5) { dst = p.vcb; ld = LDKC; cb = 0; }
        else if (ct == 6) { dst = p.ksb; ld = 128; cb = 0; }
        else if (ct == 8) { dst = p.kwb; ld = 128; cb = 0; }
        else if (ct < 15) { dst = p.gns; ld = 512; cb = n0 - 1408; }
        else if (ct < 28) { dst = p.rw; ld = 1664; cb = n0 - 1920; }
        else { dst = p.grw; ld = 512; cb = n0 - 3584; }
#pragma unroll
        for (int i = 0; i < 8; ++i) {
          const int idx = tide + 256 * i;
          const int r = idx >> 4, sg = idx & 15;
          const uint4 v4 = *(const uint4*)(tl + r * 136 + sg * 8);
          *(uint4*)(dst + (size_t)(m0 + r) * ld + cb + sg * 8) = v4;
        }
      }
    }
  } else if (MODE == G_CMP1) {
    const float* bias = which ? p.bias1v : p.bias1k;
    bf16_t* hid = which ? p.hidv : p.hidk;
    each([&](int ni, int rl, int row, int col, float v) { hid[(size_t)row * LDHID + col] = f2bf(siluf_(v + bias[col])); });
  } else if (MODE == G_CMP2) {
    each([&](int ni, int rl, int row, int col, float v) {
      if (col < 64) {
        const int b = row >> 8, c = (row >> 1) & 127, g = row & 1;
        const int bg = b * 2 + g;
        bf16_t hv = (c < 127) ? f2bf(v) : (bf16_t)0;
        if (which == 0) {
          p.kcmp[((size_t)bg * 128 + c) * 64 + col] = hv;
        } else {
          p.vcmp[((size_t)bg * 128 + c) * 64 + col] = hv;
          p.vcmpT[((size_t)bg * 64 + col) * 128 + c] = hv;
        }
      }
    });
  } else {
    float xv[2][2][16];
#pragma unroll
    for (int mi = 0; mi < 2; ++mi)
#pragma unroll
      for (int ni = 0; ni < 2; ++ni)
#pragma unroll
        for (int i = 0; i < 16; ++i)
          xv[mi][ni][i] = p.x[(size_t)(m0 + wm * 64 + mi * 32 + crow(i, h5)) * 1024 + n0 + wn * 64 + ni * 32 + cl];
#pragma unroll
    for (int mi = 0; mi < 2; ++mi)
#pragma unroll
      for (int ni = 0; ni < 2; ++ni)
#pragma unroll
        for (int i = 0; i < 16; ++i)
          p.out[(size_t)(m0 + wm * 64 + mi * 32 + crow(i, h5)) * 1024 + n0 + wn * 64 + ni * 32 + cl] = xv[mi][ni][i] + acc[mi][ni][i];
  }
  __syncthreads();
}

DI float shiftv(const Params& p, int tok, int col) {
  float cur = bf2f(p.rw[(size_t)tok * 1664 + col]);
  float prev = (tok & 2047) ? bf2f(p.rw[(size_t)(tok - 1) * 1664 + col]) : 0.f;
  return cur + p.mu[col] * (prev - cur);
}

DI void unpack8(uint4 u, float (&f)[8]) {
  f[0] = __uint_as_float(u.x << 16); f[1] = __uint_as_float(u.x & 0xffff0000u);
  f[2] = __uint_as_float(u.y << 16); f[3] = __uint_as_float(u.y & 0xffff0000u);
  f[4] = __uint_as_float(u.z << 16); f[5] = __uint_as_float(u.z & 0xffff0000u);
  f[6] = __uint_as_float(u.w << 16); f[7] = __uint_as_float(u.w & 0xffff0000u);
}
DI uint4 pack8(const float (&f)[8]) {
  uint4 o;
  o.x = pk2(f[0], f[1]);
  o.y = pk2(f[2], f[3]);
  o.z = pk2(f[4], f[5]);
  o.w = pk2(f[6], f[7]);
  return o;
}
DI void ld8f(const float* ptr, float (&f)[8]) {
  const float4 a = *(const float4*)ptr, b = *(const float4*)(ptr + 4);
  f[0] = a.x; f[1] = a.y; f[2] = a.z; f[3] = a.w; f[4] = b.x; f[5] = b.y; f[6] = b.z; f[7] = b.w;
}
DI void shift8(const Params& p, int tok, int col, float (&o)[8]) {
  float c[8], pv[8], m[8];
  unpack8(*(const uint4*)(p.rw + (size_t)tok * 1664 + col), c);
  uint4 pu = make_uint4(0u, 0u, 0u, 0u);
  if (tok & 2047) pu = *(const uint4*)(p.rw + (size_t)(tok - 1) * 1664 + col);
  unpack8(pu, pv);
  ld8f(p.mu + col, m);
#pragma unroll
  for (int j = 0; j < 8; ++j) o[j] = c[j] + m[j] * (pv[j] - c[j]);
}

DI void rwkv_prep_tile(const Params& p, int tile, char* smem) {
  const int t0 = tile * 32;
  bf16_t* sW = (bf16_t*)smem;
  bf16_t* sAd = sW + 32 * 72;
  bf16_t* sA = sAd + 32 * 72;
  int tid = threadIdx.x;
  asm volatile("" : "+v"(tid));
  const int lane = tid & 63, wave = tid >> 6;
#pragma unroll
  for (int i = 0; i < 2; ++i) {
    const int idx = tid + 256 * i, m = idx >> 4, sg = idx & 15;
    float v[8];
    shift8(p, t0 + m, 1536 + sg * 8, v);
    if (sg < 8) {
#pragma unroll
      for (int j = 0; j < 8; ++j) v[j] = tanhf(v[j]);
      *(uint4*)(sW + m * 72 + sg * 8) = pack8(v);
    } else {
      *(uint4*)(sAd + m * 72 + (sg - 8) * 8) = pack8(v);
    }
  }
  __syncthreads();
  const int h5 = lane >> 5, cl = lane & 31;
#pragma unroll 1
  for (int sp = 0; sp < 8; ++sp) {
    const int pass = sp >> 2, ni = sp & 3;
    const bf16_t* As = pass ? sAd : sW;
    const bf16_t* Bt = pass ? p.AupT : p.WupT;
    const int n = wave * 128 + ni * 32 + cl;
    f32x16 acc;
#pragma unroll
    for (int i = 0; i < 16; ++i) acc[i] = 0.f;
#pragma unroll
    for (int ks = 0; ks < 4; ++ks) {
      bf16x8 af = *(const bf16x8*)(As + cl * 72 + ks * 16 + h5 * 8);
      bf16x8 bfr = *(const bf16x8*)(Bt + (size_t)n * 64 + ks * 16 + h5 * 8);
      acc = __builtin_amdgcn_mfma_f32_32x32x16_bf16(af, bfr, acc, 0, 0, 0);
    }
    if (pass == 0) {
      const float w0n = p.w0[n];
#pragma unroll
      for (int i = 0; i < 16; ++i) {
        const int tok = t0 + crow(i, h5);
        const float sg = 1.f / (1.f + __expf(-(w0n + acc[i])));
        __builtin_nontemporal_store(__expf(-0.6065306597126334f * sg), p.dec + (size_t)tok * 512 + n);
      }
    } else {
      const float a0n = p.a0[n];
#pragma unroll
      for (int i = 0; i < 16; ++i) sA[crow(i, h5) * 520 + n] = f2bf(1.f / (1.f + __expf(-(a0n + acc[i]))));
    }
  }
  __syncthreads();
#pragma unroll 1
  for (int i = 0; i < 8; ++i) {
    const int idx = tid + 256 * i, m = idx >> 6, ch0 = (idx & 63) * 8;
    const int tok = t0 + m;
    const size_t o = (size_t)tok * 512 + ch0;
    float rs[8], ks[8], vs[8], a[8], kkc[8], kac[8];
    shift8(p, tok, ch0, rs);
    shift8(p, tok, 512 + ch0, ks);
    shift8(p, tok, 1024 + ch0, vs);
    unpack8(*(const uint4*)(sA + m * 520 + ch0), a);
    ld8f(p.k_k + ch0, kkc);
    ld8f(p.k_a + ch0, kac);
    float kkr[8], ssq = 0.f;
#pragma unroll
    for (int j = 0; j < 8; ++j) { kkr[j] = ks[j] * kkc[j]; ssq += kkr[j] * kkr[j]; }
    ssq += __shfl_xor(ssq, 1);
    ssq += __shfl_xor(ssq, 2);
    ssq += __shfl_xor(ssq, 4);
    const float inv = 1.0f / fmaxf(sqrtf(ssq), 1e-12f);
    float kp[8], bb[8];
#pragma unroll
    for (int j = 0; j < 8; ++j) {
      kkr[j] *= inv;
      kp[j] = ks[j] * (1.f + (a[j] - 1.f) * kac[j]);
      bb[j] = kkr[j] * a[j];
    }
    stnt16(p.rr + o, pack8(rs));
    stnt16(p.kp + o, pack8(kp));
    stnt16(p.vv + o, pack8(vs));
    stnt16(p.kk + o, pack8(kkr));
    stnt16(p.bb + o, pack8(bb));
  }
  __syncthreads();
}

constexpr int SCH = 16;
constexpr int SSTR = 336;

DI void scan_item(const Params& p, int item, char* smem) {
  const int xcd = item & 7, slot = item >> 3;
  const int bh = xcd * 8 + (slot >> 2), rg = slot & 3;
  const int b = bh >> 3, h = bh & 7, row0 = rg * 16;
  float* buf = (float*)smem;
  float* ybuf = buf + 2 * SCH * SSTR;
  int tid = threadIdx.x;
  asm volatile("" : "+v"(tid));
  const int lane = tid & 63, wave = tid >> 6;
  const int q = lane >> 4, c = lane & 15, lr = wave * 4 + q;
  const size_t tokb = (size_t)b * 2048;

  const bf16_t* ap[2];
  int ast[2], aseg[2], aslot[2];
#pragma unroll
  for (int i = 0; i < 2; ++i) {
    int e = tid + 256 * i;
    int arr = e >> 7;
    ast[i] = (e >> 3) & 15;
    aseg[i] = e & 7;
    ap[i] = arr == 0 ? p.rr : arr == 1 ? p.kp : arr == 2 ? p.kk : p.bb;
    aslot[i] = arr == 0 ? 4 : arr;
  }
  const int dst_ = tid >> 4, dseg = tid & 15;
  const int vst = (tid >> 1) & 15, vseg = tid & 1;
  struct Stage { uint4 g0, g1, gv; float4 gd; };
  auto gload = [&](Stage& S, int ci) {
    const size_t s0 = tokb + (size_t)ci * SCH;
    S.g0 = *(const uint4*)(ap[0] + (s0 + ast[0]) * 512 + h * 64 + aseg[0] * 8);
    S.g1 = *(const uint4*)(ap[1] + (s0 + ast[1]) * 512 + h * 64 + aseg[1] * 8);
    S.gd = *(const float4*)(p.dec + (s0 + dst_) * 512 + h * 64 + dseg * 4);
    if (tid < 32) S.gv = *(const uint4*)(p.vv + (s0 + vst) * 512 + h * 64 + row0 + vseg * 8);
  };
  auto cvt8 = [&](uint4 u, float* d) {
    float4 a, b2;
    a.x = __uint_as_float(u.x << 16); a.y = __uint_as_float(u.x & 0xffff0000u);
    a.z = __uint_as_float(u.y << 16); a.w = __uint_as_float(u.y & 0xffff0000u);
    b2.x = __uint_as_float(u.z << 16); b2.y = __uint_as_float(u.z & 0xffff0000u);
    b2.z = __uint_as_float(u.w << 16); b2.w = __uint_as_float(u.w & 0xffff0000u);
    *(float4*)d = a;
    *(float4*)(d + 4) = b2;
  };
  auto sstore = [&](const Stage& S, int nbuf) {
    float* B = buf + nbuf * SCH * SSTR;
    cvt8(S.g0, B + ast[0] * SSTR + aslot[0] * 64 + aseg[0] * 8);
    cvt8(S.g1, B + ast[1] * SSTR + aslot[1] * 64 + aseg[1] * 8);
    *(float4*)(B + dst_ * SSTR + dseg * 4) = S.gd;
    if (tid < 32) cvt8(S.gv, B + vst * SSTR + 320 + vseg * 8);
  };

  f32x2_t sA = {0.f, 0.f}, sB = {0.f, 0.f};
  auto compute = [&](int ci, int cb) {
    const float* B = buf + cb * SCH * SSTR;
    float* Y = ybuf + cb * 256;
    const float* Lc = B + 4 * c;
    const float* Lv = B + 320 + lr;
    float4 w0_ = *(const float4*)(Lc), k0_ = *(const float4*)(Lc + 64), q0_ = *(const float4*)(Lc + 128),
           b0_ = *(const float4*)(Lc + 192), r0_ = *(const float4*)(Lc + 256);
    float v0_ = Lv[0];
    float4 w1_, k1_, q1_, b1_, r1_;
    float v1_;
    float pp;
    {
      const f32x2_t k0 = {q0_.x, q0_.y}, k1 = {q0_.z, q0_.w};
      f32x2_t pq = sA * k0;
      pq = sB * k1 + pq;
      pp = allred16(pq.x + pq.y);
    }
    float ysel = 0.f;
#define SCAN_STEP(W, K, BV, R, V, NW, NK, NQ, NB, NR, NV, ST)                                          \
  {                                                                                                    \
    if ((ST) + 1 < SCH) {                                                                              \
      NW = *(const float4*)(Lc + ((ST) + 1) * SSTR);                                                   \
      NK = *(const float4*)(Lc + ((ST) + 1) * SSTR + 64);                                              \
      NQ = *(const float4*)(Lc + ((ST) + 1) * SSTR + 128);                                             \
      NB = *(const float4*)(Lc + ((ST) + 1) * SSTR + 192);                                             \
      NR = *(const float4*)(Lc + ((ST) + 1) * SSTR + 256);                                             \
      NV = Lv[((ST) + 1) * SSTR];                                                                      \
    }                                                                                                  \
    const f32x2_t wa = {W.x, W.y}, wb = {W.z, W.w}, ka = {K.x, K.y}, kb = {K.z, K.w}, ba = {BV.x, BV.y}, \
                  bb2 = {BV.z, BV.w}, ra = {R.x, R.y}, rb = {R.z, R.w}, qa = {NQ.x, NQ.y}, qb = {NQ.z, NQ.w}; \
    const f32x2_t msa = {-pp, -pp}, vv2 = {V, V};                                                      \
    const f32x2_t t0 = ba * msa + ka * vv2, t1 = bb2 * msa + kb * vv2;                                 \
    sA = sA * wa + t0;                                                                                 \
    sB = sB * wb + t1;                                                                                 \
    f32x2_t yq = sA * ra;                                                                              \
    yq = sB * rb + yq;                                                                                 \
    f32x2_t pq = sA * qa;                                                                              \
    pq = sB * qb + pq;                                                                                 \
    float ys = yq.x + yq.y, ps = pq.x + pq.y;                                                          \
    ys += dppf<0xB1>(ys);  ps += dppf<0xB1>(ps);                                                       \
    ys += dppf<0x4E>(ys);  ps += dppf<0x4E>(ps);                                                       \
    ys += dppf<0x141>(ys); ps += dppf<0x141>(ps);                                                      \
    ys += dppf<0x128>(ys); ps += dppf<0x128>(ps);                                                      \
    pp = ps;                                                                                           \
    ysel = (c == (ST)) ? ys : ysel;                                                                    \
  }
#pragma unroll 2
    for (int st = 0; st < SCH; st += 2) {
      SCAN_STEP(w0_, k0_, b0_, r0_, v0_, w1_, k1_, q1_, b1_, r1_, v1_, st)
      SCAN_STEP(w1_, k1_, b1_, r1_, v1_, w0_, k0_, q0_, b0_, r0_, v0_, st + 1)
    }
#undef SCAN_STEP
    Y[c * 16 + lr] = ysel;
  };
  auto flush = [&](int ci, int cb) {
    const int st = tid >> 4, rr_ = tid & 15;
    __builtin_nontemporal_store((ybuf + cb * 256)[tid], p.yraw + (tokb + (size_t)ci * SCH + st) * 512 + h * 64 + row0 + rr_);
  };

  constexpr int NCH = S_ / SCH;
  Stage SA, SB;
  gload(SA, 0);
  gload(SB, 1);
  sstore(SA, 0);
  __syncthreads();
  for (int ci = 0; ci < NCH; ci += 2) {
    if (ci + 2 < NCH) gload(SA, ci + 2);
    compute(ci, 0);
    sstore(SB, 1);
    __syncthreads();
    flush(ci, 0);
    if (ci + 3 < NCH) gload(SB, ci + 3);
    compute(ci + 1, 1);
    if (ci + 2 < NCH) sstore(SA, 0);
    __syncthreads();
    flush(ci + 1, 1);
  }
  __syncthreads();
}

#define MFMA16(a, b, c) __builtin_amdgcn_mfma_f32_16x16x32_bf16((a), (b), (c), 0, 0, 0)
DI float ex2(float x) { return __builtin_amdgcn_exp2f(x); }
constexpr float SCL2 = 0.18033688011112042f;
constexpr float NEGB = -1e30f;

DI unsigned topk8(const float* imp, int tblk) {
  float v[32];
#pragma unroll
  for (int j = 0; j < 32; ++j) {
    float xv = imp[j];
    bool forced = (j == 0) | (j == tblk) | (j == tblk - 1);
    v[j] = (j <= tblk) ? (xv + (forced ? 1000.f : 0.f)) : -1.f;
  }
  unsigned sel = 0;
#pragma unroll
  for (int r = 0; r < 8; ++r) {
    float best = -3e38f;
    int bi = 0;
#pragma unroll
    for (int j = 0; j < 32; ++j) {
      bool ok = (((sel >> j) & 1u) == 0u) && (v[j] > best);
      best = ok ? v[j] : best;
      bi = ok ? j : bi;
    }
    sel |= 1u << bi;
  }
  return sel;
}

DI void head_step(const bf16x8& k00, const bf16x8& k01, const bf16x8& k10, const bf16x8& k11, const bf16x8& v0, const bf16x8& v1,
                  const bf16x8& v2, const bf16x8& v3, const bf16x8& q0, const bf16x8& q1, const float (&bias)[8], f32x4& O0,
                  f32x4& O1, f32x4& O2, f32x4& O3, float& m, float& l) {
  f32x4 sa = {0.f, 0.f, 0.f, 0.f}, sb = {0.f, 0.f, 0.f, 0.f};
  sa = MFMA16(k00, q0, sa);
  sb = MFMA16(k10, q0, sb);
  sa = MFMA16(k01, q1, sa);
  sb = MFMA16(k11, q1, sb);
  float sc[8];
  float cm = -3e38f;
#pragma unroll
  for (int e = 0; e < 8; ++e) {
    sc[e] = fmaf((e < 4) ? sa[e & 3] : sb[e & 3], SCL2, bias[e]);
    cm = fmaxf(cm, sc[e]);
  }
  if (__builtin_amdgcn_ballot_w64(cm > m) != 0ull) {
    cm = fmaxf(cm, __shfl_xor(cm, 16));
    cm = fmaxf(cm, __shfl_xor(cm, 32));
    const float mn = fmaxf(m, cm);
    const float alpha = ex2(m - mn);
    m = mn;
    l *= alpha;
    O0 *= alpha; O1 *= alpha; O2 *= alpha; O3 *= alpha;
  }
  float ps = 0.f;
  float pe[8];
#pragma unroll
  for (int e = 0; e < 8; ++e) {
    pe[e] = ex2(sc[e] - m);
    ps += pe[e];
  }
  l += ps;
  union { unsigned u[4]; bf16x8 v; } pk;
  pk.u[0] = pk2(pe[0], pe[1]); pk.u[1] = pk2(pe[2], pe[3]); pk.u[2] = pk2(pe[4], pe[5]); pk.u[3] = pk2(pe[6], pe[7]);
  O0 = MFMA16(v0, pk.v, O0);
  O1 = MFMA16(v1, pk.v, O1);
  O2 = MFMA16(v2, pk.v, O2);
  O3 = MFMA16(v3, pk.v, O3);
}

template <int MODE>
DI void attend(unsigned long long cmask, const bf16_t* __restrict__ Kb, const bf16_t* __restrict__ VT, const bf16x8* ql, int t,
               int t0, unsigned selmask, int n, int q4, f32x4 (&O)[4][4], float (&m)[4], float (&l)[4]) {
  const int krow = (n >> 2) * 8 + (n & 3);
  const bf16_t* Kl = Kb + (size_t)krow * 128 + q4 * 8;
  const bf16_t* Vl = VT + (size_t)n * VTS + q4 * 8;
  if (!cmask) return;
  int cur = __ffsll(cmask) - 1;
  cmask &= cmask - 1;
  bf16x8 k00, k01, k10, k11;
  {
    const bf16_t* kp_ = Kl + (size_t)cur * 32 * 128;
    k00 = *(const bf16x8*)(kp_); k01 = *(const bf16x8*)(kp_ + 32);
    k10 = *(const bf16x8*)(kp_ + 4 * 128); k11 = *(const bf16x8*)(kp_ + 4 * 128 + 32);
  }
  while (true) {
    int nxt = -1;
    if (cmask) { nxt = __ffsll(cmask) - 1; cmask &= cmask - 1; }
    bf16x8 n00, n01, n10, n11, v0, v1, v2, v3;
    {
      const bf16_t* vp_ = Vl + cur * 32;
      v0 = *(const bf16x8*)(vp_); v1 = *(const bf16x8*)(vp_ + 16 * VTS);
      v2 = *(const bf16x8*)(vp_ + 32 * VTS); v3 = *(const bf16x8*)(vp_ + 48 * VTS);
    }
    if (nxt >= 0) {
      const bf16_t* kp_ = Kl + (size_t)nxt * 32 * 128;
      n00 = *(const bf16x8*)(kp_); n01 = *(const bf16x8*)(kp_ + 32);
      n10 = *(const bf16x8*)(kp_ + 4 * 128); n11 = *(const bf16x8*)(kp_ + 4 * 128 + 32);
    }
    const int kb = cur * 32;
    const int key0 = kb + q4 * 8;
    bool blk = true;
    if (MODE == 1) blk = ((selmask >> (kb >> 6)) & 1u) != 0u;
    float bias[8];
#pragma unroll
    for (int e = 0; e < 8; ++e) {
      const int key = key0 + e;
      bool v = blk && (key <= t);
      if (MODE == 2) v = v && (key + 512 > t);
      bias[e] = v ? 0.f : NEGB;
    }
#pragma unroll
    for (int r = 0; r < 4; ++r) {
      const bf16x8 q0 = ql[(r * 2 + 0) * 64], q1 = ql[(r * 2 + 1) * 64];
      head_step(k00, k01, k10, k11, v0, v1, v2, v3, q0, q1, bias, O[r][0], O[r][1], O[r][2], O[r][3], m[r], l[r]);

    }
    if (nxt < 0) break;
    k00 = n00; k01 = n01; k10 = n10; k11 = n11;
    cur = nxt;
  }
}

constexpr int NSA_WFLOATS = 16 * 132 + 16 * 32;

__device__ void nsa_wave_item(const Params& p, int item, float* wl) {
  int tx_ = threadIdx.x;
  asm volatile("" : "+v"(tx_));
  const int lane = tx_ & 63, n = lane & 15, q4 = lane >> 4;
  const int bg = item & 15, tt = item >> 4;
  const int b = bg >> 1, g = bg & 1, t0 = tt * 16, t = t0 + n;
  const size_t tok = (size_t)b * 2048 + t;
  float* impb = wl + 2048;
  bf16x8* ql = (bf16x8*)wl + lane;
  const int krow = (n >> 2) * 8 + (n & 3);

#pragma unroll
  for (int r = 0; r < 4; ++r)
#pragma unroll
    for (int kd = 0; kd < 2; ++kd) ql[(r * 2 + kd) * 64] = *(const bf16x8*)(p.qb + tok * 512 + (g * 4 + r) * 64 + kd * 32 + q4 * 8);
  const float* gatep = p.glb + tok * 24 + g * 12;
  bf16_t* mixl = p.mix + tok * LDH + (g * 4) * 64 + q4 * 4;
  f32x4 Oc[4][4];

  {
    const bf16_t* Kc = p.kcmp + (size_t)bg * 128 * 64;
    const bf16_t* VcT = p.vcmpT + (size_t)bg * 64 * 128;
    const int nch = (t0 + 15 >= 31) ? ((min((t0 + 15 - 31) >> 4, 126) >> 5) + 1) : 0;
#pragma unroll
    for (int e = 0; e < 9; ++e) impb[lane * 9 + e] = 0.f;
    float m[4], l[4];
#pragma unroll
    for (int r = 0; r < 4; ++r) { m[r] = NEGB; l[r] = 0.f; }
#pragma unroll 1
    for (int ch = 0; ch < nch; ++ch) {
      const int kb = ch * 32;
      bf16x8 kf[2][2];
#pragma unroll
      for (int sub = 0; sub < 2; ++sub)
#pragma unroll
        for (int kd = 0; kd < 2; ++kd) kf[sub][kd] = *(const bf16x8*)(Kc + (size_t)(kb + krow + sub * 4) * 64 + kd * 32 + q4 * 8);
#pragma unroll
      for (int r = 0; r < 4; ++r) {
        f32x4 sa = {0.f, 0.f, 0.f, 0.f}, sb = {0.f, 0.f, 0.f, 0.f};
#pragma unroll
        for (int kd = 0; kd < 2; ++kd) {
          const bf16x8 qv = ql[(r * 2 + kd) * 64];
          sa = MFMA16(kf[0][kd], qv, sa);
          sb = MFMA16(kf[1][kd], qv, sb);
        }
        float sc[8];
        float cm = NEGB;
#pragma unroll
        for (int e = 0; e < 8; ++e) {
          const int c = kb + q4 * 8 + e;
          const bool v = (16 * c + 31 <= t);
          float x = ((e < 4) ? sa[e & 3] : sb[e & 3]) * SCL2;
          sc[e] = v ? x : NEGB;
          cm = fmaxf(cm, sc[e]);
        }
        cm = fmaxf(cm, __shfl_xor(cm, 16));
        cm = fmaxf(cm, __shfl_xor(cm, 32));
        const float mn = fmaxf(m[r], cm);
        float ps = 0.f;
#pragma unroll
        for (int e = 0; e < 8; ++e) ps += (sc[e] > -1e29f) ? ex2(sc[e] - mn) : 0.f;
        l[r] = l[r] * ex2(m[r] - mn) + ps;
        m[r] = mn;
        __builtin_amdgcn_sched_barrier(0);
      }
    }
    float inv[4];
#pragma unroll
    for (int r = 0; r < 4; ++r) {
      float lv = l[r];
      lv += __shfl_xor(lv, 16);
      lv += __shfl_xor(lv, 32);
      inv[r] = (lv > 0.f) ? 1.f / lv : 0.f;
    }
#pragma unroll
    for (int dt = 0; dt < 4; ++dt)
#pragma unroll
      for (int r = 0; r < 4; ++r) Oc[dt][r] = f32x4{0.f, 0.f, 0.f, 0.f};
#pragma unroll 1
    for (int ch = 0; ch < nch; ++ch) {
      const int kb = ch * 32;
      bf16x8 kf[2][2];
#pragma unroll
      for (int sub = 0; sub < 2; ++sub)
#pragma unroll
        for (int kd = 0; kd < 2; ++kd) kf[sub][kd] = *(const bf16x8*)(Kc + (size_t)(kb + krow + sub * 4) * 64 + kd * 32 + q4 * 8);
      bf16x8 vf[4];
#pragma unroll
      for (int dt = 0; dt < 4; ++dt) vf[dt] = *(const bf16x8*)(VcT + (size_t)(dt * 16 + n) * 128 + kb + q4 * 8);
      float psm[8];
#pragma unroll
      for (int e = 0; e < 8; ++e) psm[e] = 0.f;
      bf16x8 pf[4];
#pragma unroll
      for (int r = 0; r < 4; ++r) {
        f32x4 sa = {0.f, 0.f, 0.f, 0.f}, sb = {0.f, 0.f, 0.f, 0.f};
#pragma unroll
        for (int kd = 0; kd < 2; ++kd) {
          const bf16x8 qv = ql[(r * 2 + kd) * 64];
          sa = MFMA16(kf[0][kd], qv, sa);
          sb = MFMA16(kf[1][kd], qv, sb);
        }
        float pe[8];
#pragma unroll
        for (int e = 0; e < 8; ++e) {
          const int c = kb + q4 * 8 + e;
          const bool v = (16 * c + 31 <= t);
          float x = ((e < 4) ? sa[e & 3] : sb[e & 3]) * SCL2;
          pe[e] = v ? ex2(x - m[r]) * inv[r] : 0.f;
          psm[e] += pe[e];
        }
        union { unsigned u[4]; bf16x8 v; } pk;
        pk.u[0] = pk2(pe[0], pe[1]); pk.u[1] = pk2(pe[2], pe[3]); pk.u[2] = pk2(pe[4], pe[5]); pk.u[3] = pk2(pe[6], pe[7]);
        pf[r] = pk.v;
        __builtin_amdgcn_sched_barrier(0);
      }
      {
        float* ip = impb + n * 36 + (kb >> 2) + 2 * q4;
        ip[0] += psm[0] + psm[1] + psm[2] + 0.5f * psm[3];
        __builtin_amdgcn_fence(__ATOMIC_ACQ_REL, "workgroup");
        __builtin_amdgcn_wave_barrier();
        ip[1] += 0.5f * psm[3] + psm[4] + psm[5] + psm[6] + 0.5f * psm[7];
        __builtin_amdgcn_fence(__ATOMIC_ACQ_REL, "workgroup");
        __builtin_amdgcn_wave_barrier();
        ip[2] += 0.5f * psm[7];
        __builtin_amdgcn_fence(__ATOMIC_ACQ_REL, "workgroup");
        __builtin_amdgcn_wave_barrier();
      }
#pragma unroll
      for (int dt = 0; dt < 4; ++dt)
#pragma unroll
        for (int r = 0; r < 4; ++r) Oc[dt][r] = MFMA16(vf[dt], pf[r], Oc[dt][r]);
    }
  }
#pragma unroll
  for (int r = 0; r < 4; ++r) {
    const float gsc = gatep[r * 3 + 0];
#pragma unroll
    for (int dt = 0; dt < 4; ++dt) {
      uint2 o;
      o.x = pk2(Oc[dt][r][0] * gsc, Oc[dt][r][1] * gsc);
      o.y = pk2(Oc[dt][r][2] * gsc, Oc[dt][r][3] * gsc);
      *(uint2*)(mixl + r * 64 + dt * 16) = o;
    }
  }
  __builtin_amdgcn_fence(__ATOMIC_ACQ_REL, "workgroup");
  __builtin_amdgcn_wave_barrier();
  const int tblk = t0 >> 6;
  unsigned selmask = topk8(impb + n * 36, tblk);
  selmask &= (tblk >= 31) ? 0xffffffffu : ((1u << (tblk + 1)) - 1u);
  __builtin_amdgcn_wave_barrier();

#pragma unroll
  for (int r = 0; r < 4; ++r) {
    const bf16x8 q0 = ql[(r * 2 + 0) * 64];
    union { unsigned u[4]; bf16x8 v; } pk;
    float vals[8];
#pragma unroll
    for (int j = 0; j < 8; ++j) {
      float xv = bf2f((bf16_t)q0[j]);
      float ov = __shfl_xor(xv, 16);
      float2 cs = p.rope[t * 8 + j];
      vals[j] = (q4 == 0) ? (xv * cs.x - ov * cs.y) : ((q4 == 1) ? (xv * cs.x + ov * cs.y) : xv);
    }
    pk.u[0] = pk2(vals[0], vals[1]); pk.u[1] = pk2(vals[2], vals[3]); pk.u[2] = pk2(vals[4], vals[5]); pk.u[3] = pk2(vals[6], vals[7]);
    ql[(r * 2 + 0) * 64] = pk.v;
  }

#pragma unroll 1
  for (int br = 1; br <= 2; ++br) {
    unsigned long long cmask = 0ull;
    const int hic = (t0 + 15) >> 5;
    if (br == 1) {
      unsigned any = selmask;
#pragma unroll
      for (int o = 32; o >= 1; o >>= 1) any |= (unsigned)__shfl_xor((int)any, o);
      any = __builtin_amdgcn_readfirstlane(any);
      for (int j = 0; j <= tblk; ++j)
        if ((any >> j) & 1u) cmask |= 3ull << (2 * j);
      if (hic < 63) cmask &= (1ull << (hic + 1)) - 1ull;
    } else {
      const int lo = max(0, t0 - 511) >> 5;
      cmask = (hic < 63) ? ((1ull << (hic + 1)) - 1ull) : ~0ull;
      cmask &= ~((1ull << lo) - 1ull);
    }
    f32x4 O[4][4];
    float m[4], l[4];
#pragma unroll
    for (int dt = 0; dt < 4; ++dt)
#pragma unroll
      for (int r = 0; r < 4; ++r) O[r][dt] = f32x4{0.f, 0.f, 0.f, 0.f};
#pragma unroll
    for (int r = 0; r < 4; ++r) { m[r] = -1e29f; l[r] = 0.f; }
    if (br == 1)
      attend<1>(cmask, p.ksb + (size_t)b * 2048 * 128 + g * 64, p.vsT + (size_t)bg * 64 * VTS, ql, t, t0, selmask, n, q4, O, m, l);
    else
      attend<2>(cmask, p.kwb + (size_t)b * 2048 * 128 + g * 64, p.vwT + (size_t)bg * 64 * VTS, ql, t, t0, selmask, n, q4, O, m, l);
#pragma unroll
    for (int r = 0; r < 4; ++r) {
      float lv = l[r];
      lv += __shfl_xor(lv, 16);
      lv += __shfl_xor(lv, 32);
      const float gsc = gatep[r * 3 + br] * ((lv > 0.f) ? 1.f / lv : 0.f);
#pragma unroll
      for (int dt = 0; dt < 4; ++dt) {
        uint2* mp = (uint2*)(mixl + r * 64 + dt * 16);
        const uint2 u = *mp;
        float a0 = __uint_as_float(u.x << 16) + O[r][dt][0] * gsc, a1 = __uint_as_float(u.x & 0xffff0000u) + O[r][dt][1] * gsc;
        float a2 = __uint_as_float(u.y << 16) + O[r][dt][2] * gsc, a3 = __uint_as_float(u.y & 0xffff0000u) + O[r][dt][3] * gsc;
        if (br == 2) {
          const uint2 gg = *(const uint2*)(p.gns + tok * 512 + (g * 4 + r) * 64 + dt * 16 + q4 * 4);
          a0 *= __uint_as_float(gg.x << 16); a1 *= __uint_as_float(gg.x & 0xffff0000u);
          a2 *= __uint_as_float(gg.y << 16); a3 *= __uint_as_float(gg.y & 0xffff0000u);
        }
        uint2 o;
        o.x = pk2(a0, a1);
        o.y = pk2(a2, a3);
        *mp = o;
      }
    }
  }
}

DI void phase_mix_rwkv(const Params& p) {
  int tx = threadIdx.x;
  asm volatile("" : "+v"(tx));
  const int lane = tx & 63, sub = lane >> 4, c = lane & 15;
  const int gw = blockIdx.x * 4 + (tx >> 6), nw = gridDim.x * 4;
  for (int it = gw; it < T_ * 2; it += nw) {
    const int ph = it * 4 + sub;
    const int tok = ph >> 3, h = ph & 7;
    const int ch = h * 64 + c * 4;
    const size_t idx = (size_t)tok * 512 + ch;
    const float4 y = *(const float4*)(p.yraw + idx);
    const float mean = allred16(y.x + y.y + y.z + y.w) * (1.f / 64.f);
    const float d0 = y.x - mean, d1 = y.y - mean, d2 = y.z - mean, d3 = y.w - mean;
    const float var = allred16(d0 * d0 + d1 * d1 + d2 * d2 + d3 * d3) * (1.f / 64.f);
    const float rs = rsqrtf(var + 64e-5f);
    const float4 gw4 = *(const float4*)(p.gn_w + ch), gb4 = *(const float4*)(p.gn_b + ch), rk4 = *(const float4*)(p.r_k + ch);
    const uint2 ru = *(const uint2*)(p.rr + idx), ku = *(const uint2*)(p.kp + idx), vu = *(const uint2*)(p.vv + idx),
                gu = *(const uint2*)(p.grw + idx);
    const float r0 = __uint_as_float(ru.x << 16), r1 = __uint_as_float(ru.x & 0xffff0000u), r2 = __uint_as_float(ru.y << 16),
                r3 = __uint_as_float(ru.y & 0xffff0000u);
    const float k0 = __uint_as_float(ku.x << 16), k1 = __uint_as_float(ku.x & 0xffff0000u), k2 = __uint_as_float(ku.y << 16),
                k3 = __uint_as_float(ku.y & 0xffff0000u);
    const float v0 = __uint_as_float(vu.x << 16), v1 = __uint_as_float(vu.x & 0xffff0000u), v2 = __uint_as_float(vu.y << 16),
                v3 = __uint_as_float(vu.y & 0xffff0000u);
    const float g0 = __uint_as_float(gu.x << 16), g1 = __uint_as_float(gu.x & 0xffff0000u), g2 = __uint_as_float(gu.y << 16),
                g3 = __uint_as_float(gu.y & 0xffff0000u);
    const float bonus = allred16(r0 * k0 * rk4.x + r1 * k1 * rk4.y + r2 * k2 * rk4.z + r3 * k3 * rk4.w);
    uint2 o;
    o.x = pk2((d0 * rs * gw4.x + gb4.x + bonus * v0) * g0, (d1 * rs * gw4.y + gb4.y + bonus * v1) * g1);
    o.y = pk2((d2 * rs * gw4.z + gb4.z + bonus * v2) * g2, (d3 * rs * gw4.w + gb4.w + bonus * v3) * g3);
    *(uint2*)(p.mix + (size_t)tok * LDH + 512 + ch) = o;
  }
}

DI void phase_final_norm(const Params& p) {
  int tx = threadIdx.x;
  asm volatile("" : "+v"(tx));
  const int lane = tx & 63;
  const int gw = blockIdx.x * 4 + (tx >> 6), nw = gridDim.x * 4;
  const float4* fg = (const float4*)p.final_g;
  for (int row = gw; row < T_; row += nw) {
    float4* o4 = (float4*)(p.out + (size_t)row * 1024);
    float4 v[4];
    float ss = 0.f;
#pragma unroll
    for (int i = 0; i < 4; ++i) {
      v[i] = o4[i * 64 + lane];
      ss += v[i].x * v[i].x + v[i].y * v[i].y + v[i].z * v[i].z + v[i].w * v[i].w;
    }
    ss = wsum(ss);
    const float sc = rsqrtf(ss * (1.f / 1024.f) + 1e-6f);
#pragma unroll
    for (int i = 0; i < 4; ++i) {
      float4 gq = fg[i * 64 + lane];
      v[i].x *= sc * gq.x; v[i].y *= sc * gq.y; v[i].z *= sc * gq.z; v[i].w *= sc * gq.w;
      {
        const f32x4 t_ = {v[i].x, v[i].y, v[i].z, v[i].w};
        __builtin_nontemporal_store(t_, (f32x4*)&o4[i * 64 + lane]);
      }
    }
  }
}

constexpr int NPHASE = 8;
constexpr int SMEM_BYTES = 65536;

template <int PH> DI void run_phase(const Params& p, char* smem) {
  const int bid = blockIdx.x, nb = gridDim.x;
  if (PH == 0) phase_prep(p, smem);
  if (PH == 1)
    for (int t = bid; t < 128 * 32; t += nb) gemm_tile<G_PROJ>(p, t >> 5, t & 31, 0, smem);
  if (PH == 2)
    if (nb > 128) {
      if (bid < 64) gemm_tile<G_CMP1>(p, (bid & 31) >> 1, bid & 1, bid >> 5, smem);
      else
        for (int t = bid - 64; t < 512; t += nb - 64) rwkv_prep_tile(p, t, smem);
    } else {
      for (int t = bid; t < 512 + 64; t += nb) {
        if (t < 64) gemm_tile<G_CMP1>(p, (t & 31) >> 1, t & 1, t >> 5, smem);
        else rwkv_prep_tile(p, t - 64, smem);
      }
    }
  if (PH == 3) {
    if (nb != 512)
      for (int t = bid; t < 32; t += nb) gemm_tile<G_CMP2>(p, t & 15, 0, t >> 4, smem);
  }
  if (PH == 4) {
    unsigned* flag = p.ctr + 40;
    if (nb == 512 && bid >= 256 && bid < 288) {
      const int t = bid - 256;
      gemm_tile<G_CMP2>(p, t & 15, 0, t >> 4, smem);
      asm volatile("s_waitcnt vmcnt(0)" ::: "memory");
      __syncthreads();
      if (threadIdx.x == 0) {
        __builtin_amdgcn_fence(__ATOMIC_RELEASE, "agent");
        asm volatile("s_waitcnt vmcnt(0)" ::: "memory");
        __hip_atomic_fetch_add(flag, 1u, __ATOMIC_RELAXED, __HIP_MEMORY_SCOPE_AGENT);
      }
    }
    for (int t = bid; t < 256; t += nb) scan_item(p, t, smem);
    if (nb == 512) {
      if (threadIdx.x == 0) {
        while (__hip_atomic_load(flag, __ATOMIC_RELAXED, __HIP_MEMORY_SCOPE_AGENT) < 32u) __builtin_amdgcn_s_sleep(2);
        __builtin_amdgcn_fence(__ATOMIC_ACQUIRE, "agent");
        asm volatile("s_waitcnt vmcnt(0)" ::: "memory");
      }
      __syncthreads();
    }
    float* wl = (float*)smem + (threadIdx.x >> 6) * NSA_WFLOATS;
    while (true) {
      int it = 0;
      if ((threadIdx.x & 63) == 0) it = (int)atomicAdd(p.ctr, 1u);
      it = __builtin_amdgcn_readfirstlane(it);
      if (it >= 2048) break;
      nsa_wave_item(p, (127 - (it >> 4)) * 16 + (it & 15), wl);
    }
  }
  if (PH == 5) phase_mix_rwkv(p);
  if (PH == 6)
    for (int t = bid; t < 128 * 8; t += nb) gemm_tile<G_OUT>(p, t >> 3, t & 7, 0, smem);
  if (PH == 7) phase_final_norm(p);
}

template <int PH> __global__ void __launch_bounds__(256, 2) phk(Params p) {
  __shared__ __attribute__((aligned(16))) char smem[SMEM_BYTES];
  run_phase<PH>(p, smem);
}

#ifndef PROBE_PH
#define PROBE_PH -1
#endif
#define XB_CNT(j) (256 + 64 * (j))
#define XB_SUB(j) (1280 + 64 * (j))
#define XB_GEN(j) (2304 + 64 * (j))
#define XB_TOP 3328
#define XB_TOPGEN 3392
DI unsigned xb_ld(unsigned* q) { return __hip_atomic_load(q, __ATOMIC_RELAXED, __HIP_MEMORY_SCOPE_AGENT); }
DI unsigned xb_add(unsigned* q, unsigned v) { return __hip_atomic_fetch_add(q, v, __ATOMIC_RELAXED, __HIP_MEMORY_SCOPE_AGENT); }
DI unsigned xb_xcc() { return (unsigned)__builtin_amdgcn_s_getreg((3 << 11) | 20) & 0xFu; }
DI void fast_barrier(unsigned* bar) {
  asm volatile("s_waitcnt vmcnt(0)" ::: "memory");
  __syncthreads();
  if (threadIdx.x == 0) {
    const unsigned x = xb_xcc();
    unsigned nloc, nx;
    for (;;) {
      unsigned sum = 0u;
      nloc = 1u;
      nx = 0u;
#pragma unroll
      for (unsigned j = 0; j < 16; ++j) {
        const unsigned c = xb_ld(&bar[XB_CNT(j)]);
        sum += c;
        nx += (c > 0u) ? 1u : 0u;
        nloc = (j == x) ? c : nloc;
      }
      if (sum == gridDim.x) break;
      __builtin_amdgcn_s_sleep(1);
    }
    const unsigned old = xb_add(&bar[XB_SUB(x)], 1u);
    const unsigned gen = old / nloc;
    if (old + 1u == (gen + 1u) * nloc) {
      __builtin_amdgcn_fence(__ATOMIC_RELEASE, "agent");
      asm volatile("s_waitcnt vmcnt(0)" ::: "memory");
      const unsigned og = xb_add(&bar[XB_TOP], 1u);
      const unsigned tg = og / nx;
      if (og + 1u == (tg + 1u) * nx) xb_add(&bar[XB_TOPGEN], 1u);
      else
        while (xb_ld(&bar[XB_TOPGEN]) == tg) __builtin_amdgcn_s_sleep(1);
      __builtin_amdgcn_fence(__ATOMIC_ACQUIRE, "agent");
      xb_add(&bar[XB_GEN(x)], 1u);
      asm volatile("s_waitcnt vmcnt(0)" ::: "memory");
    } else {
      while (xb_ld(&bar[XB_GEN(x)]) == gen) __builtin_amdgcn_s_sleep(1);
      __builtin_amdgcn_fence(__ATOMIC_ACQUIRE, "agent");
      asm volatile("s_waitcnt vmcnt(0)" ::: "memory");
    }
  }
  __syncthreads();
}

__global__ void __launch_bounds__(256, 2) mega(Params p) {
  __shared__ __attribute__((aligned(16))) char smem[SMEM_BYTES];
  cg::grid_group grid = cg::this_grid();
  unsigned* bar = p.xbar;
  const unsigned nblk = gridDim.x;
  if (p.ctr == nullptr) grid.sync();
  if (threadIdx.x == 0) (void)xb_add(&bar[XB_CNT(xb_xcc())], 1u);
  run_phase<0>(p, smem); fast_barrier(bar);
  run_phase<1>(p, smem); fast_barrier(bar);
  run_phase<2>(p, smem); fast_barrier(bar);
  if (nblk != 512u) { run_phase<3>(p, smem); fast_barrier(bar); }
  run_phase<4>(p, smem); fast_barrier(bar);
  run_phase<5>(p, smem); fast_barrier(bar);
  run_phase<6>(p, smem); fast_barrier(bar);
  run_phase<7>(p, smem);
}

extern "C" void kernel_launch(void* const* d_in, const int* in_sizes, int n_in, void* d_out, int out_size, void* d_ws, size_t ws_size,
                              hipStream_t stream) {
  Params p{};
  const float** pin = (const float**)&p;
  for (int i = 0; i < 21; ++i) pin[i] = (const float*)d_in[i];
  p.out = (float*)d_out;
  char* w = (char*)d_ws;
  size_t off = 0;
  auto alloc = [&](size_t bytes) { void* r = w + off; off += (bytes + 255) & ~(size_t)255; return r; };
  p.WinT = (bf16_t*)alloc((size_t)NPAD * LDW * 2);
  p.WoutT = (bf16_t*)alloc((size_t)1024 * LDW * 2);
  p.W1Tk = (bf16_t*)alloc((size_t)256 * LDW1 * 2);
  p.W1Tv = (bf16_t*)alloc((size_t)256 * LDW1 * 2);
  p.W2Tk = (bf16_t*)alloc((size_t)128 * LDW2 * 2);
  p.W2Tv = (bf16_t*)alloc((size_t)128 * LDW2 * 2);
  p.WupT = (bf16_t*)alloc((size_t)512 * 64 * 2);
  p.AupT = (bf16_t*)alloc((size_t)512 * 64 * 2);
  p.bias1k = (float*)alloc(256 * 4);
  p.bias1v = (float*)alloc(256 * 4);
  p.rope = (float2*)alloc((size_t)2048 * 8 * 8);
  p.qb = (bf16_t*)alloc((size_t)T_ * 512 * 2);
  p.kcb = (bf16_t*)alloc((size_t)(T_ + 16) * LDKC * 2);
  p.vcb = (bf16_t*)alloc((size_t)(T_ + 16) * LDKC * 2);
  p.ksb = (bf16_t*)alloc((size_t)T_ * 128 * 2);
  p.kwb = (bf16_t*)alloc((size_t)T_ * 128 * 2);
  p.vsb = nullptr;
  p.vwb = nullptr;
  p.vsT = (bf16_t*)alloc((size_t)16 * 64 * VTS * 2);
  p.vwT = (bf16_t*)alloc((size_t)16 * 64 * VTS * 2);
  p.glb = (float*)alloc((size_t)T_ * 24 * 4);
  p.gns = (bf16_t*)alloc((size_t)T_ * 512 * 2);
  p.rw = (bf16_t*)alloc((size_t)T_ * 1664 * 2);
  p.yraw = (float*)p.rw;
  p.grw = (bf16_t*)alloc((size_t)T_ * 512 * 2);
  p.hidk = (bf16_t*)alloc((size_t)2048 * LDHID * 2);
  p.hidv = (bf16_t*)alloc((size_t)2048 * LDHID * 2);
  p.kcmp = (bf16_t*)alloc((size_t)16 * 128 * 64 * 2);
  p.vcmp = (bf16_t*)alloc((size_t)16 * 128 * 64 * 2);
  p.vcmpT = (bf16_t*)alloc((size_t)16 * 128 * 64 * 2);
  p.rr = (bf16_t*)alloc((size_t)T_ * 512 * 2);
  p.kp = (bf16_t*)alloc((size_t)T_ * 512 * 2);
  p.vv = (bf16_t*)alloc((size_t)T_ * 512 * 2);
  p.mix = (bf16_t*)alloc((size_t)T_ * LDH * 2);
  p.hb = p.mix;
  p.ctr = (unsigned*)alloc(256);
  p.xbar = (unsigned*)alloc(16384);
  p.dec = (float*)d_out;
  p.kk = (bf16_t*)((char*)d_out + (size_t)T_ * 512 * 4);
  p.bb = (bf16_t*)((char*)d_out + (size_t)T_ * 512 * 6);
  if (off > ws_size) {
    fprintf(stderr, "workspace too small: need %zu have %zu\n", off, ws_size);
    return;
  }
#ifdef MULTI_LAUNCH
  hipLaunchKernelGGL(phk<0>, dim3(512), dim3(256), 0, stream, p);
  hipLaunchKernelGGL(phk<1>, dim3(512), dim3(256), 0, stream, p);
  hipLaunchKernelGGL(phk<2>, dim3(512), dim3(256), 0, stream, p);
  hipLaunchKernelGGL(phk<3>, dim3(512), dim3(256), 0, stream, p);
  hipLaunchKernelGGL(phk<4>, dim3(512), dim3(256), 0, stream, p);
  hipLaunchKernelGGL(phk<5>, dim3(512), dim3(256), 0, stream, p);
  hipLaunchKernelGGL(phk<6>, dim3(512), dim3(256), 0, stream, p);
  hipLaunchKernelGGL(phk<7>, dim3(512), dim3(256), 0, stream, p);
#else
  static int grid_blocks = 0;
  if (!grid_blocks) {
    int dev = 0, cus = 0, per_cu = 0;
    hipGetDevice(&dev);
    hipDeviceGetAttribute(&cus, hipDeviceAttributeMultiprocessorCount, dev);
    hipOccupancyMaxActiveBlocksPerMultiprocessor(&per_cu, mega, 256, 0);
    if (per_cu > 2) per_cu = 2;
    if (per_cu < 1) per_cu = 1;
    grid_blocks = cus * per_cu;
  }
  hipMemsetAsync(p.ctr, 0, 256 + 16384, stream);
  void* args[] = {&p};
  hipError_t e = hipLaunchCooperativeKernel((void*)mega, dim3(grid_blocks), dim3(256), args, 0, stream);
  if (e != hipSuccess) fprintf(stderr, "cooperative launch failed: %s (grid %d)\n", hipGetErrorString(e), grid_blocks);
#endif
}
```
